# Optimizing an MI355X kernel written in HIP

```python
import jax, jax.numpy as jnp
from jax import lax
import numpy as np

D_MODEL = 1024
BATCH = 4
SEQ = 4096
DEPTH = 1
DEC_BATCH = 2
DEC_SEQ = 8192
PAST_LEN = 128

GRID_W = 64
HGRN_HEADS = 4
HGRN_DK = 128
HGRN_DV = 128
HGRN_WIDTH = HGRN_HEADS * HGRN_DV
CHUNK = 64
NA_HEADS = 8
NA_DH = 64
NA_WIDTH = NA_HEADS * NA_DH
NA_KH_MAX = 8
NA_KW = 16
NA_QBLK = 16
NA_KBAND = 32
D_FF = 2816
EPS = 1e-6
IN_COLS = 5 * HGRN_WIDTH + 3 * NA_WIDTH
SPLITS = [HGRN_WIDTH, 2 * HGRN_WIDTH, 3 * HGRN_WIDTH, 4 * HGRN_WIDTH, 5 * HGRN_WIDTH,
          5 * HGRN_WIDTH + NA_WIDTH, 5 * HGRN_WIDTH + 2 * NA_WIDTH]

kernel_name = "hymba_hgrn2_natten_encoder"


def rmsnorm(x, w):
    xf = x.astype(jnp.float32)
    y = xf * lax.rsqrt(jnp.mean(xf * xf, axis=-1, keepdims=True) + EPS) * w.astype(jnp.float32)
    return y.astype(x.dtype)


def hgrn2_direction(q, k, log_f, v):
    B, T, H, dk = q.shape
    dv = v.shape[-1]
    n = T // CHUNK

    def chunks(a):
        return a.reshape(B, n, CHUNK, H, a.shape[-1]).transpose(1, 0, 3, 2, 4)

    tril = jnp.tril(jnp.ones((CHUNK, CHUNK), dtype=bool))[..., None]

    def step(S, inp):
        qc, kc, gc, vc = inp
        b = jnp.cumsum(gc, axis=2)
        diff = b[:, :, :, None, :] - b[:, :, None, :, :]
        decay = jnp.exp(jnp.where(tril, diff, -jnp.inf))
        A = jnp.einsum('bhtd,bhsd,bhtsd->bhts', qc, kc, decay)
        b_last = b[:, :, -1:, :]
        o = jnp.einsum('bhts,bhse->bhte', A, vc) + jnp.einsum('bhtd,bhde->bhte', qc * jnp.exp(b), S)
        S = jnp.exp(b_last[:, :, 0, :])[..., None] * S + jnp.einsum(
            'bhsd,bhse->bhde', kc * jnp.exp(b_last - b), vc)
        return S, o

    S0 = jnp.zeros((B, H, dk, dv), jnp.float32)
    _, o = lax.scan(step, S0, (chunks(q), chunks(k), chunks(log_f), chunks(v)))
    return o.transpose(1, 0, 3, 2, 4).reshape(B, T, H, dv)


def neighbourhood_attention(q, k, v, rpb):
    B, T = q.shape[0], q.shape[1]
    rows = T // GRID_W
    kh = min(NA_KH_MAX, rows)
    ncb = GRID_W // NA_QBLK
    r = np.arange(rows)
    row_start = np.clip(r - kh // 2, 0, rows - kh)
    row_idx = row_start[:, None] + np.arange(kh)[None, :]
    j = np.arange(ncb)
    band_start = np.clip(j * NA_QBLK - NA_KW // 2, 0, GRID_W - NA_KBAND)
    col_idx = band_start[:, None] + np.arange(NA_KBAND)[None, :]
    qcol = j[:, None] * NA_QBLK + np.arange(NA_QBLK)[None, :]
    win_start = np.clip(qcol - NA_KW // 2, 0, GRID_W - NA_KW)
    valid = ((col_idx[:, None, :] >= win_start[:, :, None]) &
             (col_idx[:, None, :] < win_start[:, :, None] + NA_KW))
    dr = row_idx - r[:, None]
    dc = np.clip(col_idx[:, None, :] - qcol[:, :, None], -(NA_KW - 1), NA_KW - 1)

    def grid(a):
        return a.reshape(B, rows, GRID_W, NA_HEADS, NA_DH).transpose(0, 3, 1, 2, 4)

    qg, kg, vg = grid(q), grid(k), grid(v)
    qb = qg.reshape(B, NA_HEADS, rows, ncb, NA_QBLK, NA_DH)
    ri = row_idx[:, None, :, None]
    ci = col_idx[None, :, None, :]
    kb = kg[:, :, ri, ci]
    vb = vg[:, :, ri, ci]
    scores = jnp.einsum('bhrjqd,bhrjkwd->bhrjqkw', qb, kb).astype(jnp.float32) * (NA_DH ** -0.5)
    bias = rpb[:, (dr + NA_KH_MAX - 1)[:, None, None, :, None],
               (dc + NA_KW - 1)[None, :, :, None, :]]
    scores = scores + bias[None].astype(jnp.float32)
    scores = jnp.where(valid[None, None, None, :, :, None, :], scores, -1e30)
    shp = scores.shape
    p = jax.nn.softmax(scores.reshape(shp[:-2] + (kh * NA_KBAND,)), axis=-1).reshape(shp)
    out = jnp.einsum('bhrjqkw,bhrjkwd->bhrjqd', p.astype(vb.dtype), vb)
    out = out.reshape(B, NA_HEADS, rows, GRID_W, NA_DH).transpose(0, 2, 3, 1, 4)
    return out.reshape(B, T, NA_WIDTH)


def encoder_layer(x, norm_mix_w, w_in, lb, hgrn_gnorm_w, na_q_norm_w, na_k_norm_w, na_rpb,
                  w_out, norm_ffn_w, w_gate, w_up, w_down):
    B, T, _ = x.shape
    f32 = jnp.float32
    h = rmsnorm(x, norm_mix_w)
    proj = h @ w_in
    hq, hf_fwd, hf_bwd, hi, hg, nq, nk, nv = jnp.split(proj, SPLITS, axis=-1)

    def heads(a, d):
        return a.reshape(B, T, -1, d)

    qh = heads(jax.nn.silu(hq.astype(f32)), HGRN_DK)
    vh = heads(hi.astype(f32), HGRN_DV)

    def gate(logit, lb_d):
        f = lb_d + (1.0 - lb_d) * jax.nn.sigmoid(logit.astype(f32))
        return heads(1.0 - f, HGRN_DK), heads(jnp.log(f), HGRN_DK)

    kf, gf = gate(hf_fwd, lb[0])
    kbk, gbk = gate(hf_bwd, lb[1])
    o_f = hgrn2_direction(qh, kf, gf, vh)
    o_b = jnp.flip(hgrn2_direction(jnp.flip(qh, 1), jnp.flip(kbk, 1), jnp.flip(gbk, 1),
                                   jnp.flip(vh, 1)), axis=1)
    o = o_f + o_b
    o = (o * lax.rsqrt(jnp.mean(o * o, axis=-1, keepdims=True) + EPS) * hgrn_gnorm_w.astype(f32)
         * jax.nn.silu(heads(hg.astype(f32), HGRN_DV)))
    o_hgrn = o.reshape(B, T, HGRN_WIDTH).astype(x.dtype)

    qa = rmsnorm(heads(nq, NA_DH), na_q_norm_w)
    ka = rmsnorm(heads(nk, NA_DH), na_k_norm_w)
    va = heads(nv, NA_DH)
    o_na = neighbourhood_attention(qa, ka, va, na_rpb).astype(x.dtype)

    x = x + jnp.concatenate([o_hgrn, o_na], axis=-1) @ w_out

    h2 = rmsnorm(x, norm_ffn_w)
    x = x + (jax.nn.silu(h2 @ w_gate) * (h2 @ w_up)) @ w_down
    return x


def setup_inputs(seed: int = 0) -> dict:
    key = jax.random.key(seed)
    ks = jax.random.split(key, 14)
    n = jax.random.normal
    return {
        "x_prompt": n(ks[0], (BATCH, SEQ, D_MODEL), jnp.float32),
        "x_sample": n(ks[1], (DEC_BATCH, DEC_SEQ, D_MODEL), jnp.float32),
        "norm_mix_w": 1.0 + 0.1 * n(ks[2], (DEPTH, D_MODEL), jnp.float32),
        "w_in": n(ks[3], (DEPTH, D_MODEL, IN_COLS), jnp.float32) * D_MODEL ** -0.5,
        "hgrn_lb": 0.5 * n(ks[4], (DEPTH + 1, 2, HGRN_WIDTH), jnp.float32),
        "hgrn_gnorm_w": 1.0 + 0.1 * n(ks[5], (DEPTH, HGRN_DV), jnp.float32),
        "na_q_norm_w": 1.0 + 0.1 * n(ks[6], (DEPTH, NA_DH), jnp.float32),
        "na_k_norm_w": 1.0 + 0.1 * n(ks[7], (DEPTH, NA_DH), jnp.float32),
        "na_rpb": 0.1 * n(ks[8], (DEPTH, NA_HEADS, 2 * NA_KH_MAX - 1, 2 * NA_KW - 1), jnp.float32),
        "w_out": n(ks[9], (DEPTH, D_MODEL, D_MODEL), jnp.float32) * D_MODEL ** -0.5,
        "norm_ffn_w": 1.0 + 0.1 * n(ks[10], (DEPTH, D_MODEL), jnp.float32),
        "w_gate": n(ks[11], (DEPTH, D_MODEL, D_FF), jnp.float32) * D_MODEL ** -0.5,
        "w_up": n(ks[12], (DEPTH, D_MODEL, D_FF), jnp.float32) * D_MODEL ** -0.5,
        "w_down": n(ks[13], (DEPTH, D_FF, D_MODEL), jnp.float32) * D_FF ** -0.5,
    }


def reference(x_prompt, x_sample, norm_mix_w, w_in, hgrn_lb, hgrn_gnorm_w, na_q_norm_w,
              na_k_norm_w, na_rpb, w_out, norm_ffn_w, w_gate, w_up, w_down):
    lb_all = jnp.cumsum(jax.nn.softmax(hgrn_lb.astype(jnp.float32), axis=0), axis=0)

    def trunk(x):
        for l in range(DEPTH):
            x = encoder_layer(x, norm_mix_w[l], w_in[l], lb_all[l], hgrn_gnorm_w[l], na_q_norm_w[l],
                              na_k_norm_w[l], na_rpb[l], w_out[l], norm_ffn_w[l], w_gate[l],
                              w_up[l], w_down[l])
        return x

    y_prompt = trunk(x_prompt)
    y_sample = trunk(x_sample)
    return (y_prompt, y_sample)
```

```cpp
#include <hip/hip_runtime.h>
#include <cstdio>
#include <cstdint>
namespace pg8 {
#define PG8_LAS __attribute__((address_space(3)))
typedef unsigned short bf16_t;
typedef short bf16x8 __attribute__((ext_vector_type(8)));
typedef float f32x4 __attribute__((ext_vector_type(4)));
typedef unsigned u32x4 __attribute__((ext_vector_type(4)));
constexpr int BM = 256, BK = 64, HALF = 128, HTB = HALF * BK * 2  , STAGE_BYTES = 8 * HTB, NXCD = 8, WGM = 8;

__host__ __device__ __forceinline__ int lds_byte(int r, int c) { const int st = (r >> 4) * 2 + (c >> 5), rr = r & 15, cc = c & 31, ob = rr * 64 + cc * 2; return st * 1024 + (ob ^ (((ob >> 9) & 1) << 5)); }
__host__ __device__ __forceinline__ void stage_rc(int b, int& R, int& C) { const int st = b / 1024, sb = b % 1024, swz = sb ^ (((sb >> 9) & 1) << 5); R = (st >> 1) * 16 + swz / 64; C = (st & 1) * 32 + (swz % 64) / 2; }
__host__ __device__ __forceinline__ int perm32(int rho) { const int n = rho >> 4, i = rho & 15; return 8 * (i >> 2) + 4 * n + (i & 3); }

struct Unit { int pm, pn; };
struct Gemm { const bf16_t* A; const bf16_t* Bt; int M, N, K; };

struct StaticOrder {
    int nM, nN, nwg, G, c;
    __host__ __device__ void init(int M, int N, int G_, int c_) { nM = M / BM; nN = N / BM; nwg = nM * nN; G = G_; c = c_; }
    __host__ __device__ bool next(int i, Unit& u) const {
        const long L = (long)i * G + c; if (L >= nwg) return false;
        int wgid = (int)L; { const int q = nwg / NXCD, r = nwg % NXCD, xcd = wgid % NXCD, off = wgid / NXCD; wgid = (xcd < r ? xcd * (q + 1) : r * (q + 1) + (xcd - r) * q) + off; }
        const int nig = WGM * nN, gid = wgid / nig, fm = gid * WGM, gsz = (nM - fm) < WGM ? (nM - fm) : WGM;
        u.pm = fm + ((wgid % nig) % gsz); u.pn = (wgid % nig) / gsz; return true;
    }
    __device__ __forceinline__ void a_ready(const Unit&) const {}
    __device__ __forceinline__ void done(const Unit&) const {}
};

__device__ __forceinline__ unsigned cvt_pk_bf16(float lo, float hi) { unsigned r; asm volatile("v_cvt_pk_bf16_f32 %0, %1, %2" : "=v"(r) : "v"(lo), "v"(hi)); return r; }
template <class Epi, class Sched, bool ALIGN_EPI = false, bool SP2 = false>
__device__ __forceinline__ void gemm_phase(PG8_LAS unsigned char* lds, const Gemm g, const Sched& S, const Epi& E) {
    const int tid = threadIdx.x, wid = __builtin_amdgcn_readfirstlane(tid >> 6), lane = tid & 63, wr = wid >> 2, wc = wid & 3, fr = lane & 15, fq = lane >> 4;
    const int K = g.K, nt = K / BK;
    unsigned voffA[2], voffB[2];
#pragma unroll
    for (int i = 0; i < 2; ++i) { int R, C; stage_rc(tid * 16 + i * 8192, R, C); const int Rb = Epi::PERM ? ((R & ~31) + perm32(R & 31)) : R;
        voffA[i] = (unsigned)(R * K + C) * 2u; voffB[i] = (unsigned)(Rb * K + C) * 2u; }
    const size_t kstep = (size_t)(BK * 2);
    const size_t hstep = (size_t)HALF * K * 2;
    const size_t tstep = 2 * hstep;
    const unsigned ldsw = (unsigned)wid * 1024u;
    const int aoff = lds_byte(wr * 64 + fr, fq * 8), boff = lds_byte(wc * 32 + fr, fq * 8);
#define PG8_SA(b, h) (((b) * 2 + (h)) * HTB)
#define PG8_SB(b, h) ((4 + (b) * 2 + (h)) * HTB)
#define PG8_STAGE(bufoff, gbase, voff) do { _Pragma("unroll") for (int _i = 0; _i < 2; ++_i) \
        __builtin_amdgcn_global_load_lds((const unsigned*)((const char*)(gbase) + (voff)[_i]), (PG8_LAS unsigned*)(lds + (bufoff) + ldsw + _i * 8192), 16, 0, 0); } while (0)
#define PG8_LDA(dst, b, h) do { _Pragma("unroll") for (int m = 0; m < 4; ++m) _Pragma("unroll") for (int k = 0; k < 2; ++k) dst[m][k] = *(const PG8_LAS bf16x8*)(lds + PG8_SA(b, h) + aoff + m * 2048 + k * 1024); } while (0)
#define PG8_LDB(dst, b, h) do { _Pragma("unroll") for (int n = 0; n < 2; ++n) _Pragma("unroll") for (int k = 0; k < 2; ++k) dst[n][k] = *(const PG8_LAS bf16x8*)(lds + PG8_SB(b, h) + boff + n * 2048 + k * 1024); } while (0)
#define PG8_MMA(ai, bj, At, Bt) do { __builtin_amdgcn_s_setprio(1); _Pragma("unroll") for (int m = 0; m < 4; ++m) _Pragma("unroll") for (int n = 0; n < 2; ++n) _Pragma("unroll") for (int k = 0; k < 2; ++k) \
        acc[ai][bj][m][n] = __builtin_amdgcn_mfma_f32_16x16x32_bf16(Bt[n][k], At[m][k], acc[ai][bj][m][n], 0, 0, 0); __builtin_amdgcn_s_setprio(0); } while (0)
#define PG8_WAIT_V(n) asm volatile("s_waitcnt vmcnt(" #n ")" ::: "memory")
#define PG8_WAIT_L(n) asm volatile("s_waitcnt lgkmcnt(" #n ")" ::: "memory")
#define PG8_BAR __builtin_amdgcn_s_barrier()
#define PG8_SCHED __builtin_amdgcn_sched_barrier(0)
    Unit cur, nxt; int ui = 0;
    if (!S.next(0, cur)) return;
    f32x4 acc[2][2][4][2];
#pragma unroll
    for (int a = 0; a < 2; ++a)
#pragma unroll
        for (int b = 0; b < 2; ++b)
#pragma unroll
            for (int m = 0; m < 4; ++m)
#pragma unroll
                for (int n = 0; n < 2; ++n) acc[a][b][m][n] = (f32x4){0.f, 0.f, 0.f, 0.f};
    bf16x8 At[4][2], B0[2][2], B1[2][2];
    const char* cA = (const char*)g.A + (size_t)cur.pm * tstep; const char* cB = (const char*)g.Bt + (size_t)cur.pn * tstep;
    S.a_ready(cur);
    if constexpr (SP2) {
        PG8_STAGE(PG8_SB(0, 0), cB, voffB); PG8_STAGE(PG8_SB(0, 1), cB + hstep, voffB); PG8_STAGE(PG8_SA(0, 0), cA, voffA); PG8_STAGE(PG8_SA(0, 1), cA + hstep, voffA);
        if (wr == 1) PG8_BAR;
        PG8_WAIT_V(2); PG8_BAR;
        PG8_STAGE(PG8_SB(1, 0), cB + kstep, voffB); PG8_STAGE(PG8_SA(1, 0), cA + kstep, voffA); PG8_STAGE(PG8_SB(1, 1), cB + hstep + kstep, voffB);
        PG8_WAIT_V(6); PG8_BAR;
    } else {
        PG8_STAGE(PG8_SB(0, 0), cB, voffB); PG8_STAGE(PG8_SA(0, 0), cA, voffA); PG8_STAGE(PG8_SB(0, 1), cB + hstep, voffB); PG8_STAGE(PG8_SA(0, 1), cA + hstep, voffA);
        if (wr == 1) PG8_BAR;
        PG8_WAIT_V(4); PG8_BAR;
        PG8_STAGE(PG8_SB(1, 0), cB + kstep, voffB); PG8_STAGE(PG8_SA(1, 0), cA + kstep, voffA); PG8_STAGE(PG8_SB(1, 1), cB + hstep + kstep, voffB);
        PG8_WAIT_V(6); PG8_BAR;
    }
    for (;;) {
        const bool has_next = S.next(ui + 1, nxt);
        const char* nA = has_next ? (const char*)g.A + (size_t)nxt.pm * tstep : cA; const char* nB = has_next ? (const char*)g.Bt + (size_t)nxt.pn * tstep : cB;
        for (int t = 0; t < nt; t += 2) {
            const bool last = (t == nt - 2);
            const char* a1 = cA + (size_t)(t + 1) * kstep;
            const char* a2 = last ? nA : cA + (size_t)(t + 2) * kstep; const char* b2 = last ? nB : cB + (size_t)(t + 2) * kstep;
            const char* a3 = a2 + kstep; const char* b3 = b2 + kstep;
            if (last && has_next) S.a_ready(nxt);
            if constexpr (SP2) {
            PG8_LDB(B0, 0, 0); PG8_LDB(B1, 0, 1); PG8_SCHED; PG8_LDA(At, 0, 0); PG8_STAGE(PG8_SA(1, 1), a1 + hstep, voffA);
            PG8_WAIT_V(8); PG8_WAIT_L(0); PG8_BAR; PG8_MMA(0, 0, At, B0); PG8_MMA(0, 1, At, B1); PG8_BAR; PG8_SCHED;
            PG8_LDA(At, 0, 1); PG8_STAGE(PG8_SB(0, 0), b2, voffB); PG8_STAGE(PG8_SB(0, 1), b2 + hstep, voffB); PG8_STAGE(PG8_SA(0, 0), a2, voffA);
            PG8_WAIT_V(8); PG8_WAIT_L(0); PG8_BAR; PG8_MMA(1, 0, At, B0); PG8_MMA(1, 1, At, B1); PG8_BAR; PG8_SCHED;
            PG8_LDB(B0, 1, 0); PG8_LDB(B1, 1, 1); PG8_SCHED; PG8_LDA(At, 1, 0); PG8_STAGE(PG8_SA(0, 1), a2 + hstep, voffA);
            PG8_WAIT_V(8); PG8_WAIT_L(0); PG8_BAR; PG8_MMA(0, 0, At, B0); PG8_MMA(0, 1, At, B1); PG8_BAR; PG8_SCHED;
            PG8_LDA(At, 1, 1); PG8_STAGE(PG8_SB(1, 0), b3, voffB); PG8_STAGE(PG8_SB(1, 1), b3 + hstep, voffB); PG8_STAGE(PG8_SA(1, 0), a3, voffA);
            PG8_WAIT_V(8); PG8_WAIT_L(0); PG8_BAR; PG8_MMA(1, 0, At, B0); PG8_MMA(1, 1, At, B1); PG8_BAR; PG8_SCHED;
            } else {
            PG8_LDB(B0, 0, 0); PG8_SCHED; PG8_LDA(At, 0, 0); PG8_STAGE(PG8_SA(1, 1), a1 + hstep, voffA);
            PG8_WAIT_L(8); PG8_BAR; PG8_WAIT_L(0); PG8_MMA(0, 0, At, B0); PG8_BAR; PG8_SCHED;
            PG8_LDB(B1, 0, 1); PG8_STAGE(PG8_SB(0, 0), b2, voffB);
            PG8_BAR; PG8_WAIT_L(0); PG8_MMA(0, 1, At, B1); PG8_BAR;
            PG8_LDA(At, 0, 1); PG8_STAGE(PG8_SA(0, 0), a2, voffA);
            PG8_BAR; PG8_WAIT_L(0); PG8_MMA(1, 0, At, B0); PG8_BAR; PG8_SCHED;
            PG8_STAGE(PG8_SB(0, 1), b2 + hstep, voffB);
            PG8_WAIT_V(6); PG8_BAR; PG8_MMA(1, 1, At, B1); PG8_BAR;
            PG8_LDB(B0, 1, 0); PG8_SCHED; PG8_LDA(At, 1, 0); PG8_STAGE(PG8_SA(0, 1), a2 + hstep, voffA);
            PG8_WAIT_L(8); PG8_BAR; PG8_WAIT_L(0); PG8_MMA(0, 0, At, B0); PG8_BAR; PG8_SCHED;
            PG8_LDB(B1, 1, 1); PG8_STAGE(PG8_SB(1, 0), b3, voffB);
            PG8_BAR; PG8_WAIT_L(0); PG8_MMA(0, 1, At, B1); PG8_BAR;
            PG8_LDA(At, 1, 1); PG8_STAGE(PG8_SA(1, 0), a3, voffA);
            PG8_BAR; PG8_WAIT_L(0); PG8_MMA(1, 0, At, B0); PG8_BAR; PG8_SCHED;
            PG8_STAGE(PG8_SB(1, 1), b3 + hstep, voffB);
            PG8_WAIT_V(6); PG8_BAR; PG8_MMA(1, 1, At, B1); PG8_BAR;
            }
        }
        if constexpr (ALIGN_EPI) { if (wr == 0) PG8_BAR; }
        if constexpr (!Epi::AFTER_DRAIN) { E(acc, cur, wr, wc, fr, fq); S.done(cur); }
        if (!has_next) break;
#pragma unroll
        for (int a = 0; a < 2; ++a)
#pragma unroll
            for (int b = 0; b < 2; ++b)
#pragma unroll
                for (int m = 0; m < 4; ++m)
#pragma unroll
                    for (int n = 0; n < 2; ++n) acc[a][b][m][n] = (f32x4){0.f, 0.f, 0.f, 0.f};
        cur = nxt; cA = nA; cB = nB; ++ui;
        if constexpr (ALIGN_EPI) { if (wr == 1) PG8_BAR; }
    }
    PG8_WAIT_V(0);
    if constexpr (!ALIGN_EPI) { if (wr == 0) PG8_BAR; }
    PG8_BAR;
    if constexpr (Epi::AFTER_DRAIN) { E.fused(acc, cur, wr, wc, fr, fq, lds, wid, lane); S.done(cur); }
#undef PG8_SA
#undef PG8_SB
#undef PG8_STAGE
#undef PG8_LDA
#undef PG8_LDB
#undef PG8_MMA
#undef PG8_WAIT_V
#undef PG8_WAIT_L
#undef PG8_BAR
#undef PG8_SCHED
}
}

constexpr int NWAVES = 8;
constexpr int M = 32768, MP = 16384, D = 1024, INC = 4096, FF = 2816, GW = 512;
constexpr float EPS = 1e-6f;
constexpr size_t MiB = 1u << 20;
constexpr size_t WS_CTL = 0, CTL_ZERO_BYTES = 1 * MiB;
constexpr size_t WS_WGU = 1 * MiB;
constexpr size_t WS_A = 12 * MiB;
constexpr size_t WS_H = 76 * MiB;
constexpr size_t HSLOT = 32 * MiB;
constexpr size_t WS_O = WS_H;
constexpr size_t WS_WIN = 236 * MiB;
constexpr size_t WS_WOUT = 252 * MiB;
constexpr size_t WS_XN2 = 188 * MiB;
constexpr size_t WS_HFF = 12 * MiB;
constexpr size_t WS_WDOWN = 188 * MiB;
constexpr size_t WS_END = 256 * MiB;
constexpr int CW_BAR = 4096;
constexpr int CW_SSQ = 65536;
static_assert((CW_SSQ + M) * 4 <= (int)CTL_ZERO_BYTES, "ctl");
constexpr int RING_OFF = 0, RING_BYTES = 131072;
constexpr int LDSCTL_OFF = RING_BYTES, MISC_OFF = LDSCTL_OFF + 320;
constexpr int LDS_BYTES = 147456;

#define GAS __attribute__((address_space(1)))
#define LAS __attribute__((address_space(3)))
typedef unsigned short bf16;
typedef unsigned v4u __attribute__((ext_vector_type(4)));
typedef unsigned v2u __attribute__((ext_vector_type(2)));
typedef float f32x4 __attribute__((ext_vector_type(4)));
typedef float f32x2 __attribute__((ext_vector_type(2)));
#define LDS_WAIT() asm volatile("s_waitcnt lgkmcnt(0)" ::: "memory")
#define VM_WAIT() asm volatile("s_waitcnt vmcnt(0)" ::: "memory")
__device__ __forceinline__ unsigned f2bf(float f) { unsigned u = __builtin_bit_cast(unsigned, f); return (u + 0x7fffu + ((u >> 16) & 1u)) >> 16; }
__device__ __forceinline__ unsigned pk2(float lo, float hi) { return f2bf(lo) | (f2bf(hi) << 16); }
__device__ __forceinline__ float bflo(unsigned w) { return __builtin_bit_cast(float, w << 16); }
__device__ __forceinline__ float bfhi(unsigned w) { return __builtin_bit_cast(float, w & 0xffff0000u); }
__device__ __forceinline__ float sigmoidf_(float x) { return 1.f / (1.f + __expf(-x)); }
__device__ __forceinline__ float siluf_(float x) { return x / (1.f + __expf(-x)); }

#define XB_TMO      128
#define XB_XCNT(j)  (256  + 64 * (j))
#define XB_XSUB(j)  (1280 + 64 * (j))
#define XB_XGEN(j)  (2304 + 64 * (j))
#define XB_TOP      3328
#define XB_TOPGEN   3392
#define XCD_BAR_WORDS 3456
#define XB_SPIN_CAP (1u << 18)
__device__ __forceinline__ unsigned xb_ld(unsigned* p)              { return __hip_atomic_load(p, __ATOMIC_RELAXED, __HIP_MEMORY_SCOPE_AGENT); }
__device__ __forceinline__ unsigned xb_add(unsigned* p, unsigned v) { return __hip_atomic_fetch_add(p, v, __ATOMIC_RELAXED, __HIP_MEMORY_SCOPE_AGENT); }
__device__ __forceinline__ unsigned xb_xcc_id() { return (unsigned)__builtin_amdgcn_s_getreg((3 << 11) | 20) & 0xFu; }
#define XB_SPIN(cond, bar) do { unsigned _sp = 0; while (cond) { __builtin_amdgcn_s_sleep(1); \
    if ((++_sp & 255u) == 0u) { if (xb_ld(&(bar)[XB_TMO])) break; if (_sp > XB_SPIN_CAP) { atomicAdd(&(bar)[XB_TMO], 1u); break; } } } } while (0)
struct XcdBarrier { unsigned* bar; unsigned x; volatile LAS unsigned* st; };
__device__ __forceinline__ XcdBarrier xcd_barrier_post(unsigned* bar, volatile LAS unsigned* st) {
    XcdBarrier b; b.bar = bar; b.x = xb_xcc_id(); b.st = st;
    if (threadIdx.x == 0) (void)xb_add(&bar[XB_XCNT(b.x)], 1u);
    return b;
}
__device__ __forceinline__ void xcd_barrier_complete(unsigned* bar, unsigned x, unsigned& nloc, unsigned& nx) {
    const unsigned G = gridDim.x * gridDim.y * gridDim.z;
    unsigned sum, cnt, mine, sp = 0u;
    for (;;) {
        sum = 0u; cnt = 0u; mine = 0u;
#pragma unroll
        for (unsigned j = 0; j < 16; ++j) { const unsigned c = xb_ld(&bar[XB_XCNT(j)]); sum += c; cnt += (c > 0u) ? 1u : 0u; mine = (j == x) ? c : mine; }
        if (sum == G) break;
        __builtin_amdgcn_s_sleep(1);
        if ((++sp & 255u) == 0u) { if (xb_ld(&bar[XB_TMO])) break; if (sp > XB_SPIN_CAP) { atomicAdd(&bar[XB_TMO], 1u); break; } }
    }
    nloc = mine > 0u ? mine : 1u; nx = cnt > 0u ? cnt : 1u;
}
__device__ __forceinline__ void xcd_barrier(const XcdBarrier& b) {
    asm volatile("s_waitcnt vmcnt(0)" ::: "memory");
    __syncthreads();
    if (threadIdx.x == 0) {
        unsigned* bar = b.bar;
        __builtin_amdgcn_s_waitcnt(0);
        unsigned nloc = b.st[0], nx = b.st[1];
        if (nloc == 0u) { xcd_barrier_complete(bar, b.x, nloc, nx); b.st[0] = nloc; b.st[1] = nx; }
        const unsigned old = xb_add(&bar[XB_XSUB(b.x)], 1u);
        const unsigned gen = old / nloc;
        if (old + 1u == (gen + 1u) * nloc) {
            __builtin_amdgcn_fence(__ATOMIC_RELEASE, "agent");
            asm volatile("s_waitcnt vmcnt(0)" ::: "memory");
            const unsigned og = xb_add(&bar[XB_TOP], 1u);
            const unsigned tg = og / nx;
            if (og + 1u == (tg + 1u) * nx) xb_add(&bar[XB_TOPGEN], 1u);
            else XB_SPIN(xb_ld(&bar[XB_TOPGEN]) == tg, bar);
            __builtin_amdgcn_fence(__ATOMIC_ACQUIRE, "agent");
            xb_add(&bar[XB_XGEN(b.x)], 1u);
            asm volatile("s_waitcnt vmcnt(0)" ::: "memory");
        } else {
            XB_SPIN(xb_ld(&bar[XB_XGEN(b.x)]) == gen, bar);
            __builtin_amdgcn_fence(__ATOMIC_ACQUIRE, "agent");
            asm volatile("s_waitcnt vmcnt(0)" ::: "memory");
        }
    }
    __syncthreads();
}

struct EpiInProj {
    static constexpr bool PERM = true, AFTER_DRAIN = false;
    bf16* hbase; bf16* nabase; const float* lbp;
    __device__ __forceinline__ void operator()(const pg8::f32x4 (&acc)[2][2][4][2], const pg8::Unit& u, int wr, int wc, int fr, int fq) const {
        const int grp = u.pn >> 1;
        bf16* base = grp < 5 ? hbase + (size_t)grp * ((size_t)M * GW) : nabase + (size_t)(grp - 5) * ((size_t)M * GW);
        const int row0 = u.pm * 256 + wr * 64 + fr;
        const int col0 = (u.pn & 1) * 256 + wc * 32 + 8 * fq;
        float lb[2][8];
#pragma unroll
        for (int bj = 0; bj < 2; ++bj)
#pragma unroll
            for (int e = 0; e < 8; ++e) lb[bj][e] = 0.f;
        if (grp == 1 || grp == 2) {
#pragma unroll
            for (int bj = 0; bj < 2; ++bj)
#pragma unroll
                for (int e = 0; e < 8; ++e) { const int c = (grp - 1) * GW + col0 + bj * 128 + e; lb[bj][e] = 1.f / (1.f + __expf(lbp[1024 + c] - lbp[c])); }
        }
#pragma unroll
        for (int ai = 0; ai < 2; ++ai)
#pragma unroll
            for (int m = 0; m < 4; ++m) { bf16* rowp = base + (size_t)(row0 + ai * 128 + m * 16) * GW + col0;
#pragma unroll
                for (int bj = 0; bj < 2; ++bj) {
                    float v[8];
#pragma unroll
                    for (int e = 0; e < 4; ++e) { v[e] = acc[ai][bj][m][0][e]; v[4 + e] = acc[ai][bj][m][1][e]; }
                    if (grp == 0 || grp == 4) {
#pragma unroll
                        for (int e = 0; e < 8; ++e) v[e] = siluf_(v[e]);
                    } else if (grp == 1 || grp == 2) {
#pragma unroll
                        for (int e = 0; e < 8; ++e) v[e] = __logf(lb[bj][e] + (1.f - lb[bj][e]) * sigmoidf_(v[e]));
                    }
                    pg8::u32x4 w; w.x = pg8::cvt_pk_bf16(v[0], v[1]); w.y = pg8::cvt_pk_bf16(v[2], v[3]); w.z = pg8::cvt_pk_bf16(v[4], v[5]); w.w = pg8::cvt_pk_bf16(v[6], v[7]);
                    *(pg8::u32x4*)(rowp + bj * 128) = w; } }
    }
};
struct EpiOutProj {
    static constexpr bool PERM = true, AFTER_DRAIN = false;
    const float* xp; const float* xs; float* out; bf16* xn2; const float* wffn; float* ssq;
    __device__ __forceinline__ void operator()(const pg8::f32x4 (&acc)[2][2][4][2], const pg8::Unit& u, int wr, int wc, int fr, int fq) const {
        const int row0 = u.pm * 256 + wr * 64 + fr, col0 = u.pn * 256 + wc * 32 + 8 * fq;
        pg8::f32x4 wv[2][2];
#pragma unroll
        for (int bj = 0; bj < 2; ++bj)
#pragma unroll
            for (int n = 0; n < 2; ++n) wv[bj][n] = *(const pg8::f32x4*)(wffn + col0 + bj * 128 + 4 * n);
#pragma unroll
        for (int ai = 0; ai < 2; ++ai)
#pragma unroll
            for (int m = 0; m < 4; ++m) { const int row = row0 + ai * 128 + m * 16;
                const float* xrow = (row < MP ? xp + (size_t)row * D : xs + (size_t)(row - MP) * D) + col0;
                float* orow = out + (size_t)row * D + col0; bf16* nrow = xn2 + (size_t)row * D + col0;
                float sq = 0.f;
#pragma unroll
                for (int bj = 0; bj < 2; ++bj) {
                    const pg8::f32x4 a0 = *(const pg8::f32x4*)(xrow + bj * 128) + acc[ai][bj][m][0], a1 = *(const pg8::f32x4*)(xrow + bj * 128 + 4) + acc[ai][bj][m][1];
                    *(pg8::f32x4*)(orow + bj * 128) = a0; *(pg8::f32x4*)(orow + bj * 128 + 4) = a1;
                    sq += (a0[0] * a0[0] + a0[1] * a0[1]) + (a0[2] * a0[2] + a0[3] * a0[3]) + (a1[0] * a1[0] + a1[1] * a1[1]) + (a1[2] * a1[2] + a1[3] * a1[3]);
                    const pg8::f32x4 b0 = a0 * wv[bj][0], b1 = a1 * wv[bj][1];
                    pg8::u32x4 w; w.x = pg8::cvt_pk_bf16(b0[0], b0[1]); w.y = pg8::cvt_pk_bf16(b0[2], b0[3]); w.z = pg8::cvt_pk_bf16(b1[0], b1[1]); w.w = pg8::cvt_pk_bf16(b1[2], b1[3]);
                    *(pg8::u32x4*)(nrow + bj * 128) = w; }
                sq += __shfl_xor(sq, 16); sq += __shfl_xor(sq, 32);
                if (fq == 0) atomicAdd(ssq + row, sq); }
    }
};
struct EpiGateUp {
    static constexpr bool PERM = true, AFTER_DRAIN = false;
    bf16* h; const float* ssq;
    __device__ __forceinline__ void operator()(const pg8::f32x4 (&acc)[2][2][4][2], const pg8::Unit& u, int wr, int wc, int fr, int fq) const {
        const int row0 = u.pm * 256 + wr * 64 + fr, col0 = u.pn * 128 + wc * 32 + 8 * fq;
#pragma unroll
        for (int ai = 0; ai < 2; ++ai)
#pragma unroll
            for (int m = 0; m < 4; ++m) { const int row = row0 + ai * 128 + m * 16;
                const float rstd = 1.f / sqrtf(ssq[row] * (1.f / D) + EPS);
                float v[8];
#pragma unroll
                for (int e = 0; e < 4; ++e) { v[e] = siluf_(acc[ai][0][m][0][e] * rstd) * (acc[ai][1][m][0][e] * rstd); v[4 + e] = siluf_(acc[ai][0][m][1][e] * rstd) * (acc[ai][1][m][1][e] * rstd); }
                pg8::u32x4 w; w.x = pg8::cvt_pk_bf16(v[0], v[1]); w.y = pg8::cvt_pk_bf16(v[2], v[3]); w.z = pg8::cvt_pk_bf16(v[4], v[5]); w.w = pg8::cvt_pk_bf16(v[6], v[7]);
                *(pg8::u32x4*)(h + (size_t)row * FF + col0) = w; }
    }
};
struct EpiDown {
    static constexpr bool PERM = true, AFTER_DRAIN = false;
    float* out;
    __device__ __forceinline__ void operator()(const pg8::f32x4 (&acc)[2][2][4][2], const pg8::Unit& u, int wr, int wc, int fr, int fq) const {
        const int row0 = u.pm * 256 + wr * 64 + fr, col0 = u.pn * 256 + wc * 32 + 8 * fq;
#pragma unroll
        for (int ai = 0; ai < 2; ++ai)
#pragma unroll
            for (int m = 0; m < 4; ++m) { float* orow = out + (size_t)(row0 + ai * 128 + m * 16) * D + col0;
#pragma unroll
                for (int bj = 0; bj < 2; ++bj) {
                    const pg8::f32x4 a0 = *(const pg8::f32x4*)(orow + bj * 128) + acc[ai][bj][m][0], a1 = *(const pg8::f32x4*)(orow + bj * 128 + 4) + acc[ai][bj][m][1];
                    *(pg8::f32x4*)(orow + bj * 128) = a0; *(pg8::f32x4*)(orow + bj * 128 + 4) = a1; } }
    }
};

__device__ __forceinline__ float wave_sum(float v) {
#pragma unroll
    for (int o = 1; o < 64; o <<= 1) v += __shfl_xor(v, o);
    return v;
}
template <int MODE>
__device__ __forceinline__ void transpose_item(const float* W, int K, int N, bf16* WT, LAS float* scr, int item, int lane) {
    const int nblk = N / 32, kb = item / nblk, nb = item % nblk, k0 = 64 * kb, n0 = 32 * nb;
#pragma unroll 8
    for (int i = 0; i < 32; ++i) { const int kk = 2 * i + (lane >> 5); scr[kk * 33 + (lane & 31)] = W[(size_t)(k0 + kk) * N + n0 + (lane & 31)]; }
    LDS_WAIT(); asm volatile("" ::: "memory");
    const int c = lane & 7;
    const int d0 = MODE == 0 ? n0 : (256 * (n0 / 128) + (n0 % 128) + (MODE == 2 ? 128 : 0));
#pragma unroll
    for (int j = 0; j < 4; ++j) { const int n = (lane >> 3) + 8 * j; const LAS float* s = scr + (8 * c) * 33 + n;
        v4u o; o.x = pk2(s[0 * 33], s[1 * 33]); o.y = pk2(s[2 * 33], s[3 * 33]); o.z = pk2(s[4 * 33], s[5 * 33]); o.w = pk2(s[6 * 33], s[7 * 33]);
        *(v4u*)(WT + (size_t)(d0 + n) * K + k0 + 8 * c) = o; }
    LDS_WAIT(); asm volatile("" ::: "memory");
}
__device__ __forceinline__ void rms_row_to_bf16(const float* xrow, const float* w, bf16* orow, int lane) {
    const f32x4* xr = (const f32x4*)xrow + lane; const f32x4* wr = (const f32x4*)w + lane;
    f32x4 v[4]; float s = 0.f;
#pragma unroll
    for (int j = 0; j < 4; ++j) { v[j] = xr[64 * j]; s += (v[j].x * v[j].x + v[j].y * v[j].y) + (v[j].z * v[j].z + v[j].w * v[j].w); }
    const float rstd = 1.f / sqrtf(wave_sum(s) * (1.f / D) + EPS);
    unsigned long long* o8 = (unsigned long long*)orow + lane;
#pragma unroll
    for (int j = 0; j < 4; ++j) { const f32x4 ww = wr[64 * j]; o8[64 * j] = (unsigned long long)pk2(v[j].x * rstd * ww.x, v[j].y * rstd * ww.y) | ((unsigned long long)pk2(v[j].z * rstd * ww.z, v[j].w * rstd * ww.w) << 32); }
}

struct Args { const float* in[14]; float* out; unsigned char* ws; int ph_lo, ph_hi; };

__device__ __forceinline__ void hgrn_simple(LAS unsigned char* lds, const bf16* Hq, const bf16* Hgf, const bf16* Hgb, const bf16* Hv, float* osum) {
    LAS float* qs = (LAS float*)lds;
    LAS float* fs = qs + 32 * 128;
    LAS float* vs = fs + 32 * 128;
    LAS float* part = vs + 32 * 32;
    const int t = threadIdx.x, c = t & 31, kg = t >> 5;
    for (int item = blockIdx.x; item < 96; item += gridDim.x) {
        const int seq = item >> 4, head = (item >> 2) & 3, dvs = item & 3;
        const int s0 = seq < 4 ? seq * 4096 : MP + (seq - 4) * 8192, len = seq < 4 ? 4096 : 8192;
        for (int dir = 0; dir < 2; ++dir) {
            float S[8];
#pragma unroll
            for (int r = 0; r < 8; ++r) S[r] = 0.f;
            const bf16* G = dir == 0 ? Hgf : Hgb;
            for (int b0 = 0; b0 < len; b0 += 32) {
                { const int i = t >> 4, dk0 = (t & 15) * 8; const int tok = dir == 0 ? b0 + i : len - 1 - (b0 + i);
                  const size_t off = (size_t)(s0 + tok) * GW + head * 128 + dk0;
                  const v4u qw = *(const v4u*)(Hq + off), gw = *(const v4u*)(G + off);
                  LAS float* qd = qs + i * 128 + dk0; LAS float* fd = fs + i * 128 + dk0;
                  qd[0] = bflo(qw.x); qd[1] = bfhi(qw.x); qd[2] = bflo(qw.y); qd[3] = bfhi(qw.y); qd[4] = bflo(qw.z); qd[5] = bfhi(qw.z); qd[6] = bflo(qw.w); qd[7] = bfhi(qw.w);
                  fd[0] = __expf(bflo(gw.x)); fd[1] = __expf(bfhi(gw.x)); fd[2] = __expf(bflo(gw.y)); fd[3] = __expf(bfhi(gw.y)); fd[4] = __expf(bflo(gw.z)); fd[5] = __expf(bfhi(gw.z)); fd[6] = __expf(bflo(gw.w)); fd[7] = __expf(bfhi(gw.w));
                  if (t < 128) { const int i2 = t >> 2, c0 = (t & 3) * 8; const int tok2 = dir == 0 ? b0 + i2 : len - 1 - (b0 + i2);
                      const v4u vw = *(const v4u*)(Hv + (size_t)(s0 + tok2) * GW + head * 128 + dvs * 32 + c0); LAS float* vd = vs + i2 * 32 + c0;
                      vd[0] = bflo(vw.x); vd[1] = bfhi(vw.x); vd[2] = bflo(vw.y); vd[3] = bfhi(vw.y); vd[4] = bflo(vw.z); vd[5] = bfhi(vw.z); vd[6] = bflo(vw.w); vd[7] = bfhi(vw.w); } }
                __syncthreads();
                for (int i = 0; i < 32; ++i) {
                    const float v = vs[i * 32 + c]; float o = 0.f;
#pragma unroll
                    for (int r = 0; r < 8; ++r) { const float f = fs[i * 128 + kg * 8 + r], q = qs[i * 128 + kg * 8 + r]; S[r] = f * S[r] + (1.f - f) * v; o += S[r] * q; }
                    part[(i * 16 + kg) * 32 + c] = o;
                }
                __syncthreads();
#pragma unroll
                for (int k = 0; k < 2; ++k) { const int oi = t + 512 * k, i = oi >> 5, cc = oi & 31; float s = 0.f;
#pragma unroll
                    for (int k2 = 0; k2 < 16; ++k2) s += part[(i * 16 + k2) * 32 + cc];
                    const int tok = dir == 0 ? b0 + i : len - 1 - (b0 + i);
                    float* dst = osum + (size_t)(s0 + tok) * GW + head * 128 + dvs * 32 + cc;
                    if (dir == 0) *dst = s; else *dst += s; }
                __syncthreads();
            }
        }
    }
}
__device__ __forceinline__ void hgrn_finalize_simple(const float* osum, const bf16* Hgate, const float* gnw, bf16* O, int gw, int ngw, int lane) {
    for (int it = gw; it < M * 4; it += ngw) { const int row = it >> 2, head = it & 3;
        const f32x2 o = *(const f32x2*)(osum + (size_t)row * GW + head * 128 + 2 * lane);
        const float r = 1.f / sqrtf(wave_sum(o.x * o.x + o.y * o.y) * (1.f / 128.f) + EPS);
        const unsigned g = *(const unsigned*)(Hgate + (size_t)row * GW + head * 128 + 2 * lane);
        const f32x2 w = *(const f32x2*)(gnw + 2 * lane);
        *(unsigned*)(O + (size_t)row * D + head * 128 + 2 * lane) = pk2(o.x * r * w.x * bflo(g), o.y * r * w.y * bfhi(g)); }
}
__device__ __forceinline__ void na_simple(const bf16* NQ, const bf16* NK, const bf16* NV, const float* qw, const float* kw, const float* rpb, bf16* O, int gid, int nthreads) {
    for (int idx = gid; idx < M * 8; idx += nthreads) {
        const int head = idx & 7, row = idx >> 3;
        const int s0 = row < MP ? (row & ~4095) : MP + ((row - MP) & ~8191), len = row < MP ? 4096 : 8192;
        const int t = row - s0, r = t >> 6, c = t & 63, rows = len >> 6;
        const int rs = min(max(r - 4, 0), rows - 8), wsn = min(max(c - 8, 0), 48);
        float q[64]; float ss = 0.f;
        { const v4u* qp = (const v4u*)(NQ + (size_t)row * GW + head * 64);
#pragma unroll
          for (int j = 0; j < 8; ++j) { const v4u w = qp[j]; q[8*j] = bflo(w.x); q[8*j+1] = bfhi(w.x); q[8*j+2] = bflo(w.y); q[8*j+3] = bfhi(w.y); q[8*j+4] = bflo(w.z); q[8*j+5] = bfhi(w.z); q[8*j+6] = bflo(w.w); q[8*j+7] = bfhi(w.w); } }
#pragma unroll
        for (int d = 0; d < 64; ++d) ss += q[d] * q[d];
        { const float rq = 0.125f / sqrtf(ss * (1.f / 64.f) + EPS);
#pragma unroll
          for (int d = 0; d < 64; ++d) q[d] = q[d] * rq * qw[d] * kw[d]; }
        float mx = -1e30f, l = 0.f; float acc[64];
#pragma unroll
        for (int d = 0; d < 64; ++d) acc[d] = 0.f;
        for (int kr = 0; kr < 8; ++kr)
            for (int kc = 0; kc < 16; ++kc) {
                const int krow = rs + kr, kcol = wsn + kc; const size_t koff = (size_t)(s0 + krow * 64 + kcol) * GW + head * 64;
                const v4u* kp = (const v4u*)(NK + koff); float dot = 0.f, sk = 0.f;
#pragma unroll
                for (int j = 0; j < 8; ++j) { const v4u w = kp[j]; float k0 = bflo(w.x), k1 = bfhi(w.x), k2 = bflo(w.y), k3 = bfhi(w.y), k4 = bflo(w.z), k5 = bfhi(w.z), k6 = bflo(w.w), k7 = bfhi(w.w);
                    dot += q[8*j] * k0 + q[8*j+1] * k1 + q[8*j+2] * k2 + q[8*j+3] * k3 + q[8*j+4] * k4 + q[8*j+5] * k5 + q[8*j+6] * k6 + q[8*j+7] * k7;
                    sk += k0 * k0 + k1 * k1 + k2 * k2 + k3 * k3 + k4 * k4 + k5 * k5 + k6 * k6 + k7 * k7; }
                const float s = dot / sqrtf(sk * (1.f / 64.f) + EPS) + rpb[head * 465 + (krow - r + 7) * 31 + (kcol - c + 15)];
                const float mn = fmaxf(mx, s), a = __expf(mx - mn), p = __expf(s - mn);
                l = l * a + p; mx = mn;
                const v4u* vp = (const v4u*)(NV + koff);
#pragma unroll
                for (int j = 0; j < 8; ++j) { const v4u w = vp[j];
                    acc[8*j] = acc[8*j] * a + p * bflo(w.x); acc[8*j+1] = acc[8*j+1] * a + p * bfhi(w.x); acc[8*j+2] = acc[8*j+2] * a + p * bflo(w.y); acc[8*j+3] = acc[8*j+3] * a + p * bfhi(w.y);
                    acc[8*j+4] = acc[8*j+4] * a + p * bflo(w.z); acc[8*j+5] = acc[8*j+5] * a + p * bfhi(w.z); acc[8*j+6] = acc[8*j+6] * a + p * bflo(w.w); acc[8*j+7] = acc[8*j+7] * a + p * bfhi(w.w); }
            }
        const float il = 1.f / l; v4u* op = (v4u*)(O + (size_t)row * D + GW + head * 64);
#pragma unroll
        for (int j = 0; j < 8; ++j) { v4u w; w.x = pk2(acc[8*j] * il, acc[8*j+1] * il); w.y = pk2(acc[8*j+2] * il, acc[8*j+3] * il); w.z = pk2(acc[8*j+4] * il, acc[8*j+5] * il); w.w = pk2(acc[8*j+6] * il, acc[8*j+7] * il); op[j] = w; }
    }
}

constexpr int N_PHASES = 8;
__global__ void __launch_bounds__(NWAVES * 64, 2) fwd_kernel(Args args) {
    extern __shared__ __attribute__((aligned(16))) unsigned char lds_raw[];
    LAS unsigned char* lds = (LAS unsigned char*)lds_raw;
    volatile LAS unsigned* MISC = (volatile LAS unsigned*)(lds + MISC_OFF);
    const int tid = threadIdx.x, lane = tid & 63, wave = __builtin_amdgcn_readfirstlane(tid >> 6);
    const int G = gridDim.x; const int bx = blockIdx.x; const int vcu = (G % 8 == 0) ? (bx % 8) * (G / 8) + bx / 8 : bx;
    unsigned char* ws = args.ws;
    unsigned* ctl = (unsigned*)(ws + WS_CTL);
    const float* xp = args.in[0]; const float* xs = args.in[1]; const float* w_mix = args.in[2]; const float* w_in = args.in[3]; const float* lbp = args.in[4];
    const float* gnw = args.in[5]; const float* qnw = args.in[6]; const float* knw = args.in[7]; const float* rpb = args.in[8]; const float* w_out = args.in[9];
    const float* w_ffn = args.in[10]; const float* w_gate = args.in[11]; const float* w_up = args.in[12]; const float* w_down = args.in[13];
    float* out = args.out;
    bf16* Wgu_t = (bf16*)(ws + WS_WGU); bf16* Win_t = (bf16*)(ws + WS_WIN); bf16* Wout_t = (bf16*)(ws + WS_WOUT); bf16* Wdown_t = (bf16*)(ws + WS_WDOWN);
    bf16* XN = (bf16*)(ws + WS_A); float* osum = (float*)(ws + WS_A); bf16* Hb = (bf16*)(ws + WS_H); bf16* Ob = (bf16*)(ws + WS_O);
    bf16* XN2 = (bf16*)(ws + WS_XN2); bf16* HFF = (bf16*)(ws + WS_HFF); bf16* NAb = (bf16*)out; float* ssq = (float*)(ctl + CW_SSQ);
    for (int u = tid; u < (LDS_BYTES - LDSCTL_OFF) / 4; u += NWAVES * 64) ((LAS unsigned*)(lds + LDSCTL_OFF))[u] = 0u;
    __syncthreads();
    const int lo = args.ph_lo, hi = args.ph_hi;
    XcdBarrier bar; bar.bar = ctl + CW_BAR; bar.x = 0; bar.st = nullptr;
    if (hi - lo > 1) bar = xcd_barrier_post(ctl + CW_BAR, MISC + 8);
#define IN(k) (lo <= (k) && (k) < hi)
#define SEAM(k) do { if (IN(k) && IN((k) + 1)) xcd_barrier(bar); } while (0)
    const int gw = vcu * NWAVES + wave, NGW = G * NWAVES;

    if (IN(0)) {
        LAS float* scr = (LAS float*)(lds + RING_OFF + wave * 16384);
        constexpr int I_IN = (D / 64) * (INC / 32), I_OUT = (D / 64) * (D / 32), I_G = (D / 64) * (FF / 32);
        constexpr int NITEMS = I_IN + I_OUT + 2 * I_G;
        for (int it = gw; it < NITEMS; it += NGW) {
            int r = it;
            if (r < I_IN) { transpose_item<0>(w_in, D, INC, Win_t, scr, r, lane); continue; } r -= I_IN;
            if (r < I_OUT) { transpose_item<0>(w_out, D, D, Wout_t, scr, r, lane); continue; } r -= I_OUT;
            if (r < I_G) { transpose_item<1>(w_gate, D, FF, Wgu_t, scr, r, lane); continue; } r -= I_G;
            transpose_item<2>(w_up, D, FF, Wgu_t, scr, r, lane);
        }
        for (int m = gw; m < M; m += NGW) rms_row_to_bf16(m < MP ? xp + (size_t)m * D : xs + (size_t)(m - MP) * D, w_mix, XN + (size_t)m * D, lane);
    }
    SEAM(0);
    if (IN(1)) {
        pg8::Gemm g{XN, Win_t, M, INC, D}; pg8::StaticOrder S; S.init(M, INC, G, bx);
        EpiInProj E{Hb, NAb, lbp};
        pg8::gemm_phase<EpiInProj, pg8::StaticOrder, true, true>(lds + RING_OFF, g, S, E);
    }
    SEAM(1);
    if (IN(2)) hgrn_simple(lds, Hb, Hb + (size_t)M * GW, Hb + 2 * (size_t)M * GW, Hb + 3 * (size_t)M * GW, osum);
    SEAM(2);
    if (IN(3)) {
        hgrn_finalize_simple(osum, Hb + 4 * (size_t)M * GW, gnw, Ob, gw, NGW, lane);
        na_simple(NAb, NAb + (size_t)M * GW, NAb + 2 * (size_t)M * GW, qnw, knw, rpb, Ob, bx * (NWAVES * 64) + tid, G * NWAVES * 64);
    }
    SEAM(3);
    if (IN(4)) {
        pg8::Gemm g{Ob, Wout_t, M, D, D}; pg8::StaticOrder S; S.init(M, D, G, bx);
        EpiOutProj E{xp, xs, out, XN2, w_ffn, ssq};
        pg8::gemm_phase<EpiOutProj, pg8::StaticOrder, true, true>(lds + RING_OFF, g, S, E);
    }
    SEAM(4);
    if (IN(5)) {
        pg8::Gemm g{XN2, Wgu_t, M, 2 * FF, D}; pg8::StaticOrder S; S.init(M, 2 * FF, G, bx);
        EpiGateUp E{HFF, ssq};
        pg8::gemm_phase<EpiGateUp, pg8::StaticOrder, true, true>(lds + RING_OFF, g, S, E);
    }
    SEAM(5);
    if (IN(6)) {
        LAS float* scr = (LAS float*)(lds + RING_OFF + wave * 16384);
        constexpr int I_D = (FF / 64) * (D / 32);
        for (int it = gw; it < I_D; it += NGW) transpose_item<0>(w_down, FF, D, Wdown_t, scr, it, lane);
    }
    SEAM(6);
    if (IN(7)) {
        pg8::Gemm g{HFF, Wdown_t, M, D, FF}; pg8::StaticOrder S; S.init(M, D, G, bx);
        EpiDown E{out};
        pg8::gemm_phase<EpiDown, pg8::StaticOrder, true, true>(lds + RING_OFF, g, S, E);
    }
#undef IN
#undef SEAM
}

#ifndef N_LAUNCHES
#define N_LAUNCHES 8
#endif
extern "C" void kernel_launch(void* const* d_in, const int* in_sizes, int n_in, void* d_out, int out_size, void* d_ws, size_t ws_size, hipStream_t stream) {
    static int grid = 0;
    if (grid == 0) {
        if (n_in != 14 || out_size != 2 * MP * D || ws_size < WS_END) { fprintf(stderr, "kernel_launch: unexpected shapes (n_in %d out %d ws %zu)\n", n_in, out_size, ws_size); grid = -1; return; }
        int dev = 0, cus = 0;
        if (hipGetDevice(&dev) != hipSuccess || hipDeviceGetAttribute(&cus, hipDeviceAttributeMultiprocessorCount, dev) != hipSuccess) { grid = -1; return; }
        if (hipFuncSetAttribute((const void*)fwd_kernel, hipFuncAttributeMaxDynamicSharedMemorySize, LDS_BYTES) != hipSuccess) { fprintf(stderr, "kernel_launch: hipFuncSetAttribute failed\n"); grid = -1; return; }
        grid = cus;
    }
    if (grid < 0) return;
    (void)hipMemsetAsync((char*)d_ws + WS_CTL, 0, CTL_ZERO_BYTES, stream);
    Args a{};
    for (int i = 0; i < 14; ++i) a.in[i] = (const float*)d_in[i];
    a.out = (float*)d_out; a.ws = (unsigned char*)d_ws;
    if (N_LAUNCHES == 1) { a.ph_lo = 0; a.ph_hi = N_PHASES; hipLaunchKernelGGL(fwd_kernel, dim3(grid), dim3(NWAVES * 64), LDS_BYTES, stream, a); }
    else for (int p = 0; p < N_PHASES; ++p) { a.ph_lo = p; a.ph_hi = p + 1; hipLaunchKernelGGL(fwd_kernel, dim3(grid), dim3(NWAVES * 64), LDS_BYTES, stream, a); }
}
```

```cpp
#include <hip/hip_runtime.h>
#include <cstdio>
#include <cstdint>
namespace pg8 {
#define PG8_LAS __attribute__((address_space(3)))
typedef unsigned short bf16_t;
typedef short bf16x8 __attribute__((ext_vector_type(8)));
typedef float f32x4 __attribute__((ext_vector_type(4)));
typedef unsigned u32x4 __attribute__((ext_vector_type(4)));
constexpr int BM = 256, BK = 64, HALF = 128, HTB = HALF * BK * 2  , STAGE_BYTES = 8 * HTB, NXCD = 8, WGM = 8;

__host__ __device__ __forceinline__ int lds_byte(int r, int c) { const int st = (r >> 4) * 2 + (c >> 5), rr = r & 15, cc = c & 31, ob = rr * 64 + cc * 2; return st * 1024 + (ob ^ (((ob >> 9) & 1) << 5)); }
__host__ __device__ __forceinline__ void stage_rc(int b, int& R, int& C) { const int st = b / 1024, sb = b % 1024, swz = sb ^ (((sb >> 9) & 1) << 5); R = (st >> 1) * 16 + swz / 64; C = (st & 1) * 32 + (swz % 64) / 2; }
__host__ __device__ __forceinline__ int perm32(int rho) { const int n = rho >> 4, i = rho & 15; return 8 * (i >> 2) + 4 * n + (i & 3); }

struct Unit { int pm, pn; };
struct Gemm { const bf16_t* A; const bf16_t* Bt; int M, N, K; };

struct StaticOrder {
    int nM, nN, nwg, G, c;
    __host__ __device__ void init(int M, int N, int G_, int c_) { nM = M / BM; nN = N / BM; nwg = nM * nN; G = G_; c = c_; }
    __host__ __device__ bool next(int i, Unit& u) const {
        const long L = (long)i * G + c; if (L >= nwg) return false;
        int wgid = (int)L; { const int q = nwg / NXCD, r = nwg % NXCD, xcd = wgid % NXCD, off = wgid / NXCD; wgid = (xcd < r ? xcd * (q + 1) : r * (q + 1) + (xcd - r) * q) + off; }
        const int nig = WGM * nN, gid = wgid / nig, fm = gid * WGM, gsz = (nM - fm) < WGM ? (nM - fm) : WGM;
        u.pm = fm + ((wgid % nig) % gsz); u.pn = (wgid % nig) / gsz; return true;
    }
    __device__ __forceinline__ void a_ready(const Unit&) const {}
    __device__ __forceinline__ void done(const Unit&) const {}
};

__device__ __forceinline__ unsigned cvt_pk_bf16(float lo, float hi) { unsigned r; asm volatile("v_cvt_pk_bf16_f32 %0, %1, %2" : "=v"(r) : "v"(lo), "v"(hi)); return r; }
template <class Epi, class Sched, bool ALIGN_EPI = false, bool SP2 = false>
__device__ __forceinline__ void gemm_phase(PG8_LAS unsigned char* lds, const Gemm g, const Sched& S, const Epi& E) {
    const int tid = threadIdx.x, wid = __builtin_amdgcn_readfirstlane(tid >> 6), lane = tid & 63, wr = wid >> 2, wc = wid & 3, fr = lane & 15, fq = lane >> 4;
    const int K = g.K, nt = K / BK;
    unsigned voffA[2], voffB[2];
#pragma unroll
    for (int i = 0; i < 2; ++i) { int R, C; stage_rc(tid * 16 + i * 8192, R, C); const int Rb = Epi::PERM ? ((R & ~31) + perm32(R & 31)) : R;
        voffA[i] = (unsigned)(R * K + C) * 2u; voffB[i] = (unsigned)(Rb * K + C) * 2u; }
    const size_t kstep = (size_t)(BK * 2);
    const size_t hstep = (size_t)HALF * K * 2;
    const size_t tstep = 2 * hstep;
    const unsigned ldsw = (unsigned)wid * 1024u;
    const int aoff = lds_byte(wr * 64 + fr, fq * 8), boff = lds_byte(wc * 32 + fr, fq * 8);
#define PG8_SA(b, h) (((b) * 2 + (h)) * HTB)
#define PG8_SB(b, h) ((4 + (b) * 2 + (h)) * HTB)
#define PG8_STAGE(bufoff, gbase, voff) do { _Pragma("unroll") for (int _i = 0; _i < 2; ++_i) \
        __builtin_amdgcn_global_load_lds((const unsigned*)((const char*)(gbase) + (voff)[_i]), (PG8_LAS unsigned*)(lds + (bufoff) + ldsw + _i * 8192), 16, 0, 0); } while (0)
#define PG8_LDA(dst, b, h) do { _Pragma("unroll") for (int m = 0; m < 4; ++m) _Pragma("unroll") for (int k = 0; k < 2; ++k) dst[m][k] = *(const PG8_LAS bf16x8*)(lds + PG8_SA(b, h) + aoff + m * 2048 + k * 1024); } while (0)
#define PG8_LDB(dst, b, h) do { _Pragma("unroll") for (int n = 0; n < 2; ++n) _Pragma("unroll") for (int k = 0; k < 2; ++k) dst[n][k] = *(const PG8_LAS bf16x8*)(lds + PG8_SB(b, h) + boff + n * 2048 + k * 1024); } while (0)
#define PG8_MMA(ai, bj, At, Bt) do { __builtin_amdgcn_s_setprio(1); _Pragma("unroll") for (int m = 0; m < 4; ++m) _Pragma("unroll") for (int n = 0; n < 2; ++n) _Pragma("unroll") for (int k = 0; k < 2; ++k) \
        acc[ai][bj][m][n] = __builtin_amdgcn_mfma_f32_16x16x32_bf16(Bt[n][k], At[m][k], acc[ai][bj][m][n], 0, 0, 0); __builtin_amdgcn_s_setprio(0); } while (0)
#define PG8_WAIT_V(n) asm volatile("s_waitcnt vmcnt(" #n ")" ::: "memory")
#define PG8_WAIT_L(n) asm volatile("s_waitcnt lgkmcnt(" #n ")" ::: "memory")
#define PG8_BAR __builtin_amdgcn_s_barrier()
#define PG8_SCHED __builtin_amdgcn_sched_barrier(0)
    Unit cur, nxt; int ui = 0;
    if (!S.next(0, cur)) return;
    f32x4 acc[2][2][4][2];
#pragma unroll
    for (int a = 0; a < 2; ++a)
#pragma unroll
        for (int b = 0; b < 2; ++b)
#pragma unroll
            for (int m = 0; m < 4; ++m)
#pragma unroll
                for (int n = 0; n < 2; ++n) acc[a][b][m][n] = (f32x4){0.f, 0.f, 0.f, 0.f};
    bf16x8 At[4][2], B0[2][2], B1[2][2];
    const char* cA = (const char*)g.A + (size_t)cur.pm * tstep; const char* cB = (const char*)g.Bt + (size_t)cur.pn * tstep;
    S.a_ready(cur);
    if constexpr (SP2) {
        PG8_STAGE(PG8_SB(0, 0), cB, voffB); PG8_STAGE(PG8_SB(0, 1), cB + hstep, voffB); PG8_STAGE(PG8_SA(0, 0), cA, voffA); PG8_STAGE(PG8_SA(0, 1), cA + hstep, voffA);
        if (wr == 1) PG8_BAR;
        PG8_WAIT_V(2); PG8_BAR;
        PG8_STAGE(PG8_SB(1, 0), cB + kstep, voffB); PG8_STAGE(PG8_SA(1, 0), cA + kstep, voffA); PG8_STAGE(PG8_SB(1, 1), cB + hstep + kstep, voffB);
        PG8_WAIT_V(6); PG8_BAR;
    } else {
        PG8_STAGE(PG8_SB(0, 0), cB, voffB); PG8_STAGE(PG8_SA(0, 0), cA, voffA); PG8_STAGE(PG8_SB(0, 1), cB + hstep, voffB); PG8_STAGE(PG8_SA(0, 1), cA + hstep, voffA);
        if (wr == 1) PG8_BAR;
        PG8_WAIT_V(4); PG8_BAR;
        PG8_STAGE(PG8_SB(1, 0), cB + kstep, voffB); PG8_STAGE(PG8_SA(1, 0), cA + kstep, voffA); PG8_STAGE(PG8_SB(1, 1), cB + hstep + kstep, voffB);
        PG8_WAIT_V(6); PG8_BAR;
    }
    for (;;) {
        const bool has_next = S.next(ui + 1, nxt);
        const char* nA = has_next ? (const char*)g.A + (size_t)nxt.pm * tstep : cA; const char* nB = has_next ? (const char*)g.Bt + (size_t)nxt.pn * tstep : cB;
        for (int t = 0; t < nt; t += 2) {
            const bool last = (t == nt - 2);
            const char* a1 = cA + (size_t)(t + 1) * kstep;
            const char* a2 = last ? nA : cA + (size_t)(t + 2) * kstep; const char* b2 = last ? nB : cB + (size_t)(t + 2) * kstep;
            const char* a3 = a2 + kstep; const char* b3 = b2 + kstep;
            if (last && has_next) S.a_ready(nxt);
            if constexpr (SP2) {
            PG8_LDB(B0, 0, 0); PG8_LDB(B1, 0, 1); PG8_SCHED; PG8_LDA(At, 0, 0); PG8_STAGE(PG8_SA(1, 1), a1 + hstep, voffA);
            PG8_WAIT_V(8); PG8_WAIT_L(0); PG8_BAR; PG8_MMA(0, 0, At, B0); PG8_MMA(0, 1, At, B1); PG8_BAR; PG8_SCHED;
            PG8_LDA(At, 0, 1); PG8_STAGE(PG8_SB(0, 0), b2, voffB); PG8_STAGE(PG8_SB(0, 1), b2 + hstep, voffB); PG8_STAGE(PG8_SA(0, 0), a2, voffA);
            PG8_WAIT_V(8); PG8_WAIT_L(0); PG8_BAR; PG8_MMA(1, 0, At, B0); PG8_MMA(1, 1, At, B1); PG8_BAR; PG8_SCHED;
            PG8_LDB(B0, 1, 0); PG8_LDB(B1, 1, 1); PG8_SCHED; PG8_LDA(At, 1, 0); PG8_STAGE(PG8_SA(0, 1), a2 + hstep, voffA);
            PG8_WAIT_V(8); PG8_WAIT_L(0); PG8_BAR; PG8_MMA(0, 0, At, B0); PG8_MMA(0, 1, At, B1); PG8_BAR; PG8_SCHED;
            PG8_LDA(At, 1, 1); PG8_STAGE(PG8_SB(1, 0), b3, voffB); PG8_STAGE(PG8_SB(1, 1), b3 + hstep, voffB); PG8_STAGE(PG8_SA(1, 0), a3, voffA);
            PG8_WAIT_V(8); PG8_WAIT_L(0); PG8_BAR; PG8_MMA(1, 0, At, B0); PG8_MMA(1, 1, At, B1); PG8_BAR; PG8_SCHED;
            } else {
            PG8_LDB(B0, 0, 0); PG8_SCHED; PG8_LDA(At, 0, 0); PG8_STAGE(PG8_SA(1, 1), a1 + hstep, voffA);
            PG8_WAIT_L(8); PG8_BAR; PG8_WAIT_L(0); PG8_MMA(0, 0, At, B0); PG8_BAR; PG8_SCHED;
            PG8_LDB(B1, 0, 1); PG8_STAGE(PG8_SB(0, 0), b2, voffB);
            PG8_BAR; PG8_WAIT_L(0); PG8_MMA(0, 1, At, B1); PG8_BAR;
            PG8_LDA(At, 0, 1); PG8_STAGE(PG8_SA(0, 0), a2, voffA);
            PG8_BAR; PG8_WAIT_L(0); PG8_MMA(1, 0, At, B0); PG8_BAR; PG8_SCHED;
            PG8_STAGE(PG8_SB(0, 1), b2 + hstep, voffB);
            PG8_WAIT_V(6); PG8_BAR; PG8_MMA(1, 1, At, B1); PG8_BAR;
            PG8_LDB(B0, 1, 0); PG8_SCHED; PG8_LDA(At, 1, 0); PG8_STAGE(PG8_SA(0, 1), a2 + hstep, voffA);
            PG8_WAIT_L(8); PG8_BAR; PG8_WAIT_L(0); PG8_MMA(0, 0, At, B0); PG8_BAR; PG8_SCHED;
            PG8_LDB(B1, 1, 1); PG8_STAGE(PG8_SB(1, 0), b3, voffB);
            PG8_BAR; PG8_WAIT_L(0); PG8_MMA(0, 1, At, B1); PG8_BAR;
            PG8_LDA(At, 1, 1); PG8_STAGE(PG8_SA(1, 0), a3, voffA);
            PG8_BAR; PG8_WAIT_L(0); PG8_MMA(1, 0, At, B0); PG8_BAR; PG8_SCHED;
            PG8_STAGE(PG8_SB(1, 1), b3 + hstep, voffB);
            PG8_WAIT_V(6); PG8_BAR; PG8_MMA(1, 1, At, B1); PG8_BAR;
            }
        }
        if constexpr (ALIGN_EPI) { if (wr == 0) PG8_BAR; }
        if constexpr (!Epi::AFTER_DRAIN) { E(acc, cur, wr, wc, fr, fq); S.done(cur); }
        if (!has_next) break;
#pragma unroll
        for (int a = 0; a < 2; ++a)
#pragma unroll
            for (int b = 0; b < 2; ++b)
#pragma unroll
                for (int m = 0; m < 4; ++m)
#pragma unroll
                    for (int n = 0; n < 2; ++n) acc[a][b][m][n] = (f32x4){0.f, 0.f, 0.f, 0.f};
        cur = nxt; cA = nA; cB = nB; ++ui;
        if constexpr (ALIGN_EPI) { if (wr == 1) PG8_BAR; }
    }
    PG8_WAIT_V(0);
    if constexpr (!ALIGN_EPI) { if (wr == 0) PG8_BAR; }
    PG8_BAR;
    if constexpr (Epi::AFTER_DRAIN) { E.fused(acc, cur, wr, wc, fr, fq, lds, wid, lane); S.done(cur); }
#undef PG8_SA
#undef PG8_SB
#undef PG8_STAGE
#undef PG8_LDA
#undef PG8_LDB
#undef PG8_MMA
#undef PG8_WAIT_V
#undef PG8_WAIT_L
#undef PG8_BAR
#undef PG8_SCHED
}
}

#ifndef PROBE
#define PROBE -1
#endif

constexpr int NWAVES = 8;
constexpr int M = 32768, MP = 16384, D = 1024, INC = 4096, FF = 2816, GW = 512;
constexpr float EPS = 1e-6f;
constexpr size_t MiB = 1u << 20;
constexpr size_t WS_CTL = 0, CTL_BYTES = 1 * MiB, CTL_ZERO_BYTES = 32768;
constexpr size_t WS_WIN = 1 * MiB;
constexpr size_t WS_WOUT = 9 * MiB;
constexpr size_t WS_WGU = 11 * MiB;
constexpr size_t WS_WDOWN = 22 * MiB;
constexpr size_t WS_A = 28 * MiB;
constexpr size_t WS_O = 92 * MiB;
constexpr size_t WS_H = 156 * MiB;
constexpr size_t WS_SL = 316 * MiB;
constexpr size_t WS_SF = 332 * MiB;
constexpr size_t WS_X1 = 340 * MiB;
constexpr size_t WS_HFF = WS_H;
constexpr size_t WS_END = 404 * MiB;
static_assert(WS_HFF + (size_t)M * FF * 2 <= WS_SF && WS_SL + 16 * MiB <= WS_SF, "ws map");
constexpr int CW_BAR = 4096;
constexpr int CW_LB = 0;
constexpr int CW_NONCANON = 3072;
constexpr int CW_TB = 2048;
constexpr int CW_P5DONE = 3264;
constexpr int CW_P6DONE = 3328;
constexpr int CW_NADONE = 3200;
constexpr int CW_XMAP = 3136;
constexpr int CW_SSQ = 65536;
constexpr int CW_BT = 131072;
static_assert((CW_SSQ + M) <= CW_BT && (CW_BT + 256 * 128) * 4 <= (int)CTL_BYTES && (CW_BAR + 3456) * 4 <= (int)CTL_ZERO_BYTES, "ctl");
constexpr int RING_OFF = 0, RING_BYTES = 131072;
constexpr int LDS_BYTES = 163840;
constexpr int LDSCTL_OFF = 159744, MISC_OFF = LDSCTL_OFF + 320;

#define GAS __attribute__((address_space(1)))
#define LAS __attribute__((address_space(3)))
typedef unsigned short bf16;
typedef unsigned v4u __attribute__((ext_vector_type(4)));
typedef unsigned v2u __attribute__((ext_vector_type(2)));
typedef float f32x4 __attribute__((ext_vector_type(4)));
typedef float f32x2 __attribute__((ext_vector_type(2)));
#define LDS_WAIT() asm volatile("s_waitcnt lgkmcnt(0)" ::: "memory")
#define VM_WAIT() asm volatile("s_waitcnt vmcnt(0)" ::: "memory")
__device__ __forceinline__ unsigned f2bf(float f) { unsigned u = __builtin_bit_cast(unsigned, f); return (u + 0x7fffu + ((u >> 16) & 1u)) >> 16; }
__device__ __forceinline__ unsigned pk2(float lo, float hi) { return f2bf(lo) | (f2bf(hi) << 16); }
__device__ __forceinline__ float bflo(unsigned w) { return __builtin_bit_cast(float, w << 16); }
__device__ __forceinline__ float bfhi(unsigned w) { return __builtin_bit_cast(float, w & 0xffff0000u); }
typedef float f32x2_t __attribute__((ext_vector_type(2))); typedef __bf16 bf16x2_t __attribute__((ext_vector_type(2)));
__device__ __forceinline__ unsigned cvtpk(float lo, float hi) { f32x2_t v = {lo, hi}; bf16x2_t b = __builtin_convertvector(v, bf16x2_t); return __builtin_bit_cast(unsigned, b); }
__device__ __forceinline__ float ex2_(float x) { return __builtin_amdgcn_exp2f(x); }
__device__ __forceinline__ float rcp_(float x) { return __builtin_amdgcn_rcpf(x); }
__device__ __forceinline__ float rsq_(float x) { return __builtin_amdgcn_rsqf(x); }
template <int CTRL> __device__ __forceinline__ float dpp_(float v) { return __builtin_bit_cast(float, __builtin_amdgcn_update_dpp(0, __builtin_bit_cast(int, v), CTRL, 0xF, 0xF, false)); }
__device__ __forceinline__ float sum8_(float v) { v += dpp_<0xB1>(v); v += dpp_<0x4E>(v); v += dpp_<0x141>(v); return v; }
__device__ __forceinline__ float sum16_(float v) { v = sum8_(v); v += dpp_<0x140>(v); return v; }
__device__ __forceinline__ float sigmoidf_(float x) { return rcp_(1.f + ex2_(-1.44269504089f * x)); }
__device__ __forceinline__ float siluf_(float x) { return x * rcp_(1.f + ex2_(-1.44269504089f * x)); }

#define XB_TMO      128
#define XB_XCNT(j)  (256  + 64 * (j))
#define XB_XSUB(j)  (1280 + 64 * (j))
#define XB_XGEN(j)  (2304 + 64 * (j))
#define XB_TOP      3328
#define XB_TOPGEN   3392
#define XCD_BAR_WORDS 3456
#define XB_SPIN_CAP (1u << 18)
__device__ __forceinline__ unsigned xb_ld(unsigned* p)              { return __hip_atomic_load(p, __ATOMIC_RELAXED, __HIP_MEMORY_SCOPE_AGENT); }
__device__ __forceinline__ unsigned xb_add(unsigned* p, unsigned v) { return __hip_atomic_fetch_add(p, v, __ATOMIC_RELAXED, __HIP_MEMORY_SCOPE_AGENT); }
__device__ __forceinline__ unsigned xb_xcc_id() { return (unsigned)__builtin_amdgcn_s_getreg((3 << 11) | 20) & 0xFu; }
#define XB_SPIN(cond, bar) do { unsigned _sp = 0; while (cond) { __builtin_amdgcn_s_sleep(1); \
    if ((++_sp & 255u) == 0u) { if (xb_ld(&(bar)[XB_TMO])) break; if (_sp > XB_SPIN_CAP) { atomicAdd(&(bar)[XB_TMO], 1u); break; } } } } while (0)
struct XcdBarrier { unsigned* bar; unsigned x; volatile LAS unsigned* st; };
__device__ __forceinline__ XcdBarrier xcd_barrier_post(unsigned* bar, volatile LAS unsigned* st) {
    XcdBarrier b; b.bar = bar; b.x = xb_xcc_id(); b.st = st;
    if (threadIdx.x == 0) (void)xb_add(&bar[XB_XCNT(b.x)], 1u);
    return b;
}
__device__ __forceinline__ void xcd_barrier_complete(unsigned* bar, unsigned x, unsigned& nloc, unsigned& nx) {
    const unsigned G = gridDim.x * gridDim.y * gridDim.z;
    unsigned sum, cnt, mine, sp = 0u;
    for (;;) {
        sum = 0u; cnt = 0u; mine = 0u;
#pragma unroll
        for (unsigned j = 0; j < 16; ++j) { const unsigned c = xb_ld(&bar[XB_XCNT(j)]); sum += c; cnt += (c > 0u) ? 1u : 0u; mine = (j == x) ? c : mine; }
        if (sum == G) break;
        __builtin_amdgcn_s_sleep(1);
        if ((++sp & 255u) == 0u) { if (xb_ld(&bar[XB_TMO])) break; if (sp > XB_SPIN_CAP) { atomicAdd(&bar[XB_TMO], 1u); break; } }
    }
    nloc = mine > 0u ? mine : 1u; nx = cnt > 0u ? cnt : 1u;
}
__device__ __forceinline__ void xcd_barrier(const XcdBarrier& b) {
    asm volatile("s_waitcnt vmcnt(0)" ::: "memory");
    __syncthreads();
    if (threadIdx.x == 0) {
        unsigned* bar = b.bar;
        __builtin_amdgcn_s_waitcnt(0);
        unsigned nloc = b.st[0], nx = b.st[1];
        if (nloc == 0u) { xcd_barrier_complete(bar, b.x, nloc, nx); b.st[0] = nloc; b.st[1] = nx; }
        const unsigned old = xb_add(&bar[XB_XSUB(b.x)], 1u);
        const unsigned gen = old / nloc;
        if (old + 1u == (gen + 1u) * nloc) {
            __builtin_amdgcn_fence(__ATOMIC_RELEASE, "agent");
            asm volatile("s_waitcnt vmcnt(0)" ::: "memory");
            const unsigned og = xb_add(&bar[XB_TOP], 1u);
            const unsigned tg = og / nx;
            if (og + 1u == (tg + 1u) * nx) xb_add(&bar[XB_TOPGEN], 1u);
            else XB_SPIN(xb_ld(&bar[XB_TOPGEN]) == tg, bar);
            __builtin_amdgcn_fence(__ATOMIC_ACQUIRE, "agent");
            xb_add(&bar[XB_XGEN(b.x)], 1u);
            asm volatile("s_waitcnt vmcnt(0)" ::: "memory");
        } else {
            XB_SPIN(xb_ld(&bar[XB_XGEN(b.x)]) == gen, bar);
            __builtin_amdgcn_fence(__ATOMIC_ACQUIRE, "agent");
            asm volatile("s_waitcnt vmcnt(0)" ::: "memory");
        }
    }
    __syncthreads();
}

__device__ __forceinline__ unsigned xcd_barrier_arrive(const XcdBarrier& b) {
    unsigned gen = 0u;
    asm volatile("s_waitcnt vmcnt(0)" ::: "memory");
    __syncthreads();
    if (threadIdx.x == 0) {
        unsigned* bar = b.bar;
        __builtin_amdgcn_s_waitcnt(0);
        unsigned nloc = b.st[0], nx = b.st[1];
        if (nloc == 0u) { xcd_barrier_complete(bar, b.x, nloc, nx); b.st[0] = nloc; b.st[1] = nx; }
        const unsigned old = xb_add(&bar[XB_XSUB(b.x)], 1u);
        gen = old / nloc;
        if (old + 1u == (gen + 1u) * nloc) {
            __builtin_amdgcn_fence(__ATOMIC_RELEASE, "agent");
            asm volatile("s_waitcnt vmcnt(0)" ::: "memory");
            const unsigned og = xb_add(&bar[XB_TOP], 1u);
            const unsigned tg = og / nx;
            if (og + 1u == (tg + 1u) * nx) xb_add(&bar[XB_TOPGEN], 1u);
            xb_add(&bar[XB_XGEN(b.x)], 1u);
        }
    }
    return gen;
}
__device__ __forceinline__ void xcd_barrier_poll(const XcdBarrier& b, unsigned gen) {
    if (threadIdx.x == 0) { unsigned* bar = b.bar; XB_SPIN(xb_ld(&bar[XB_TOPGEN]) == gen, bar); }
}
__device__ __forceinline__ void xcd_barrier_wait(const XcdBarrier& b, unsigned gen) {
    if (threadIdx.x == 0) {
        unsigned* bar = b.bar;
        XB_SPIN(xb_ld(&bar[XB_TOPGEN]) == gen, bar);
        __builtin_amdgcn_fence(__ATOMIC_ACQUIRE, "agent");
        asm volatile("s_waitcnt vmcnt(0)" ::: "memory");
    }
    __syncthreads();
}

#define XL_SUB(j) (CW_LB + 64 * (j))
#define XL_GEN(j) (CW_LB + 1024 + 64 * (j))
__device__ __forceinline__ unsigned lb_arrive(const XcdBarrier& b, unsigned* ctl) {
    unsigned gen = 0u;
    asm volatile("s_waitcnt vmcnt(0)" ::: "memory");
    __syncthreads();
    if (threadIdx.x == 0) {
        __builtin_amdgcn_s_waitcnt(0);
        const unsigned nloc = b.st[0];
        const unsigned old = xb_add(&ctl[XL_SUB(b.x)], 1u);
        gen = old / nloc;
        if (old + 1u == (gen + 1u) * nloc) xb_add(&ctl[XL_GEN(b.x)], 1u);
    }
    return gen;
}
__device__ __forceinline__ void lb_wait(const XcdBarrier& b, unsigned* ctl, unsigned gen) {
    if (threadIdx.x == 0) {
        XB_SPIN(xb_ld(&ctl[XL_GEN(b.x)]) == gen, b.bar);
        __builtin_amdgcn_fence(__ATOMIC_ACQUIRE, "agent");
        asm volatile("s_waitcnt vmcnt(0)" ::: "memory");
    }
    __syncthreads();
}

__device__ __forceinline__ void team_barrier(unsigned* cnt, unsigned gen, unsigned* tmo) {
    asm volatile("s_waitcnt vmcnt(0)" ::: "memory");
    __syncthreads();
    if (threadIdx.x == 0) {
        __builtin_amdgcn_s_waitcnt(0);
        (void)xb_add(cnt, 1u);
        XB_SPIN(xb_ld(cnt) < 4u * (gen + 1u), tmo - XB_TMO);
        __builtin_amdgcn_fence(__ATOMIC_ACQUIRE, "agent");
        asm volatile("s_waitcnt vmcnt(0)" ::: "memory");
    }
    __syncthreads();
}

struct EpiInProj {
    static constexpr bool PERM = true, AFTER_DRAIN = false;
    bf16* hbase; bf16* nabase; const float* lbp;
    __device__ __forceinline__ void operator()(const pg8::f32x4 (&acc)[2][2][4][2], const pg8::Unit& u, int wr, int wc, int fr, int fq) const {
        const int ot = u.pn;
        const int grp = ot >> 1;
        bf16* base = grp < 5 ? hbase + (size_t)grp * ((size_t)M * GW) : nabase + (size_t)(grp - 5) * ((size_t)M * GW);
        const int row0 = u.pm * 256 + wr * 64 + fr;
        const int col0 = (ot & 1) * 256 + wc * 32 + 8 * fq;
        float lb[2][8];
#pragma unroll
        for (int bj = 0; bj < 2; ++bj)
#pragma unroll
            for (int e = 0; e < 8; ++e) lb[bj][e] = 0.f;
        if (grp == 1 || grp == 2) {
#pragma unroll
            for (int bj = 0; bj < 2; ++bj)
#pragma unroll
                for (int e = 0; e < 8; ++e) { const int c = (grp - 1) * GW + col0 + bj * 128 + e; lb[bj][e] = rcp_(1.f + ex2_(1.44269504089f * (lbp[1024 + c] - lbp[c]))); }
        }
#pragma unroll
        for (int ai = 0; ai < 2; ++ai)
#pragma unroll
            for (int m = 0; m < 4; ++m) { const size_t row = (size_t)(row0 + ai * 128 + m * 16);
#pragma unroll
                for (int bj = 0; bj < 2; ++bj) {
                    float v[8];
#pragma unroll
                    for (int e = 0; e < 4; ++e) { v[e] = acc[ai][bj][m][0][e]; v[4 + e] = acc[ai][bj][m][1][e]; }
                    if (grp == 0 || grp == 4) {
#pragma unroll
                        for (int e = 0; e < 8; ++e) v[e] = siluf_(v[e]);
                    } else if (grp == 1 || grp == 2) {
#pragma unroll
                        for (int e = 0; e < 8; ++e) v[e] = __builtin_amdgcn_logf(lb[bj][e] + (1.f - lb[bj][e]) * sigmoidf_(v[e]));
                    }
                    pg8::u32x4 w; w.x = cvtpk(v[0], v[1]); w.y = cvtpk(v[2], v[3]); w.z = cvtpk(v[4], v[5]); w.w = cvtpk(v[6], v[7]);
                    bf16* dst = grp < 5 ? base + (size_t)((ot & 1) * 2 + bj) * ((size_t)M * 128) + row * 128 + wc * 32 + 8 * fq
                                        : base + (size_t)((ot & 1) * 4 + bj * 2 + (wc >> 1)) * ((size_t)M * 64) + row * 64 + (wc & 1) * 32 + 8 * fq;
                    *(pg8::u32x4*)dst = w; } }
    }
};
struct EpiOutProj {
    static constexpr bool PERM = true, AFTER_DRAIN = false;
    const float* xp; const float* xs; bf16* x1b; float* ssq;
    __device__ __forceinline__ void operator()(const pg8::f32x4 (&acc)[2][2][4][2], const pg8::Unit& u, int wr, int wc, int fr, int fq) const {
        const int row0 = u.pm * 256 + wr * 64 + fr, col0 = u.pn * 256 + wc * 32 + 8 * fq;
        const float* xbase = (u.pm * 256 < MP ? xp + (size_t)row0 * D : xs + (size_t)(row0 - MP) * D) + col0;
#pragma unroll
        for (int ai = 0; ai < 2; ++ai) {
            pg8::f32x4 xv[4][2][2];
#pragma unroll
            for (int m = 0; m < 4; ++m)
#pragma unroll
                for (int bj = 0; bj < 2; ++bj)
#pragma unroll
                    for (int n = 0; n < 2; ++n) xv[m][bj][n] = __builtin_nontemporal_load((const pg8::f32x4*)(xbase + (size_t)(ai * 128 + m * 16) * D + bj * 128 + 4 * n));
            __builtin_amdgcn_sched_barrier(0);
            float sq4[4];
#pragma unroll
            for (int m = 0; m < 4; ++m) { const int row = row0 + ai * 128 + m * 16;
                bf16* nrow = x1b + (size_t)row * D + col0;
                float sq = 0.f;
#pragma unroll
                for (int bj = 0; bj < 2; ++bj) {
                    const pg8::f32x4 a0 = xv[m][bj][0] + acc[ai][bj][m][0], a1 = xv[m][bj][1] + acc[ai][bj][m][1];
                    sq += (a0[0] * a0[0] + a0[1] * a0[1]) + (a0[2] * a0[2] + a0[3] * a0[3]) + (a1[0] * a1[0] + a1[1] * a1[1]) + (a1[2] * a1[2] + a1[3] * a1[3]);
                    pg8::u32x4 w; w.x = cvtpk(a0[0], a0[1]); w.y = cvtpk(a0[2], a0[3]); w.z = cvtpk(a1[0], a1[1]); w.w = cvtpk(a1[2], a1[3]);
                    *(pg8::u32x4*)(nrow + bj * 128) = w; }
                sq4[m] = sq; }
#pragma unroll
            for (int m = 0; m < 4; ++m) sq4[m] += __shfl_xor(sq4[m], 16);
#pragma unroll
            for (int m = 0; m < 4; ++m) sq4[m] += __shfl_xor(sq4[m], 32);
            if (fq == 0) {
#pragma unroll
                for (int m = 0; m < 4; ++m) atomicAdd(ssq + row0 + ai * 128 + m * 16, sq4[m]); }
            __builtin_amdgcn_sched_barrier(0);
        }
    }
};
struct EpiGateUp {
    static constexpr bool PERM = true, AFTER_DRAIN = false;
    bf16* h; const float* ssq; unsigned* guard; unsigned need; mutable bool checked;
    __device__ __forceinline__ void operator()(const pg8::f32x4 (&acc)[2][2][4][2], const pg8::Unit& u, int wr, int wc, int fr, int fq) const {
        const int row0 = u.pm * 256 + wr * 64 + fr, col0 = u.pn * 128 + wc * 32 + 8 * fq;
        float sqv[2][4];
#pragma unroll
        for (int ai = 0; ai < 2; ++ai)
#pragma unroll
            for (int m = 0; m < 4; ++m) sqv[ai][m] = ssq[row0 + ai * 128 + m * 16];
        unsigned gv = checked ? need : xb_ld(guard);
        __builtin_amdgcn_sched_barrier(0);
        while (gv < need) { __builtin_amdgcn_s_sleep(2); gv = xb_ld(guard); }
        checked = true;
#pragma unroll
        for (int ai = 0; ai < 2; ++ai)
#pragma unroll
            for (int m = 0; m < 4; ++m) { const int row = row0 + ai * 128 + m * 16;
                const float rstd = rsq_(sqv[ai][m] * (((PROBE) == 5 ? 0.5f : 1.f) / D) + EPS);
                float v[8];
#pragma unroll
                for (int e = 0; e < 4; ++e) { v[e] = siluf_(acc[ai][0][m][0][e] * rstd) * (acc[ai][1][m][0][e] * rstd); v[4 + e] = siluf_(acc[ai][0][m][1][e] * rstd) * (acc[ai][1][m][1][e] * rstd); }
                pg8::u32x4 w; w.x = cvtpk(v[0], v[1]); w.y = cvtpk(v[2], v[3]); w.z = cvtpk(v[4], v[5]); w.w = cvtpk(v[6], v[7]);
                *(pg8::u32x4*)(h + (size_t)row * FF + col0) = w; }
    }
};
struct EpiDown {
    static constexpr bool PERM = true, AFTER_DRAIN = false;
    float* out; const bf16* x1b; unsigned* guard; unsigned need; mutable bool checked;
    __device__ __forceinline__ void operator()(const pg8::f32x4 (&acc)[2][2][4][2], const pg8::Unit& u, int wr, int wc, int fr, int fq) const {
        const int row0 = u.pm * 256 + wr * 64 + fr, col0 = u.pn * 256 + wc * 32 + 8 * fq;
        pg8::u32x4 xw[2][4][2];
#pragma unroll
        for (int ai = 0; ai < 2; ++ai)
#pragma unroll
            for (int m = 0; m < 4; ++m)
#pragma unroll
                for (int bj = 0; bj < 2; ++bj) xw[ai][m][bj] = __builtin_nontemporal_load((const pg8::u32x4*)(x1b + (size_t)(row0 + ai * 128 + m * 16) * D + col0 + bj * 128));
        unsigned gv = checked ? need : xb_ld(guard);
        __builtin_amdgcn_sched_barrier(0);
        while (gv < need) { __builtin_amdgcn_s_sleep(2); gv = xb_ld(guard); }
        checked = true;
#pragma unroll
        for (int ai = 0; ai < 2; ++ai)
#pragma unroll
            for (int m = 0; m < 4; ++m) { float* orow = out + (size_t)(row0 + ai * 128 + m * 16) * D + col0;
#pragma unroll
                for (int bj = 0; bj < 2; ++bj) { const pg8::u32x4 x = xw[ai][m][bj];
                    pg8::f32x4 a0 = acc[ai][bj][m][0], a1 = acc[ai][bj][m][1];
                    a0[0] += bflo(x.x); a0[1] += bfhi(x.x); a0[2] += bflo(x.y); a0[3] += bfhi(x.y); a1[0] += bflo(x.z); a1[1] += bfhi(x.z); a1[2] += bflo(x.w); a1[3] += bfhi(x.w);
                    __builtin_nontemporal_store(a0, (pg8::f32x4*)(orow + bj * 128)); __builtin_nontemporal_store(a1, (pg8::f32x4*)(orow + bj * 128 + 4)); } }
    }
};

__device__ __forceinline__ float wave_sum(float v) { v = sum16_(v); v += __shfl_xor(v, 16); v += __shfl_xor(v, 32); return v; }
__device__ __forceinline__ void tr_load(float (&wv)[32], const float* W, int N, int item, int lane) {
    const int nblk = N / 32, kb = item / nblk, nb = item % nblk, k0 = 64 * kb, n0 = 32 * nb;
#pragma unroll
    for (int i = 0; i < 32; ++i) wv[i] = __builtin_nontemporal_load(W + (size_t)(k0 + 2 * i + (lane >> 5)) * N + n0 + (lane & 31));
}
template <int MODE>
__device__ __forceinline__ void tr_finish(float (&wv)[32], int K, int N, bf16* WT, LAS float* scr, int item, int lane, const float* ksc = nullptr) {
    const int nblk = N / 32, kb = item / nblk, nb = item % nblk, k0 = 64 * kb, n0 = 32 * nb;
    if (ksc) {
#pragma unroll
        for (int i = 0; i < 32; ++i) wv[i] *= ksc[k0 + 2 * i + (lane >> 5)];
    }
#pragma unroll
    for (int i = 0; i < 32; ++i) scr[(2 * i + (lane >> 5)) * 33 + (lane & 31)] = wv[i];
    LDS_WAIT(); asm volatile("" ::: "memory");
    const int c = lane & 7;
    const int d0 = MODE == 0 ? n0 : (256 * (n0 / 128) + (n0 % 128) + (MODE == 2 ? 128 : 0));
#pragma unroll
    for (int j = 0; j < 4; ++j) { const int n = (lane >> 3) + 8 * j; const LAS float* s = scr + (8 * c) * 33 + n;
        v4u o; o.x = pk2(s[0 * 33], s[1 * 33]); o.y = pk2(s[2 * 33], s[3 * 33]); o.z = pk2(s[4 * 33], s[5 * 33]); o.w = pk2(s[6 * 33], s[7 * 33]);
        *(v4u*)(WT + (size_t)(d0 + n) * K + k0 + 8 * c) = o; }
    LDS_WAIT(); asm volatile("" ::: "memory");
}
template <int NR>
__device__ __forceinline__ void rms_rows_to_bf16(const float* const (&xrow)[NR], const f32x4 (&ww)[4], bf16* const (&orow)[NR], int lane) {
    f32x4 v[NR][4];
#pragma unroll
    for (int r = 0; r < NR; ++r)
#pragma unroll
        for (int j = 0; j < 4; ++j) v[r][j] = __builtin_nontemporal_load((const f32x4*)xrow[r] + lane + 64 * j);
#pragma unroll
    for (int r = 0; r < NR; ++r) { float s = 0.f;
#pragma unroll
        for (int j = 0; j < 4; ++j) s += (v[r][j].x * v[r][j].x + v[r][j].y * v[r][j].y) + (v[r][j].z * v[r][j].z + v[r][j].w * v[r][j].w);
        const float rstd = rsq_(wave_sum(s) * (1.f / D) + EPS);
        unsigned long long* o8 = (unsigned long long*)orow[r] + lane;
#pragma unroll
        for (int j = 0; j < 4; ++j) o8[64 * j] = (unsigned long long)pk2(v[r][j].x * rstd * ww[j].x, v[r][j].y * rstd * ww[j].y) | ((unsigned long long)pk2(v[r][j].z * rstd * ww[j].z, v[r][j].w * rstd * ww[j].w) << 32); }
}

struct Args { const float* in[14]; float* out; unsigned char* ws; int ph_lo, ph_hi; };

#define LDS_BARRIER() do { asm volatile("s_waitcnt lgkmcnt(0)" ::: "memory"); __builtin_amdgcn_s_barrier(); asm volatile("" ::: "memory"); } while (0)
typedef short s16x8 __attribute__((ext_vector_type(8)));
typedef short s16x4 __attribute__((ext_vector_type(4)));
__device__ __forceinline__ s16x4 tr16(const LAS unsigned char* p) { return __builtin_bit_cast(s16x4, __builtin_amdgcn_ds_read_tr16_b64_v4i16((LAS s16x4*)p)); }
__device__ __forceinline__ s16x8 mk8(s16x4 a, s16x4 b) { s16x8 r; r[0] = a[0]; r[1] = a[1]; r[2] = a[2]; r[3] = a[3]; r[4] = b[0]; r[5] = b[1]; r[6] = b[2]; r[7] = b[3]; return r; }
__device__ __forceinline__ s16x8 mk8u(unsigned a, unsigned b, unsigned c, unsigned d) { v4u t; t.x = a; t.y = b; t.z = c; t.w = d; return __builtin_bit_cast(s16x8, t); }
constexpr int TP = 288, AP = 144, TPQ = 272;
#define SWZ3(row_, colbyte_) ((colbyte_) ^ ((((row_) >> 3) & 1) << 7))
constexpr int HT_Q = 0, HT_G = 18432, HT_V = 36864, HT_QH = 55296, HT_KH = 73728, HT_A = 92160, HT_TOT = 101376, HT_DV = 105472, HT_V2 = 106496;
struct HGRegs { unsigned qw[8], gw[8]; v4u v0, v1; };
#define HG_LOAD(R_, cidx_) do { const size_t rb_ = hbase_ + (size_t)(s0 + 64 * (cidx_)) * 128; \
        _Pragma("unroll") for (int i_ = 0; i_ < 8; ++i_) { R_.qw[i_] = *(const unsigned*)(Hq + rb_ + (size_t)(8 * w + i_) * 128 + 2 * lane); R_.gw[i_] = *(const unsigned*)(Hg + rb_ + (size_t)(8 * w + i_) * 128 + 2 * lane); } \
        R_.v0 = *(const v4u*)(Hv + rb_ + (size_t)lr * 128 + lc * 8); R_.v1 = *(const v4u*)(Hv + rb_ + (size_t)(lr + 32) * 128 + lc * 8); } while (0)
template <int dir>
__device__ __forceinline__ void hgrn_step(LAS unsigned char* lds, const bf16* Hq, bf16* Hg, const bf16* Hv, bf16* Oo, int opitch, int s0, int cfirst, int nsteps, int head, int it, int dmode,
                                          HGRegs& R, f32x4 (&S)[8], float& bacc0, float& bacc1) {
    const int tid = threadIdx.x, lane = tid & 63, w = __builtin_amdgcn_readfirstlane(tid >> 6), h = lane >> 4, i16 = lane & 15, q4 = i16 >> 2, p4 = i16 & 3;
    LAS unsigned char* TQ = lds + HT_Q; LAS unsigned char* TG = lds + HT_G; LAS unsigned char* TV = lds + ((it & 1) ? HT_V2 : HT_V); LAS unsigned char* TQH = lds + HT_QH; LAS unsigned char* TKH = lds + HT_KH;
    LAS unsigned char* AM = lds + HT_A; LAS float* TOT = (LAS float*)(lds + HT_TOT); LAS float* DV = (LAS float*)(lds + HT_DV);
    const int lr = tid >> 4, lc = tid & 15;
    const size_t hbase_ = (size_t)head * ((size_t)M * 128);
    {
        const int cidx = dir ? cfirst - it : cfirst + it;
        *(LAS v4u*)(TV + lr * TP + SWZ3(lr, lc * 16)) = R.v0; *(LAS v4u*)(TV + (lr + 32) * TP + SWZ3(lr, lc * 16)) = R.v1;
        float glo[8], ghi[8], llo[8], lhi[8]; unsigned qws[8];
#pragma unroll
        for (int i = 0; i < 8; ++i) { glo[i] = bflo(R.gw[i]); ghi[i] = bfhi(R.gw[i]); qws[i] = R.qw[i]; }
        if (it + 1 < nsteps) { const int cn = dir ? cidx - 1 : cidx + 1; HG_LOAD(R, cn); }
        { float c0 = 0.f, c1 = 0.f;
          if (!dir) {
#pragma unroll
              for (int i = 0; i < 8; ++i) { c0 += glo[i]; c1 += ghi[i]; llo[i] = c0; lhi[i] = c1; }
          } else {
#pragma unroll
              for (int i = 7; i >= 0; --i) { c0 += glo[i]; c1 += ghi[i]; llo[i] = c0; lhi[i] = c1; }
          }
          *(LAS f32x2*)(TOT + w * 128 + 2 * lane) = (f32x2){c0, c1}; }
        LDS_BARRIER();
        if (!(dmode & 2)) {
            float offs0 = 0.f, offs1 = 0.f, ref0 = 0.f, ref1 = 0.f, all0 = 0.f, all1 = 0.f;
#pragma unroll
            for (int s = 0; s < 8; ++s) { const f32x2 tt = *(const LAS f32x2*)(TOT + s * 128 + 2 * lane); all0 += tt.x; all1 += tt.y;
                const float bo = (dir ? (s > w) : (s < w)) ? 1.f : 0.f;
                offs0 = __builtin_fmaf(bo, tt.x, offs0); offs1 = __builtin_fmaf(bo, tt.y, offs1);
                if (dir ? (s >= 4) : (s < 4)) { ref0 += tt.x; ref1 += tt.y; } }
            const float Er0 = ex2_(ref0), Er1 = ex2_(ref1), Ek0 = ex2_(all0 - ref0), Ek1 = ex2_(all1 - ref1);
            if (w == 0) *(LAS f32x2*)(DV + 2 * lane) = (f32x2){ex2_(all0), ex2_(all1)};
            const float Eg0 = Er0 * ex2_(bacc0), Eg1 = Er1 * ex2_(bacc1);
            bacc0 += all0; bacc1 += all1;
            float f0[8], f1[8], pre0[8], pre1[8];
#pragma unroll
            for (int i = 0; i < 8; ++i) { f0[i] = ex2_(glo[i]); f1[i] = ex2_(ghi[i]); }
            const float sg_ = dir ? -1.f : 1.f;
            float run0 = ex2_(fminf(sg_ * (offs0 + llo[0] - ref0), 115.f)), run1 = ex2_(fminf(sg_ * (offs1 + lhi[0] - ref1), 115.f));
            pre0[7] = ex2_(fminf(-sg_ * (offs0 + llo[7] - ref0), 115.f)); pre1[7] = ex2_(fminf(-sg_ * (offs1 + lhi[7] - ref1), 115.f));
#pragma unroll
            for (int i = 7; i > 0; --i) { pre0[i - 1] = pre0[i] * (dir ? f0[i - 1] : f0[i]); pre1[i - 1] = pre1[i] * (dir ? f1[i - 1] : f1[i]); }
            const int wv_ = tid >> 6;
            const int aq_ = HT_Q + (8 * wv_) * TP + lane * 4, aqh_ = HT_QH + (8 * wv_) * TPQ + lane * 4, akh_ = HT_KH + (8 * wv_) * TP + SWZ3(8 * wv_, lane * 4);
            bf16* gq_ = Hg + (size_t)head * ((size_t)M * 128) + (size_t)(s0 + 64 * cidx + 8 * wv_) * 128 + 2 * lane;
#pragma unroll
            for (int i = 0; i < 8; ++i) {
                const unsigned qw_ = qws[i]; const float q0 = bflo(qw_), q1 = bfhi(qw_);
                if (i > 0) { run0 *= dir ? f0[i - 1] : f0[i]; run1 *= dir ? f1[i - 1] : f1[i]; }
                const float e10 = dir ? pre0[i] : run0, e11 = dir ? pre1[i] : run1, e20 = dir ? run0 : pre0[i], e21 = dir ? run1 : pre1[i];
                const float k0 = 1.f - f0[i], k1 = 1.f - f1[i];
                const float qt0 = q0 * e10, qt1 = q1 * e11, kt0 = k0 * e20, kt1 = k1 * e21;
                *(LAS unsigned*)(lds + aq_ + i * TP) = cvtpk(qt0, qt1); *(LAS unsigned*)(lds + aq_ + (HT_G - HT_Q) + i * TP) = cvtpk(kt0, kt1);
                *(LAS unsigned*)(lds + aqh_ + i * TPQ) = cvtpk(qt0 * Er0, qt1 * Er1); *(LAS unsigned*)(lds + akh_ + i * TP) = cvtpk(kt0 * Ek0, kt1 * Ek1);
                if (!(dmode & 1)) *(unsigned*)(gq_ + i * 128) = cvtpk(qt0 * Eg0, qt1 * Eg1); }
        }
        LDS_BARRIER();
        if (!(dmode & 4)) {
            const int I = w >> 1;
            s16x8 qf[4], kf[2][4];
#pragma unroll
            for (int ks = 0; ks < 4; ++ks) qf[ks] = *(const LAS s16x8*)(TQ + (16 * I + i16) * TP + (32 * ks + 8 * h) * 2);
#pragma unroll
            for (int jj = 0; jj < 2; ++jj)
#pragma unroll
                for (int ks = 0; ks < 4; ++ks) kf[jj][ks] = *(const LAS s16x8*)(TG + (16 * (2 * (w & 1) + jj) + i16) * TP + (32 * ks + 8 * h) * 2);
            __builtin_amdgcn_sched_barrier(0);
            f32x4 a2[2];
#pragma unroll
            for (int jj = 0; jj < 2; ++jj) { a2[jj] = (f32x4){0.f, 0.f, 0.f, 0.f};
#pragma unroll
                for (int ks = 0; ks < 4; ++ks) a2[jj] = __builtin_amdgcn_mfma_f32_16x16x32_bf16(kf[jj][ks], qf[ks], a2[jj], 0, 0, 0); }
#pragma unroll
            for (int jj = 0; jj < 2; ++jj) { const int J = 2 * (w & 1) + jj; const int t = 16 * I + i16, sb = 16 * J + 4 * h;
                float vv[4];
#pragma unroll
                for (int r = 0; r < 4; ++r) { const bool keep = dir ? (sb + r >= t) : (sb + r <= t); vv[r] = keep ? a2[jj][r] : 0.f; }
                *(LAS v2u*)(AM + t * AP + sb * 2) = (v2u){cvtpk(vv[0], vv[1]), cvtpk(vv[2], vv[3])}; }
        }
        LDS_BARRIER();
        if (!(dmode & 8)) {
            s16x8 sf[4], vf[2];
#pragma unroll
            for (int ks = 0; ks < 4; ++ks) sf[ks] = mk8u(cvtpk(S[2 * ks][0], S[2 * ks][1]), cvtpk(S[2 * ks][2], S[2 * ks][3]), cvtpk(S[2 * ks + 1][0], S[2 * ks + 1][1]), cvtpk(S[2 * ks + 1][2], S[2 * ks + 1][3]));
#pragma unroll
            for (int ks = 0; ks < 2; ++ks) vf[ks] = mk8(tr16(TV + (32 * ks + 8 * h + q4) * TP + SWZ3(8 * h, (16 * w + 4 * p4) * 2)), tr16(TV + (32 * ks + 8 * h + 4 + q4) * TP + SWZ3(8 * h, (16 * w + 4 * p4) * 2)));
            f32x4 oo[4];
#pragma unroll
            for (int ip = 0; ip < 2; ++ip) {
                s16x8 afr[2][2], qfr[2][4];
#pragma unroll
                for (int ii = 0; ii < 2; ++ii) { const int i = 2 * ip + ii;
#pragma unroll
                    for (int ks = 0; ks < 2; ++ks) afr[ii][ks] = *(const LAS s16x8*)(AM + (16 * i + i16) * AP + (32 * ks + 8 * h) * 2);
#pragma unroll
                    for (int ks = 0; ks < 4; ++ks) { const v2u lo = *(const LAS v2u*)(TQH + (16 * i + i16) * TPQ + (32 * ks + 4 * h) * 2), hi = *(const LAS v2u*)(TQH + (16 * i + i16) * TPQ + (32 * ks + 16 + 4 * h) * 2);
                        qfr[ii][ks] = mk8u(lo.x, lo.y, hi.x, hi.y); } }
                __builtin_amdgcn_sched_barrier(0);
#pragma unroll
                for (int ii = 0; ii < 2; ++ii) { f32x4 o = (f32x4){0.f, 0.f, 0.f, 0.f};
#pragma unroll
                    for (int ks = 0; ks < 2; ++ks) o = __builtin_amdgcn_mfma_f32_16x16x32_bf16(vf[ks], afr[ii][ks], o, 0, 0, 0);
#pragma unroll
                    for (int ks = 0; ks < 4; ++ks) o = __builtin_amdgcn_mfma_f32_16x16x32_bf16(sf[ks], qfr[ii][ks], o, 0, 0, 0);
                    oo[2 * ip + ii] = o; }
                __builtin_amdgcn_sched_barrier(0);
            }
            s16x8 kfr[8][2]; f32x4 d4[8];
#pragma unroll
            for (int T = 0; T < 8; ++T) { d4[T] = *(const LAS f32x4*)(DV + 16 * T + 4 * h);
#pragma unroll
                for (int ks = 0; ks < 2; ++ks) kfr[T][ks] = mk8(tr16(TKH + (32 * ks + 8 * h + q4) * TP + SWZ3(8 * h, (16 * T + 4 * p4) * 2)), tr16(TKH + (32 * ks + 8 * h + 4 + q4) * TP + SWZ3(8 * h, (16 * T + 4 * p4) * 2))); }
#pragma unroll
            for (int i = 0; i < 4; ++i) *(v2u*)(Oo + (size_t)(s0 + 64 * cidx + 16 * i + i16) * opitch + 16 * w + 4 * h) = (v2u){cvtpk(oo[i][0], oo[i][1]), cvtpk(oo[i][2], oo[i][3])};
            __builtin_amdgcn_sched_barrier(0);
#pragma unroll
            for (int T = 0; T < 8; ++T) { S[T] = S[T] * d4[T];
#pragma unroll
                for (int ks = 0; ks < 2; ++ks) S[T] = __builtin_amdgcn_mfma_f32_16x16x32_bf16(kfr[T][ks], vf[ks], S[T], 0, 0, 0); }
        }
        if (it + 1 == nsteps) LDS_BARRIER();
    }
}
template <int dir>
__device__ __forceinline__ void hgrn_chain(LAS unsigned char* lds, const bf16* Hq, bf16* Hg, const bf16* Hv, bf16* Oo, int opitch, int s0, int cfirst, int nsteps, int head, float* SLc, float* Btc, int dmode = 0) {
    const int tid = threadIdx.x, lane = tid & 63, w = __builtin_amdgcn_readfirstlane(tid >> 6);
    const int lr = tid >> 4, lc = tid & 15;
    const size_t hbase_ = (size_t)head * ((size_t)M * 128);
    HGRegs A;
    HG_LOAD(A, cfirst);
    f32x4 S[8];
#pragma unroll
    for (int T = 0; T < 8; ++T) S[T] = (f32x4){0.f, 0.f, 0.f, 0.f};
    float bacc0 = 0.f, bacc1 = 0.f;
    for (int it = 0; it < nsteps; ++it)
        hgrn_step<dir>(lds, Hq, Hg, Hv, Oo, opitch, s0, cfirst, nsteps, head, it, dmode, A, S, bacc0, bacc1);
#undef HG_LOAD
#pragma unroll
    for (int T = 0; T < 8; ++T) *(f32x4*)(SLc + ((w * 8 + T) * 64 + lane) * 4) = S[T];
    if (w == 0) *(f32x2*)(Btc + 2 * lane) = (f32x2){bacc0, bacc1};
}
__device__ __forceinline__ void hgrn_scan(const float* SL, const float* Bt, v4u* SF, int gid, int nthreads, int own_x = -1) {
    for (int item = gid; item < 48 * 2048; item += nthreads) {
        const int g = item >> 11, e = item & 2047, seq = g >> 3, head = (g >> 1) & 3, dir = g & 1;
        const int ns = seq < 4 ? 4 : 8, sgbase = seq < 4 ? seq * 4 : 16 + (seq - 4) * 8;
        const int wq = e >> 8, ks = (e >> 6) & 3, ln = e & 63, dk0 = 32 * ks + 4 * (ln >> 4);
        f32x4 ta[8], tb[8], ba[8], bb[8];
#pragma unroll
        for (int jj = 0; jj < 8; ++jj) if (jj < ns) { const int j = dir ? ns - 1 - jj : jj; const int ch = ((sgbase + j) << 3) | (head << 1) | dir;
            const f32x4* p = (const f32x4*)(SL + (size_t)ch * 16384) + (wq * 8 + 2 * ks) * 64 + ln;
            ta[jj] = p[0]; tb[jj] = p[64]; ba[jj] = *(const f32x4*)(Bt + ch * 128 + dk0); bb[jj] = *(const f32x4*)(Bt + ch * 128 + dk0 + 16); }
        f32x4 ca = (f32x4){0.f, 0.f, 0.f, 0.f}, cb = ca;
#pragma unroll
        for (int jj = 0; jj < 8; ++jj) if (jj < ns) { const int j = dir ? ns - 1 - jj : jj; const int ch = ((sgbase + j) << 3) | (head << 1) | dir;
            v4u fr; fr.x = cvtpk(ca.x, ca.y); fr.y = cvtpk(ca.z, ca.w); fr.z = cvtpk(cb.x, cb.y); fr.w = cvtpk(cb.z, cb.w);
            if (own_x < 0 || ((sgbase + j) >> 2) == own_x) SF[(size_t)ch * 2048 + e] = fr;
            ca.x = ex2_(ba[jj].x) * ca.x + ta[jj].x; ca.y = ex2_(ba[jj].y) * ca.y + ta[jj].y; ca.z = ex2_(ba[jj].z) * ca.z + ta[jj].z; ca.w = ex2_(ba[jj].w) * ca.w + ta[jj].w;
            cb.x = ex2_(bb[jj].x) * cb.x + tb[jj].x; cb.y = ex2_(bb[jj].y) * cb.y + tb[jj].y; cb.z = ex2_(bb[jj].z) * cb.z + tb[jj].z; cb.w = ex2_(bb[jj].w) * cb.w + tb[jj].w; }
    }
}
constexpr int P2_QF = 0, P2_QB = 18432, P2_BUF = 36864, P2_OC = 73728, P2_OCP = 528;
__device__ __forceinline__ void hgrn_pass2(LAS unsigned char* lds, const bf16* Hqf, const bf16* Hqb, const bf16* Hgate, const float* gnw, const v4u* SF, const bf16* O, bf16* Ow, int opw, const bf16* OBk,
                                           int s0, int seg, int sg, int head, int half, int mode = 0) {
    const int tid = threadIdx.x, lane = tid & 63, w = __builtin_amdgcn_readfirstlane(tid >> 6), h = lane >> 4, i16 = lane & 15;
    const int ti = w >> 1, dh = w & 1;
    const int chf = (sg << 3) | (head << 1), chb = chf | 1;
    s16x8 sfF[4][4], sfB[4][4];
#pragma unroll
    for (int n = 0; n < 4; ++n)
#pragma unroll
        for (int ks = 0; ks < 4; ++ks) { const size_t fo = (size_t)((4 * dh + n) * 4 + ks) * 64 + lane;
            sfF[n][ks] = __builtin_bit_cast(s16x8, SF[(size_t)chf * 2048 + fo]); sfB[n][ks] = __builtin_bit_cast(s16x8, SF[(size_t)chb * 2048 + fo]); }
    const int lr = tid >> 4, lc = tid & 15; const size_t gcol = (size_t)head * 128 + lc * 8, hcol = (size_t)head * ((size_t)M * 128) + lc * 8;
    const f32x4 gn0 = *(const f32x4*)(gnw + 8 * lc), gn1 = *(const f32x4*)(gnw + 8 * lc + 4);
    LAS unsigned char* OC = lds + P2_OC;
    v4u pa0, pa1, pb0, pb1, rf0, rf1, rb0, rb1, rg0, rg1;
#define P2_LOAD(cidx_) do { const size_t o0_ = (size_t)(s0 + 64 * (cidx_) + lr) * 128 + hcol, o1_ = o0_ + (size_t)32 * 128; \
        pa0 = __builtin_nontemporal_load((const v4u*)(Hqf + o0_)); pa1 = __builtin_nontemporal_load((const v4u*)(Hqf + o1_)); pb0 = __builtin_nontemporal_load((const v4u*)(Hqb + o0_)); pb1 = __builtin_nontemporal_load((const v4u*)(Hqb + o1_)); } while (0)
#define P2_LOADR(cidx_) do { const size_t r0_ = (size_t)(s0 + 64 * (cidx_) + lr), r1_ = r0_ + 32; \
        rf0 = __builtin_nontemporal_load((const v4u*)(O + r0_ * D + gcol)); rf1 = __builtin_nontemporal_load((const v4u*)(O + r1_ * D + gcol)); rb0 = __builtin_nontemporal_load((const v4u*)(OBk + r0_ * 128 + hcol)); rb1 = __builtin_nontemporal_load((const v4u*)(OBk + r1_ * 128 + hcol)); \
        rg0 = __builtin_nontemporal_load((const v4u*)(Hgate + r0_ * 128 + hcol)); rg1 = __builtin_nontemporal_load((const v4u*)(Hgate + r1_ * 128 + hcol)); } while (0)
    P2_LOAD(16 * seg + 8 * half); P2_LOADR(16 * seg + 8 * half);
    for (int u = 0; u < 8; ++u) {
        const int cidx = 16 * seg + 8 * half + u;
        LAS unsigned char* TQF = lds + (u & 1) * P2_BUF + P2_QF; LAS unsigned char* TQB = lds + (u & 1) * P2_BUF + P2_QB;
        *(LAS v4u*)(TQF + lr * TPQ + lc * 16) = pa0; *(LAS v4u*)(TQF + (lr + 32) * TPQ + lc * 16) = pa1;
        *(LAS v4u*)(TQB + lr * TPQ + lc * 16) = pb0; *(LAS v4u*)(TQB + (lr + 32) * TPQ + lc * 16) = pb1;
        if (u + 1 < 8 && mode != 1) P2_LOAD(cidx + 1);
        LDS_BARRIER();
        if (mode != 2) {
            s16x8 ff[4], fb[4];
#pragma unroll
            for (int ks = 0; ks < 4; ++ks) { const int ro = (16 * ti + i16) * TPQ + (32 * ks + 4 * h) * 2;
                const v2u lo = *(const LAS v2u*)(TQF + ro), hi = *(const LAS v2u*)(TQF + ro + 32), lo2 = *(const LAS v2u*)(TQB + ro), hi2 = *(const LAS v2u*)(TQB + ro + 32);
                ff[ks] = mk8u(lo.x, lo.y, hi.x, hi.y); fb[ks] = mk8u(lo2.x, lo2.y, hi2.x, hi2.y); }
            __builtin_amdgcn_sched_barrier(0);
#pragma unroll
            for (int n = 0; n < 4; ++n) { f32x4 o = (f32x4){0.f, 0.f, 0.f, 0.f};
#pragma unroll
                for (int ks = 0; ks < 4; ++ks) { o = __builtin_amdgcn_mfma_f32_16x16x32_bf16(sfF[n][ks], ff[ks], o, 0, 0, 0); o = __builtin_amdgcn_mfma_f32_16x16x32_bf16(sfB[n][ks], fb[ks], o, 0, 0, 0); }
                *(LAS f32x4*)(OC + (16 * ti + i16) * P2_OCP + (16 * (4 * dh + n) + 4 * h) * 4) = o; }
            __builtin_amdgcn_sched_barrier(0);
        }
        LDS_BARRIER();
        {
            const v4u f0 = rf0, f1 = rf1, b0 = rb0, b1 = rb1, g0 = rg0, g1 = rg1;
            if (u + 1 < 8 && mode != 1) P2_LOADR(cidx + 1);
#pragma unroll
            for (int rr = 0; rr < 2; ++rr) { const int row = lr + 32 * rr; const v4u fw = rr ? f1 : f0, bw = rr ? b1 : b0, gw_ = rr ? g1 : g0;
                const f32x4 c0_ = *(const LAS f32x4*)(OC + row * P2_OCP + lc * 32), c1_ = *(const LAS f32x4*)(OC + row * P2_OCP + lc * 32 + 16);
                float o[8];
                o[0] = c0_.x + bflo(fw.x) + bflo(bw.x); o[1] = c0_.y + bfhi(fw.x) + bfhi(bw.x); o[2] = c0_.z + bflo(fw.y) + bflo(bw.y); o[3] = c0_.w + bfhi(fw.y) + bfhi(bw.y);
                o[4] = c1_.x + bflo(fw.z) + bflo(bw.z); o[5] = c1_.y + bfhi(fw.z) + bfhi(bw.z); o[6] = c1_.z + bflo(fw.w) + bflo(bw.w); o[7] = c1_.w + bfhi(fw.w) + bfhi(bw.w);
                float sq = (o[0] * o[0] + o[1] * o[1]) + (o[2] * o[2] + o[3] * o[3]) + (o[4] * o[4] + o[5] * o[5]) + (o[6] * o[6] + o[7] * o[7]);
                sq = sum16_(sq);
                const float r = rsq_(sq * (1.f / 128.f) + EPS);
                v4u ov; ov.x = cvtpk(o[0] * r * gn0.x * bflo(gw_.x), o[1] * r * gn0.y * bfhi(gw_.x)); ov.y = cvtpk(o[2] * r * gn0.z * bflo(gw_.y), o[3] * r * gn0.w * bfhi(gw_.y));
                ov.z = cvtpk(o[4] * r * gn1.x * bflo(gw_.z), o[5] * r * gn1.y * bfhi(gw_.z)); ov.w = cvtpk(o[6] * r * gn1.z * bflo(gw_.w), o[7] * r * gn1.w * bfhi(gw_.w));
                *(v4u*)(Ow + (size_t)(s0 + 64 * cidx + row) * opw + gcol) = ov; }
        }
    }
    LDS_BARRIER();
#undef P2_LOAD
#undef P2_LOADR
}
constexpr int NKP = 128, NROWB = 64 * NKP, NA_K = 0, NA_V = 9 * NROWB, NA_RPB = 18 * NROWB;
#define NA_KOFF(key_, chunk_) ((key_) * NKP + 16 * ((chunk_) ^ (((key_) >> 1) & 7)))
#define NA_VOFF(key_, unit_) ((key_) * NKP + 8 * ((unit_) ^ (4 * (((key_) >> 1) & 3))))
static_assert(NA_RPB + 480 * 4 <= LDSCTL_OFF, "NA LDS map");
__device__ __forceinline__ void na_store_krow(LAS unsigned char* KR, int row, int key, int c, v4u kr, const float* kw) {
    float x[8]; x[0] = bflo(kr.x); x[1] = bfhi(kr.x); x[2] = bflo(kr.y); x[3] = bfhi(kr.y); x[4] = bflo(kr.z); x[5] = bfhi(kr.z); x[6] = bflo(kr.w); x[7] = bfhi(kr.w);
    float ss = 0.f;
#pragma unroll
    for (int e = 0; e < 8; ++e) ss += x[e] * x[e];
    ss = sum8_(ss);
    const float sc = rsq_(ss * (1.f / 64.f) + EPS);
    const f32x4 w0 = *(const f32x4*)(kw + c * 8), w1 = *(const f32x4*)(kw + c * 8 + 4);
    v4u o; o.x = cvtpk(x[0] * sc * w0.x, x[1] * sc * w0.y); o.y = cvtpk(x[2] * sc * w0.z, x[3] * sc * w0.w); o.z = cvtpk(x[4] * sc * w1.x, x[5] * sc * w1.y); o.w = cvtpk(x[6] * sc * w1.z, x[7] * sc * w1.w);
    *(LAS v4u*)(KR + (row % 9) * NROWB + NA_KOFF(key, c)) = o;
}
__device__ __forceinline__ void na_store_vrow(LAS unsigned char* VR, int row, int key, int c, v4u vr) {
    *(LAS v4u*)(VR + (row % 9) * NROWB + NA_VOFF(key, 2 * c)) = vr;
}
__device__ __forceinline__ void na_qfrag(s16x8 (&qf)[2], v4u a, v4u b, const float* qw, int h) {
    float x[16]; x[0] = bflo(a.x); x[1] = bfhi(a.x); x[2] = bflo(a.y); x[3] = bfhi(a.y); x[4] = bflo(a.z); x[5] = bfhi(a.z); x[6] = bflo(a.w); x[7] = bfhi(a.w);
    x[8] = bflo(b.x); x[9] = bfhi(b.x); x[10] = bflo(b.y); x[11] = bfhi(b.y); x[12] = bflo(b.z); x[13] = bfhi(b.z); x[14] = bflo(b.w); x[15] = bfhi(b.w);
    float ss = 0.f;
#pragma unroll
    for (int e = 0; e < 16; ++e) ss += x[e] * x[e];
    ss += __shfl_xor(ss, 16); ss += __shfl_xor(ss, 32);
    const float sc = (0.125f * 1.44269504089f) * rsq_(ss * (1.f / 64.f) + EPS);
    const f32x4 wa0 = *(const f32x4*)(qw + 8 * h), wa1 = *(const f32x4*)(qw + 8 * h + 4), wb0 = *(const f32x4*)(qw + 32 + 8 * h), wb1 = *(const f32x4*)(qw + 32 + 8 * h + 4);
    qf[0] = mk8u(cvtpk(x[0] * sc * wa0.x, x[1] * sc * wa0.y), cvtpk(x[2] * sc * wa0.z, x[3] * sc * wa0.w), cvtpk(x[4] * sc * wa1.x, x[5] * sc * wa1.y), cvtpk(x[6] * sc * wa1.z, x[7] * sc * wa1.w));
    qf[1] = mk8u(cvtpk(x[8] * sc * wb0.x, x[9] * sc * wb0.y), cvtpk(x[10] * sc * wb0.z, x[11] * sc * wb0.w), cvtpk(x[12] * sc * wb1.x, x[13] * sc * wb1.y), cvtpk(x[14] * sc * wb1.z, x[15] * sc * wb1.w));
}
__device__ __forceinline__ void na_run(LAS unsigned char* lds, const bf16* NQ, const bf16* NK, const bf16* NV, const float* qw, const float* kw, const float* rpb, bf16* O, int s0, int rows, int head, int r0, int nr) {
    const int tid = threadIdx.x, lane = tid & 63, w = __builtin_amdgcn_readfirstlane(tid >> 6), h = lane >> 4, i16 = lane & 15, q4 = i16 >> 2, p4 = i16 & 3;
    LAS unsigned char* KR = lds + NA_K; LAS unsigned char* VR = lds + NA_V; LAS float* RB = (LAS float*)(lds + NA_RPB);
    for (int i = tid; i < 480; i += NWAVES * 64) { const int rw = i >> 5, cl = i & 31; RB[i] = cl < 31 ? rpb[head * 465 + rw * 31 + cl] * 1.44269504089f : -1e30f; }
    const int lkey = tid >> 3, lc = tid & 7; const size_t hbase = (size_t)head * ((size_t)M * 64);
    const int rr = w >> 2, j = w & 3, qcol = 16 * j + i16, bs = min(max(16 * j - 8, 0), 32), wsn = min(max(qcol - 8, 0), 48);
    {
        const int rs0 = min(max(r0 - 4, 0), rows - 8), hi0 = min(max(r0 - 3, 0), rows - 8) + 7; v4u kk[9], vv[9];
#pragma unroll
        for (int k = 0; k < 9; ++k) { const int row = min(rs0 + k, hi0); const size_t go = hbase + (size_t)(s0 + row * 64 + lkey) * 64 + lc * 8; kk[k] = *(const v4u*)(NK + go); vv[k] = *(const v4u*)(NV + go); }
#pragma unroll
        for (int k = 0; k < 9; ++k) { const int row = min(rs0 + k, hi0); na_store_krow(KR, row, lkey, lc, kk[k], kw); na_store_vrow(VR, row, lkey, lc, vv[k]); }
    }
    v4u qa, qb;
    { const size_t qrow = (size_t)(s0 + (r0 + rr) * 64 + qcol); qa = *(const v4u*)(NQ + hbase + qrow * 64 + 8 * h); qb = *(const v4u*)(NQ + hbase + qrow * 64 + 32 + 8 * h); }
    for (int st = 0; st < nr; st += 2) {
        const int r = r0 + st + rr, rs = min(max(r - 4, 0), rows - 8);
        const bool more = st + 2 < nr;
        const int hic = min(max(r0 + st - 3, 0), rows - 8) + 7, hin = min(max(r0 + st - 1, 0), rows - 8) + 7;
        const int nrA = min(hic + 1, hin), nrB = min(hic + 2, hin);
        const bool ldA = more && (hic + 1 <= hin), ldB = more && (hic + 2 <= hin);
        s16x8 qf[2]; na_qfrag(qf, qa, qb, qw, h);
        LDS_BARRIER();
        v4u nkA, nvA, nkB, nvB;
        if (ldA) { const size_t go = hbase + (size_t)(s0 + nrA * 64 + lkey) * 64 + lc * 8; nkA = *(const v4u*)(NK + go); nvA = *(const v4u*)(NV + go); }
        if (ldB) { const size_t go = hbase + (size_t)(s0 + nrB * 64 + lkey) * 64 + lc * 8; nkB = *(const v4u*)(NK + go); nvB = *(const v4u*)(NV + go); }
        const size_t qrow = (size_t)(s0 + r * 64 + qcol);
        if (more) { const size_t qn = qrow + 128; qa = *(const v4u*)(NQ + hbase + qn * 64 + 8 * h); qb = *(const v4u*)(NQ + hbase + qn * 64 + 32 + 8 * h); }
        {
            int dci[2][4];
#pragma unroll
            for (int ch = 0; ch < 2; ++ch)
#pragma unroll
                for (int rg = 0; rg < 4; ++rg) { const int kcol = bs + 16 * ch + 4 * h + rg; dci[ch][rg] = ((kcol >= wsn) && (kcol < wsn + 16)) ? kcol - qcol + 15 : 31; }
            const LAS float* rbp[2][4];
#pragma unroll
            for (int ch = 0; ch < 2; ++ch)
#pragma unroll
                for (int rg = 0; rg < 4; ++rg) rbp[ch][rg] = RB + (rs - r + 7) * 32 + dci[ch][rg];
            const s16x8 ones = {0x3F80, 0x3F80, 0x3F80, 0x3F80, 0x3F80, 0x3F80, 0x3F80, 0x3F80};
            f32x4 ls = (f32x4){0.f, 0.f, 0.f, 0.f}; s16x8 pf[8];
            float bv[2][2][2][4]; s16x8 kf[2][2][2][2];
#define NA_LOADK(B_, KP_) do { _Pragma("unroll") for (int k2 = 0; k2 < 2; ++k2) { const int kr_ = 2 * (KP_) + k2; const int slot_ = (rs + kr_) % 9; \
                _Pragma("unroll") for (int ch = 0; ch < 2; ++ch) { \
                    _Pragma("unroll") for (int rg = 0; rg < 4; ++rg) bv[B_][k2][ch][rg] = rbp[ch][rg][kr_ * 32]; \
                    _Pragma("unroll") for (int ks = 0; ks < 2; ++ks) { kf[B_][k2][ch][ks] = *(const LAS s16x8*)(KR + slot_ * NROWB + NA_KOFF(bs + 16 * ch + i16, 4 * ks + h)); } } } } while (0)
            NA_LOADK(0, 0);
#pragma unroll
            for (int kp = 0; kp < 4; ++kp) {
                if (kp < 3) NA_LOADK((kp + 1) & 1, kp + 1);
                __builtin_amdgcn_sched_barrier(0);
#pragma unroll
                for (int k2 = 0; k2 < 2; ++k2) { const int kr = 2 * kp + k2; float pp[2][4];
#pragma unroll
                    for (int ch = 0; ch < 2; ++ch) { f32x4 a = (f32x4){bv[kp & 1][k2][ch][0], bv[kp & 1][k2][ch][1], bv[kp & 1][k2][ch][2], bv[kp & 1][k2][ch][3]};
#pragma unroll
                        for (int ks = 0; ks < 2; ++ks) a = __builtin_amdgcn_mfma_f32_16x16x32_bf16(kf[kp & 1][k2][ch][ks], qf[ks], a, 0, 0, 0);
#pragma unroll
                        for (int rg = 0; rg < 4; ++rg) pp[ch][rg] = ex2_(a[rg]); }
                    pf[kr] = mk8u(cvtpk(pp[0][0], pp[0][1]), cvtpk(pp[0][2], pp[0][3]), cvtpk(pp[1][0], pp[1][1]), cvtpk(pp[1][2], pp[1][3]));
                    ls = __builtin_amdgcn_mfma_f32_16x16x32_bf16(ones, pf[kr], ls, 0, 0, 0); }
                __builtin_amdgcn_sched_barrier(0);
            }
#undef NA_LOADK
            const float il = rcp_(ls[0]);
            s16x8 vfr[2][8];
#define NA_LOADV(B_, N_) do { _Pragma("unroll") for (int kr = 0; kr < 8; ++kr) { const int slot_ = (rs + kr) % 9; \
                vfr[B_][kr] = mk8(tr16(VR + slot_ * NROWB + NA_VOFF(bs + 4 * h + q4, 4 * (N_) + p4)), tr16(VR + slot_ * NROWB + NA_VOFF(bs + 16 + 4 * h + q4, 4 * (N_) + p4))); } } while (0)
            NA_LOADV(0, 0);
#pragma unroll
            for (int n = 0; n < 4; ++n) {
                if (n < 3) NA_LOADV((n + 1) & 1, n + 1);
                __builtin_amdgcn_sched_barrier(0);
                f32x4 o = (f32x4){0.f, 0.f, 0.f, 0.f};
#pragma unroll
                for (int kr = 0; kr < 8; ++kr) o = __builtin_amdgcn_mfma_f32_16x16x32_bf16(vfr[n & 1][kr], pf[kr], o, 0, 0, 0);
                *(v2u*)(O + qrow * D + GW + head * 64 + 16 * n + 4 * h) = (v2u){cvtpk(o[0] * il, o[1] * il), cvtpk(o[2] * il, o[3] * il)};
                __builtin_amdgcn_sched_barrier(0);
            }
#undef NA_LOADV
        }
        LDS_BARRIER();
        if (ldA) { na_store_krow(KR, nrA, lkey, lc, nkA, kw); na_store_vrow(VR, nrA, lkey, lc, nvA); }
        if (ldB) { na_store_krow(KR, nrB, lkey, lc, nkB, kw); na_store_vrow(VR, nrB, lkey, lc, nvB); }
    }
    LDS_BARRIER();
}
constexpr int N_PHASES = 8;
#define REP(k) for (int rep_ = 0; rep_ < ((PROBE) == (k) ? 2 : 1); ++rep_)
__global__ void __launch_bounds__(NWAVES * 64, 2) fwd_kernel(Args args) {
    extern __shared__ __attribute__((aligned(16))) unsigned char lds_raw[];
    LAS unsigned char* lds = (LAS unsigned char*)lds_raw;
    volatile LAS unsigned* MISC = (volatile LAS unsigned*)(lds + MISC_OFF);
    const int tid = threadIdx.x, lane = tid & 63, wave = __builtin_amdgcn_readfirstlane(tid >> 6);
    const int G = gridDim.x; const int bx = blockIdx.x; const int vcu = (G % 8 == 0) ? (bx % 8) * (G / 8) + bx / 8 : bx;
    unsigned char* ws = args.ws;
    unsigned* ctl = (unsigned*)(ws + WS_CTL);
    const float* xp = args.in[0]; const float* xs = args.in[1]; const float* w_mix = args.in[2]; const float* w_in = args.in[3]; const float* lbp = args.in[4];
    const float* gnw = args.in[5]; const float* qnw = args.in[6]; const float* knw = args.in[7]; const float* rpb = args.in[8]; const float* w_out = args.in[9];
    const float* w_ffn = args.in[10]; const float* w_gate = args.in[11]; const float* w_up = args.in[12]; const float* w_down = args.in[13];
    float* out = args.out;
    bf16* Wgu_t = (bf16*)(ws + WS_WGU); bf16* Win_t = (bf16*)(ws + WS_WIN); bf16* Wout_t = (bf16*)(ws + WS_WOUT); bf16* Wdown_t = (bf16*)(ws + WS_WDOWN);
    bf16* XN = (bf16*)(ws + WS_A); bf16* OBk = (bf16*)out + 3 * (size_t)M * GW; bf16* Hb = (bf16*)(ws + WS_H); bf16* Ob = (bf16*)(ws + WS_O);
    bf16* X1b = (bf16*)(ws + WS_X1); bf16* HFF = (bf16*)(ws + WS_HFF); bf16* NAb = (bf16*)out; float* ssq = (float*)(ctl + CW_SSQ); float* SLb = (float*)(ws + WS_SL); float* Btb = (float*)(ctl + CW_BT);
    v4u* SFb = (v4u*)(ws + WS_SF);
    for (int u = tid; u < (LDS_BYTES - LDSCTL_OFF) / 4; u += NWAVES * 64) ((LAS unsigned*)(lds + LDSCTL_OFF))[u] = 0u;
    __syncthreads();
    const int lo = args.ph_lo, hi = args.ph_hi;
    XcdBarrier bar; bar.bar = ctl + CW_BAR; bar.x = 0; bar.st = nullptr;
    if (hi - lo > 1) bar = xcd_barrier_post(ctl + CW_BAR, MISC + 8);
#define IN(k) (lo <= (k) && (k) < hi)
#define SEAM(k) do { if (IN(k) && IN((k) + 1)) xcd_barrier(bar); } while (0)
#define SEAM_ARRIVE(k) do { if (IN(k) && IN((k) + 1)) bgen = xcd_barrier_arrive(bar); } while (0)
#define SEAM_WAIT(k) do { if (IN(k) && IN((k) + 1)) xcd_barrier_wait(bar, bgen); else __syncthreads(); } while (0)
    const int gw = vcu * NWAVES + wave, NGW = G * NWAVES;
    const bool full = (lo == 0 && hi == N_PHASES);
    unsigned bgen = 0u;
    if (full) { if (tid == 0 && bx < 8) __hip_atomic_store(&ctl[CW_XMAP + bx], xb_xcc_id() + 1u, __ATOMIC_RELAXED, __HIP_MEMORY_SCOPE_AGENT);
                bgen = xcd_barrier_arrive(bar); }

    if (IN(0)) REP(0) {
        LAS float* scr = (LAS float*)(lds + RING_OFF + wave * 16384);
        constexpr int I_IN = (D / 64) * (INC / 32), I_OUT = (D / 64) * (D / 32);
#define P0_LOAD(wv_, it_) do { if ((it_) < I_IN) tr_load(wv_, w_in, INC, (it_), lane); else tr_load(wv_, w_out, D, (it_) - I_IN, lane); } while (0)
#define P0_FIN(wv_, it_) do { if ((it_) < I_IN) tr_finish<0>(wv_, D, INC, Win_t, scr, (it_), lane); else tr_finish<0>(wv_, D, D, Wout_t, scr, (it_) - I_IN, lane); } while (0)
        for (int it = gw; it < I_IN + I_OUT; it += 2 * NGW) { float wa[32], wb[32]; const bool two = it + NGW < I_IN + I_OUT;
            P0_LOAD(wa, it); if (two) P0_LOAD(wb, it + NGW);
            P0_FIN(wa, it); if (two) P0_FIN(wb, it + NGW); }
#undef P0_LOAD
#undef P0_FIN
        if (full) { xcd_barrier_poll(bar, bgen);
                    if (tid == 0 && (G % 8 != 0 || xb_ld(&ctl[CW_XMAP + (bx & 7)]) != xb_xcc_id() + 1u)) atomicOr(&ctl[CW_NONCANON], 1u);
                    bgen = xcd_barrier_arrive(bar); }
        for (int i = bx * (NWAVES * 64) + tid; i < M; i += G * NWAVES * 64) ssq[i] = 0.f;
        { f32x4 ww[4];
#pragma unroll
          for (int j = 0; j < 4; ++j) ww[j] = ((const f32x4*)w_mix + lane)[64 * j];
          if (G == 256) {
              const int tp0 = 16 * (bx & 7) + ((bx >> 3) & 7), rw0 = 64 * (bx >> 6) + 8 * wave;
#pragma unroll 1
              for (int it = 0; it < 4; ++it) { const float* xr[4]; bf16* orw[4];
#pragma unroll
                  for (int r = 0; r < 4; ++r) { const int mm = 256 * (tp0 + 8 * (it >> 1)) + rw0 + 4 * (it & 1) + r; xr[r] = mm < MP ? xp + (size_t)mm * D : xs + (size_t)(mm - MP) * D; orw[r] = XN + (size_t)mm * D; }
                  rms_rows_to_bf16<4>(xr, ww, orw, lane); }
          } else
          for (int m = gw; m < M; m += 4 * NGW) {
              const float* xr[4]; bf16* orw[4];
#pragma unroll
              for (int r = 0; r < 4; ++r) { const int mm = min(m + r * NGW, M - 1); xr[r] = mm < MP ? xp + (size_t)mm * D : xs + (size_t)(mm - MP) * D; orw[r] = XN + (size_t)mm * D; }
              rms_rows_to_bf16<4>(xr, ww, orw, lane); } }
    }
    unsigned* tcnt = ctl + CW_TB + 16 * (((bx & 7) << 3) | ((bx >> 3) & 7));
    if (full) { xcd_barrier_poll(bar, bgen); if (tid == 0) MISC[12] = xb_ld(&ctl[CW_NONCANON]); } else { SEAM(0); if (tid == 0) MISC[12] = 1u; }
    __syncthreads();
    const bool local_ok = (MISC[12] == 0u);
    const bool team_ok = local_ok && G == 256;
    unsigned lgen = 0u;
    if (full) { if (team_ok) team_barrier(tcnt, 0u, ctl + CW_BAR + XB_TMO); else xcd_barrier(bar); }
    if ((PROBE) == 100) { SEAM(0); SEAM(0); SEAM(0); SEAM(0); }
    if (IN(1)) REP(1) {
        pg8::Gemm g{XN, Win_t, M, INC, D}; pg8::StaticOrder S; S.init(M, INC, G, bx);
        EpiInProj E{Hb, NAb, lbp};
        pg8::gemm_phase<EpiInProj, pg8::StaticOrder, true, true>(lds + RING_OFF, g, S, E);
    }
    if (local_ok) { lgen = lb_arrive(bar, ctl); bgen = xcd_barrier_arrive(bar); lb_wait(bar, ctl, lgen); } else SEAM(1);
    if (wave >= 4) __builtin_amdgcn_s_setprio(1);
    if (IN(2)) {
        for (int rep_ = 0; rep_ < (((PROBE) == 20 || (PROBE) / 10 == 20) ? 2 : 1); ++rep_) for (int ch = vcu; ch < 256; ch += G) { const int dir = ch & 1, head = (ch >> 1) & 3, sg = ch >> 3;
            const int seq = sg < 16 ? sg >> 2 : 4 + ((sg - 16) >> 3), seg = sg < 16 ? sg & 3 : (sg - 16) & 7;
            const int s0 = seq < 4 ? seq * 4096 : MP + (seq - 4) * 8192;
            const int dm_ = (((PROBE) / 10 == 20 || (PROBE) == 20) && rep_ == 0) ? (1 | (((PROBE) / 10 == 20) ? ((PROBE) % 10) * 2 : 0)) : 0;
            if (dir) hgrn_chain<1>(lds, Hb, Hb + 2 * (size_t)M * GW, Hb + 3 * (size_t)M * GW, OBk + (size_t)head * ((size_t)M * 128), 128, s0, 16 * seg + 15, 16, head, SLb + (size_t)ch * 16384, Btb + ch * 128, dm_);
            else     hgrn_chain<0>(lds, Hb, Hb + (size_t)M * GW, Hb + 3 * (size_t)M * GW, Ob + head * 128, D, s0, 16 * seg, 16, head, SLb + (size_t)ch * 16384, Btb + ch * 128, dm_); }
        if (local_ok) xcd_barrier_wait(bar, bgen);
        if (team_ok) bgen = xcd_barrier_arrive(bar);
        REP(21) for (int ru = vcu; ru < 256; ru += G) { int seq, head, run;
            if (ru < 128) { seq = ru >> 5; head = (ru >> 2) & 7; run = ru & 3; } else { const int r2 = ru - 128, x2 = r2 >> 5, q2 = r2 & 31; seq = 4 + (x2 >> 1); head = q2 >> 2; run = 4 * (x2 & 1) + (q2 & 3); }
            const int s0 = seq < 4 ? seq * 4096 : MP + (seq - 4) * 8192, rows = seq < 4 ? 64 : 128;
            na_run(lds, NAb, NAb + (size_t)M * GW, NAb + 2 * (size_t)M * GW, qnw, knw, rpb, Ob, s0, rows, head, run * 16, 16); }
        if (team_ok) { __syncthreads(); if (tid == 0) (void)xb_add(&ctl[CW_NADONE], 1u); }
    }
    if (team_ok) {
        xcd_barrier_wait(bar, bgen);
        { const int xk = bx & 7, e_all = (bx >> 3) * (NWAVES * 64) + tid, seq = xk < 4 ? xk : 4 + ((xk - 4) >> 1);
          hgrn_scan(SLb, Btb, SFb, ((seq << 3) | (e_all >> 11)) * 2048 + (e_all & 2047), 1 << 30, xk); }
        lgen = lb_arrive(bar, ctl); lb_wait(bar, ctl, lgen);
    } else {
        SEAM(2);
        if (IN(3)) hgrn_scan(SLb, Btb, SFb, bx * (NWAVES * 64) + tid, G * NWAVES * 64);
        SEAM(3);
    }
    if (IN(4)) for (int rep_ = 0; rep_ < (((PROBE) == 4 || (PROBE) == 41 || (PROBE) == 42) ? 2 : 1); ++rep_) {
        const bool dry_ = ((PROBE) == 4 || (PROBE) == 41 || (PROBE) == 42) && rep_ == 0; const int mode_ = dry_ ? ((PROBE) == 41 ? 1 : ((PROBE) == 42 ? 2 : 0)) : 0;
        for (int un = vcu; un < 256; un += G) { const int half = un & 1, head = (un >> 1) & 3, sg = un >> 3;
            const int seq = sg < 16 ? sg >> 2 : 4 + ((sg - 16) >> 3), seg = sg < 16 ? sg & 3 : (sg - 16) & 7;
            const int s0 = seq < 4 ? seq * 4096 : MP + (seq - 4) * 8192;
            hgrn_pass2(lds, Hb + (size_t)M * GW, Hb + 2 * (size_t)M * GW, Hb + 4 * (size_t)M * GW, gnw, SFb, Ob, dry_ ? Hb + 3 * (size_t)M * GW : Ob, dry_ ? GW : D, OBk, s0, seg, sg, head, half, mode_); }
    }
    __builtin_amdgcn_s_setprio(0);
    SEAM_ARRIVE(4);
    if (team_ok) { if (tid == 0) XB_SPIN(xb_ld(&ctl[CW_NADONE]) < (unsigned)G, ctl + CW_BAR); __syncthreads(); }
    constexpr int I_G = (D / 64) * (FF / 32), I_D = (FF / 64) * (D / 32);
    if (IN(5)) {
        LAS float* scr = (LAS float*)(lds + RING_OFF + wave * 16384);
#define P5_LOAD(wv_, it_) do { if ((it_) < I_G) tr_load(wv_, w_gate, FF, (it_), lane); else if ((it_) < 2 * I_G) tr_load(wv_, w_up, FF, (it_) - I_G, lane); else tr_load(wv_, w_down, D, (it_) - 2 * I_G, lane); } while (0)
#define P5_FIN(wv_, it_) do { if ((it_) < I_G) tr_finish<1>(wv_, D, FF, Wgu_t, scr, (it_), lane, w_ffn); else if ((it_) < 2 * I_G) tr_finish<2>(wv_, D, FF, Wgu_t, scr, (it_) - I_G, lane, w_ffn); \
                else tr_finish<0>(wv_, FF, D, Wdown_t, scr, (it_) - 2 * I_G, lane); } while (0)
        for (int it = gw; it < 2 * I_G + I_D; it += 2 * NGW) { float wa[32], wb[32]; const bool two = it + NGW < 2 * I_G + I_D;
            P5_LOAD(wa, it); if (two) P5_LOAD(wb, it + NGW);
            P5_FIN(wa, it); if (two) P5_FIN(wb, it + NGW); }
#undef P5_LOAD
#undef P5_FIN
    }
    SEAM_WAIT(4);
    if (local_ok) bgen = xcd_barrier_arrive(bar);
    if (IN(5)) REP(5) {
        pg8::Gemm g{Ob, Wout_t, M, D, D}; pg8::StaticOrder S; S.init(M, D, G, bx);
        EpiOutProj E{xp, xs, X1b, ssq};
        pg8::gemm_phase<EpiOutProj, pg8::StaticOrder, true, true>(lds + RING_OFF, g, S, E);
        __syncthreads(); if (tid == 0) (void)xb_add(&ctl[CW_P5DONE], 1u);
    }
    if (team_ok) { xcd_barrier_poll(bar, bgen); team_barrier(tcnt, 1u, ctl + CW_BAR + XB_TMO); }
    else if (local_ok) { lgen = lb_arrive(bar, ctl); lb_wait(bar, ctl, lgen); xcd_barrier_wait(bar, bgen); } else SEAM(5);
    if (IN(6)) REP(6) {
        pg8::Gemm g{X1b, Wgu_t, M, 2 * FF, D}; pg8::StaticOrder S; S.init(M, 2 * FF, G, bx);
        EpiGateUp E{HFF, ssq, ctl + CW_P5DONE, full ? (unsigned)G : 0u, false};
        pg8::gemm_phase<EpiGateUp, pg8::StaticOrder, true, true>(lds + RING_OFF, g, S, E);
        __syncthreads(); if (tid == 0) (void)xb_add(&ctl[CW_P6DONE], 1u);
    }
    if (team_ok) team_barrier(tcnt, 2u, ctl + CW_BAR + XB_TMO);
    else if (local_ok) { lgen = lb_arrive(bar, ctl); lb_wait(bar, ctl, lgen); } else SEAM(6);
    if (IN(7)) REP(7) {
        pg8::Gemm g{HFF, Wdown_t, M, D, FF}; pg8::StaticOrder S; S.init(M, D, G, bx);
        EpiDown E{out, X1b, ctl + CW_P6DONE, full ? (unsigned)G : 0u, false};
        pg8::gemm_phase<EpiDown, pg8::StaticOrder, true, true>(lds + RING_OFF, g, S, E);
    }
#undef IN
#undef SEAM
}

#ifndef N_LAUNCHES
#define N_LAUNCHES 1
#endif
extern "C" void kernel_launch(void* const* d_in, const int* in_sizes, int n_in, void* d_out, int out_size, void* d_ws, size_t ws_size, hipStream_t stream) {
    static int grid = 0;
    if (grid == 0) {
        if (n_in != 14 || out_size != 2 * MP * D || ws_size < WS_END) { fprintf(stderr, "kernel_launch: unexpected shapes (n_in %d out %d ws %zu)\n", n_in, out_size, ws_size); grid = -1; return; }
        int dev = 0, cus = 0;
        if (hipGetDevice(&dev) != hipSuccess || hipDeviceGetAttribute(&cus, hipDeviceAttributeMultiprocessorCount, dev) != hipSuccess) { grid = -1; return; }
        if (hipFuncSetAttribute((const void*)fwd_kernel, hipFuncAttributeMaxDynamicSharedMemorySize, LDS_BYTES) != hipSuccess) { fprintf(stderr, "kernel_launch: hipFuncSetAttribute failed\n"); grid = -1; return; }
        grid = cus;
    }
    if (grid < 0) return;
    (void)hipMemsetAsync((char*)d_ws + WS_CTL, 0, CTL_ZERO_BYTES, stream);
    Args a{};
    for (int i = 0; i < 14; ++i) a.in[i] = (const float*)d_in[i];
    a.out = (float*)d_out; a.ws = (unsigned char*)d_ws;
    if (N_LAUNCHES == 1) { a.ph_lo = 0; a.ph_hi = N_PHASES; hipLaunchKernelGGL(fwd_kernel, dim3(grid), dim3(NWAVES * 64), LDS_BYTES, stream, a); }
    else for (int p = 0; p < N_PHASES; ++p) { a.ph_lo = p; a.ph_hi = p + 1; hipLaunchKernelGGL(fwd_kernel, dim3(grid), dim3(NWAVES * 64), LDS_BYTES, stream, a); }
}
```

```cpp
#include <hip/hip_runtime.h>
#include <cstdio>
#include <cstdint>
namespace pg8 {
#define PG8_LAS __attribute__((address_space(3)))
typedef unsigned short bf16_t;
typedef short bf16x8 __attribute__((ext_vector_type(8)));
typedef float f32x4 __attribute__((ext_vector_type(4)));
typedef unsigned u32x4 __attribute__((ext_vector_type(4)));
constexpr int BM = 256, BK = 64, HALF = 128, HTB = HALF * BK * 2  , STAGE_BYTES = 8 * HTB, NXCD = 8, WGM = 8;

__host__ __device__ __forceinline__ int lds_byte(int r, int c) { const int st = (r >> 4) * 2 + (c >> 5), rr = r & 15, cc = c & 31, ob = rr * 64 + cc * 2; return st * 1024 + (ob ^ (((ob >> 9) & 1) << 5)); }
__host__ __device__ __forceinline__ void stage_rc(int b, int& R, int& C) { const int st = b / 1024, sb = b % 1024, swz = sb ^ (((sb >> 9) & 1) << 5); R = (st >> 1) * 16 + swz / 64; C = (st & 1) * 32 + (swz % 64) / 2; }
__host__ __device__ __forceinline__ int perm32(int rho) { const int n = rho >> 4, i = rho & 15; return 8 * (i >> 2) + 4 * n + (i & 3); }

struct Unit { int pm, pn; };
struct Gemm { const bf16_t* A; const bf16_t* Bt; int M, N, K; };

struct StaticOrder {
    int nM, nN, nwg, G, c;
    __host__ __device__ void init(int M, int N, int G_, int c_) { nM = M / BM; nN = N / BM; nwg = nM * nN; G = G_; c = c_; }
    __host__ __device__ bool next(int i, Unit& u) const {
        const long L = (long)i * G + c; if (L >= nwg) return false;
        int wgid = (int)L; { const int q = nwg / NXCD, r = nwg % NXCD, xcd = wgid % NXCD, off = wgid / NXCD; wgid = (xcd < r ? xcd * (q + 1) : r * (q + 1) + (xcd - r) * q) + off; }
        const int nig = WGM * nN, gid = wgid / nig, fm = gid * WGM, gsz = (nM - fm) < WGM ? (nM - fm) : WGM;
        u.pm = fm + ((wgid % nig) % gsz); u.pn = (wgid % nig) / gsz; return true;
    }
    __device__ __forceinline__ void a_ready(const Unit&) const {}
    __device__ __forceinline__ void done(const Unit&) const {}
};

__device__ __forceinline__ unsigned cvt_pk_bf16(float lo, float hi) { unsigned r; asm volatile("v_cvt_pk_bf16_f32 %0, %1, %2" : "=v"(r) : "v"(lo), "v"(hi)); return r; }
template <class Epi, class Sched, bool ALIGN_EPI = false, bool SP2 = false>
__device__ __forceinline__ void gemm_phase(PG8_LAS unsigned char* lds, const Gemm g, const Sched& S, const Epi& E) {
    const int tid = threadIdx.x, wid = __builtin_amdgcn_readfirstlane(tid >> 6), lane = tid & 63, wr = wid >> 2, wc = wid & 3, fr = lane & 15, fq = lane >> 4;
    const int K = g.K, nt = K / BK;
    unsigned voffA[2], voffB[2];
#pragma unroll
    for (int i = 0; i < 2; ++i) { int R, C; stage_rc(tid * 16 + i * 8192, R, C); const int Rb = Epi::PERM ? ((R & ~31) + perm32(R & 31)) : R;
        voffA[i] = (unsigned)(R * K + C) * 2u; voffB[i] = (unsigned)(Rb * K + C) * 2u; }
    const size_t kstep = (size_t)(BK * 2);
    const size_t hstep = (size_t)HALF * K * 2;
    const size_t tstep = 2 * hstep;
    const unsigned ldsw = (unsigned)wid * 1024u;
    const int aoff = lds_byte(wr * 64 + fr, fq * 8), boff = lds_byte(wc * 32 + fr, fq * 8);
#define PG8_SA(b, h) (((b) * 2 + (h)) * HTB)
#define PG8_SB(b, h) ((4 + (b) * 2 + (h)) * HTB)
#define PG8_STAGE(bufoff, gbase, voff) do { _Pragma("unroll") for (int _i = 0; _i < 2; ++_i) \
        __builtin_amdgcn_global_load_lds((const unsigned*)((const char*)(gbase) + (voff)[_i]), (PG8_LAS unsigned*)(lds + (bufoff) + ldsw + _i * 8192), 16, 0, 0); } while (0)
#define PG8_LDA(dst, b, h) do { _Pragma("unroll") for (int m = 0; m < 4; ++m) _Pragma("unroll") for (int k = 0; k < 2; ++k) dst[m][k] = *(const PG8_LAS bf16x8*)(lds + PG8_SA(b, h) + aoff + m * 2048 + k * 1024); } while (0)
#define PG8_LDB(dst, b, h) do { _Pragma("unroll") for (int n = 0; n < 2; ++n) _Pragma("unroll") for (int k = 0; k < 2; ++k) dst[n][k] = *(const PG8_LAS bf16x8*)(lds + PG8_SB(b, h) + boff + n * 2048 + k * 1024); } while (0)
#define PG8_MMA(ai, bj, At, Bt) do { __builtin_amdgcn_s_setprio(1); _Pragma("unroll") for (int m = 0; m < 4; ++m) _Pragma("unroll") for (int n = 0; n < 2; ++n) _Pragma("unroll") for (int k = 0; k < 2; ++k) \
        acc[ai][bj][m][n] = __builtin_amdgcn_mfma_f32_16x16x32_bf16(Bt[n][k], At[m][k], acc[ai][bj][m][n], 0, 0, 0); __builtin_amdgcn_s_setprio(0); } while (0)
#define PG8_WAIT_V(n) asm volatile("s_waitcnt vmcnt(" #n ")" ::: "memory")
#define PG8_WAIT_L(n) asm volatile("s_waitcnt lgkmcnt(" #n ")" ::: "memory")
#define PG8_BAR __builtin_amdgcn_s_barrier()
#define PG8_SCHED __builtin_amdgcn_sched_barrier(0)
    Unit cur, nxt; int ui = 0;
    if (!S.next(0, cur)) return;
    f32x4 acc[2][2][4][2];
#pragma unroll
    for (int a = 0; a < 2; ++a)
#pragma unroll
        for (int b = 0; b < 2; ++b)
#pragma unroll
            for (int m = 0; m < 4; ++m)
#pragma unroll
                for (int n = 0; n < 2; ++n) acc[a][b][m][n] = (f32x4){0.f, 0.f, 0.f, 0.f};
    bf16x8 At[4][2], B0[2][2], B1[2][2];
    const char* cA = (const char*)g.A + (size_t)cur.pm * tstep; const char* cB = (const char*)g.Bt + (size_t)cur.pn * tstep;
    S.a_ready(cur);
    if constexpr (SP2) {
        PG8_STAGE(PG8_SB(0, 0), cB, voffB); PG8_STAGE(PG8_SB(0, 1), cB + hstep, voffB); PG8_STAGE(PG8_SA(0, 0), cA, voffA); PG8_STAGE(PG8_SA(0, 1), cA + hstep, voffA);
        if (wr == 1) PG8_BAR;
        PG8_WAIT_V(2); PG8_BAR;
        PG8_STAGE(PG8_SB(1, 0), cB + kstep, voffB); PG8_STAGE(PG8_SA(1, 0), cA + kstep, voffA); PG8_STAGE(PG8_SB(1, 1), cB + hstep + kstep, voffB);
        PG8_WAIT_V(6); PG8_BAR;
    } else {
        PG8_STAGE(PG8_SB(0, 0), cB, voffB); PG8_STAGE(PG8_SA(0, 0), cA, voffA); PG8_STAGE(PG8_SB(0, 1), cB + hstep, voffB); PG8_STAGE(PG8_SA(0, 1), cA + hstep, voffA);
        if (wr == 1) PG8_BAR;
        PG8_WAIT_V(4); PG8_BAR;
        PG8_STAGE(PG8_SB(1, 0), cB + kstep, voffB); PG8_STAGE(PG8_SA(1, 0), cA + kstep, voffA); PG8_STAGE(PG8_SB(1, 1), cB + hstep + kstep, voffB);
        PG8_WAIT_V(6); PG8_BAR;
    }
    for (;;) {
        const bool has_next = S.next(ui + 1, nxt);
        const char* nA = has_next ? (const char*)g.A + (size_t)nxt.pm * tstep : cA; const char* nB = has_next ? (const char*)g.Bt + (size_t)nxt.pn * tstep : cB;
        for (int t = 0; t < nt; t += 2) {
            const bool last = (t == nt - 2);
            const char* a1 = cA + (size_t)(t + 1) * kstep;
            const char* a2 = last ? nA : cA + (size_t)(t + 2) * kstep; const char* b2 = last ? nB : cB + (size_t)(t + 2) * kstep;
            const char* a3 = a2 + kstep; const char* b3 = b2 + kstep;
            if (last && has_next) S.a_ready(nxt);
            if constexpr (SP2) {
            PG8_LDB(B0, 0, 0); PG8_LDB(B1, 0, 1); PG8_SCHED; PG8_LDA(At, 0, 0); PG8_STAGE(PG8_SA(1, 1), a1 + hstep, voffA);
            PG8_WAIT_V(8); PG8_WAIT_L(0); PG8_BAR; PG8_MMA(0, 0, At, B0); PG8_MMA(0, 1, At, B1); PG8_BAR; PG8_SCHED;
            PG8_LDA(At, 0, 1); PG8_STAGE(PG8_SB(0, 0), b2, voffB); PG8_STAGE(PG8_SB(0, 1), b2 + hstep, voffB); PG8_STAGE(PG8_SA(0, 0), a2, voffA);
            PG8_WAIT_V(8); PG8_WAIT_L(0); PG8_BAR; PG8_MMA(1, 0, At, B0); PG8_MMA(1, 1, At, B1); PG8_BAR; PG8_SCHED;
            PG8_LDB(B0, 1, 0); PG8_LDB(B1, 1, 1); PG8_SCHED; PG8_LDA(At, 1, 0); PG8_STAGE(PG8_SA(0, 1), a2 + hstep, voffA);
            PG8_WAIT_V(8); PG8_WAIT_L(0); PG8_BAR; PG8_MMA(0, 0, At, B0); PG8_MMA(0, 1, At, B1); PG8_BAR; PG8_SCHED;
            PG8_LDA(At, 1, 1); PG8_STAGE(PG8_SB(1, 0), b3, voffB); PG8_STAGE(PG8_SB(1, 1), b3 + hstep, voffB); PG8_STAGE(PG8_SA(1, 0), a3, voffA);
            PG8_WAIT_V(8); PG8_WAIT_L(0); PG8_BAR; PG8_MMA(1, 0, At, B0); PG8_MMA(1, 1, At, B1); PG8_BAR; PG8_SCHED;
            } else {
            PG8_LDB(B0, 0, 0); PG8_SCHED; PG8_LDA(At, 0, 0); PG8_STAGE(PG8_SA(1, 1), a1 + hstep, voffA);
            PG8_WAIT_L(8); PG8_BAR; PG8_WAIT_L(0); PG8_MMA(0, 0, At, B0); PG8_BAR; PG8_SCHED;
            PG8_LDB(B1, 0, 1); PG8_STAGE(PG8_SB(0, 0), b2, voffB);
            PG8_BAR; PG8_WAIT_L(0); PG8_MMA(0, 1, At, B1); PG8_BAR;
            PG8_LDA(At, 0, 1); PG8_STAGE(PG8_SA(0, 0), a2, voffA);
            PG8_BAR; PG8_WAIT_L(0); PG8_MMA(1, 0, At, B0); PG8_BAR; PG8_SCHED;
            PG8_STAGE(PG8_SB(0, 1), b2 + hstep, voffB);
            PG8_WAIT_V(6); PG8_BAR; PG8_MMA(1, 1, At, B1); PG8_BAR;
            PG8_LDB(B0, 1, 0); PG8_SCHED; PG8_LDA(At, 1, 0); PG8_STAGE(PG8_SA(0, 1), a2 + hstep, voffA);
            PG8_WAIT_L(8); PG8_BAR; PG8_WAIT_L(0); PG8_MMA(0, 0, At, B0); PG8_BAR; PG8_SCHED;
            PG8_LDB(B1, 1, 1); PG8_STAGE(PG8_SB(1, 0), b3, voffB);
            PG8_BAR; PG8_WAIT_L(0); PG8_MMA(0, 1, At, B1); PG8_BAR;
            PG8_LDA(At, 1, 1); PG8_STAGE(PG8_SA(1, 0), a3, voffA);
            PG8_BAR; PG8_WAIT_L(0); PG8_MMA(1, 0, At, B0); PG8_BAR; PG8_SCHED;
            PG8_STAGE(PG8_SB(1, 1), b3 + hstep, voffB);
            PG8_WAIT_V(6); PG8_BAR; PG8_MMA(1, 1, At, B1); PG8_BAR;
            }
        }
        if constexpr (ALIGN_EPI) { if (wr == 0) PG8_BAR; }
        if constexpr (!Epi::AFTER_DRAIN) { E(acc, cur, wr, wc, fr, fq); S.done(cur); }
        if (!has_next) break;
#pragma unroll
        for (int a = 0; a < 2; ++a)
#pragma unroll
            for (int b = 0; b < 2; ++b)
#pragma unroll
                for (int m = 0; m < 4; ++m)
#pragma unroll
                    for (int n = 0; n < 2; ++n) acc[a][b][m][n] = (f32x4){0.f, 0.f, 0.f, 0.f};
        cur = nxt; cA = nA; cB = nB; ++ui;
        if constexpr (ALIGN_EPI) { if (wr == 1) PG8_BAR; }
    }
    PG8_WAIT_V(0);
    if constexpr (!ALIGN_EPI) { if (wr == 0) PG8_BAR; }
    PG8_BAR;
    if constexpr (Epi::AFTER_DRAIN) { E.fused(acc, cur, wr, wc, fr, fq, lds, wid, lane); S.done(cur); }
#undef PG8_SA
#undef PG8_SB
#undef PG8_STAGE
#undef PG8_LDA
#undef PG8_LDB
#undef PG8_MMA
#undef PG8_WAIT_V
#undef PG8_WAIT_L
#undef PG8_BAR
#undef PG8_SCHED
}
}

#ifndef PROBE
#define PROBE -1
#endif

constexpr int NWAVES = 8;
constexpr int M = 32768, MP = 16384, D = 1024, INC = 4096, FF = 2816, GW = 512;
constexpr float EPS = 1e-6f;
constexpr size_t MiB = 1u << 20;
constexpr size_t WS_CTL = 0, CTL_BYTES = 1 * MiB, CTL_ZERO_BYTES = 32768;
constexpr size_t WS_WIN = 1 * MiB;
constexpr size_t WS_WOUT = 9 * MiB;
constexpr size_t WS_WGU = 11 * MiB;
constexpr size_t WS_WDOWN = 22 * MiB;
constexpr size_t WS_A = 28 * MiB;
constexpr size_t WS_O = 92 * MiB;
constexpr size_t WS_H = 156 * MiB;
constexpr size_t WS_SL = 316 * MiB;
constexpr size_t WS_SF = 332 * MiB;
constexpr size_t WS_X1 = 340 * MiB;
constexpr size_t WS_HFF = WS_H;
constexpr size_t WS_END = 404 * MiB;
static_assert(WS_HFF + (size_t)M * FF * 2 <= WS_SF && WS_SL + 16 * MiB <= WS_SF, "ws map");
constexpr int CW_BAR = 4096;
constexpr int CW_LB = 0;
constexpr int CW_NONCANON = 3072;
constexpr int CW_TB = 2048;
constexpr int CW_P5DONE = 3264;
constexpr int CW_P6DONE = 3328;
constexpr int CW_NADONE = 3200;
constexpr int CW_XMAP = 3136;
constexpr int CW_RSTD0 = 98304;
constexpr int CW_SSQ = 65536;
constexpr int CW_BT = 131072;
static_assert((CW_SSQ + M) <= CW_BT && (CW_BT + 256 * 128) * 4 <= (int)CTL_BYTES && (CW_BAR + 3456) * 4 <= (int)CTL_ZERO_BYTES, "ctl");
constexpr int RING_OFF = 0, RING_BYTES = 131072;
constexpr int LDS_BYTES = 163840;
constexpr int LDSCTL_OFF = 159744, MISC_OFF = LDSCTL_OFF + 320;

#define GAS __attribute__((address_space(1)))
#define LAS __attribute__((address_space(3)))
typedef unsigned short bf16;
typedef unsigned v4u __attribute__((ext_vector_type(4)));
typedef unsigned v2u __attribute__((ext_vector_type(2)));
typedef float f32x4 __attribute__((ext_vector_type(4)));
typedef float f32x2 __attribute__((ext_vector_type(2)));
#define LDS_WAIT() asm volatile("s_waitcnt lgkmcnt(0)" ::: "memory")
#define VM_WAIT() asm volatile("s_waitcnt vmcnt(0)" ::: "memory")
__device__ __forceinline__ unsigned f2bf(float f) { unsigned u = __builtin_bit_cast(unsigned, f); return (u + 0x7fffu + ((u >> 16) & 1u)) >> 16; }
__device__ __forceinline__ unsigned pk2(float lo, float hi) { return f2bf(lo) | (f2bf(hi) << 16); }
__device__ __forceinline__ float bflo(unsigned w) { return __builtin_bit_cast(float, w << 16); }
__device__ __forceinline__ float bfhi(unsigned w) { return __builtin_bit_cast(float, w & 0xffff0000u); }
typedef float f32x2_t __attribute__((ext_vector_type(2))); typedef __bf16 bf16x2_t __attribute__((ext_vector_type(2)));
__device__ __forceinline__ unsigned cvtpk(float lo, float hi) { f32x2_t v = {lo, hi}; bf16x2_t b = __builtin_convertvector(v, bf16x2_t); return __builtin_bit_cast(unsigned, b); }
__device__ __forceinline__ float ex2_(float x) { return __builtin_amdgcn_exp2f(x); }
__device__ __forceinline__ float rcp_(float x) { return __builtin_amdgcn_rcpf(x); }
__device__ __forceinline__ float rsq_(float x) { return __builtin_amdgcn_rsqf(x); }
template <int CTRL> __device__ __forceinline__ float dpp_(float v) { return __builtin_bit_cast(float, __builtin_amdgcn_update_dpp(0, __builtin_bit_cast(int, v), CTRL, 0xF, 0xF, false)); }
__device__ __forceinline__ float sum8_(float v) { v += dpp_<0xB1>(v); v += dpp_<0x4E>(v); v += dpp_<0x141>(v); return v; }
__device__ __forceinline__ float sum16_(float v) { v = sum8_(v); v += dpp_<0x140>(v); return v; }
__device__ __forceinline__ float sigmoidf_(float x) { return rcp_(1.f + ex2_(-1.44269504089f * x)); }
__device__ __forceinline__ float siluf_(float x) { return x * rcp_(1.f + ex2_(-1.44269504089f * x)); }

#define XB_TMO      128
#define XB_XCNT(j)  (256  + 64 * (j))
#define XB_XSUB(j)  (1280 + 64 * (j))
#define XB_XGEN(j)  (2304 + 64 * (j))
#define XB_TOP      3328
#define XB_TOPGEN   3392
#define XCD_BAR_WORDS 3456
#define XB_SPIN_CAP (1u << 18)
__device__ __forceinline__ unsigned xb_ld(unsigned* p)              { return __hip_atomic_load(p, __ATOMIC_RELAXED, __HIP_MEMORY_SCOPE_AGENT); }
__device__ __forceinline__ unsigned xb_add(unsigned* p, unsigned v) { return __hip_atomic_fetch_add(p, v, __ATOMIC_RELAXED, __HIP_MEMORY_SCOPE_AGENT); }
__device__ __forceinline__ unsigned xb_xcc_id() { return (unsigned)__builtin_amdgcn_s_getreg((3 << 11) | 20) & 0xFu; }
#define XB_SPIN(cond, bar) do { unsigned _sp = 0; while (cond) { __builtin_amdgcn_s_sleep(1); \
    if ((++_sp & 255u) == 0u) { if (xb_ld(&(bar)[XB_TMO])) break; if (_sp > XB_SPIN_CAP) { atomicAdd(&(bar)[XB_TMO], 1u); break; } } } } while (0)
struct XcdBarrier { unsigned* bar; unsigned x; volatile LAS unsigned* st; };
__device__ __forceinline__ XcdBarrier xcd_barrier_post(unsigned* bar, volatile LAS unsigned* st) {
    XcdBarrier b; b.bar = bar; b.x = xb_xcc_id(); b.st = st;
    if (threadIdx.x == 0) (void)xb_add(&bar[XB_XCNT(b.x)], 1u);
    return b;
}
__device__ __forceinline__ void xcd_barrier_complete(unsigned* bar, unsigned x, unsigned& nloc, unsigned& nx) {
    const unsigned G = gridDim.x * gridDim.y * gridDim.z;
    unsigned sum, cnt, mine, sp = 0u;
    for (;;) {
        sum = 0u; cnt = 0u; mine = 0u;
#pragma unroll
        for (unsigned j = 0; j < 16; ++j) { const unsigned c = xb_ld(&bar[XB_XCNT(j)]); sum += c; cnt += (c > 0u) ? 1u : 0u; mine = (j == x) ? c : mine; }
        if (sum == G) break;
        __builtin_amdgcn_s_sleep(1);
        if ((++sp & 255u) == 0u) { if (xb_ld(&bar[XB_TMO])) break; if (sp > XB_SPIN_CAP) { atomicAdd(&bar[XB_TMO], 1u); break; } }
    }
    nloc = mine > 0u ? mine : 1u; nx = cnt > 0u ? cnt : 1u;
}
__device__ __forceinline__ void xcd_barrier(const XcdBarrier& b) {
    asm volatile("s_waitcnt vmcnt(0)" ::: "memory");
    __syncthreads();
    if (threadIdx.x == 0) {
        unsigned* bar = b.bar;
        __builtin_amdgcn_s_waitcnt(0);
        unsigned nloc = b.st[0], nx = b.st[1];
        if (nloc == 0u) { xcd_barrier_complete(bar, b.x, nloc, nx); b.st[0] = nloc; b.st[1] = nx; }
        const unsigned old = xb_add(&bar[XB_XSUB(b.x)], 1u);
        const unsigned gen = old / nloc;
        if (old + 1u == (gen + 1u) * nloc) {
            __builtin_amdgcn_fence(__ATOMIC_RELEASE, "agent");
            asm volatile("s_waitcnt vmcnt(0)" ::: "memory");
            const unsigned og = xb_add(&bar[XB_TOP], 1u);
            const unsigned tg = og / nx;
            if (og + 1u == (tg + 1u) * nx) xb_add(&bar[XB_TOPGEN], 1u);
            else XB_SPIN(xb_ld(&bar[XB_TOPGEN]) == tg, bar);
            __builtin_amdgcn_fence(__ATOMIC_ACQUIRE, "agent");
            xb_add(&bar[XB_XGEN(b.x)], 1u);
            asm volatile("s_waitcnt vmcnt(0)" ::: "memory");
        } else {
            XB_SPIN(xb_ld(&bar[XB_XGEN(b.x)]) == gen, bar);
            __builtin_amdgcn_fence(__ATOMIC_ACQUIRE, "agent");
            asm volatile("s_waitcnt vmcnt(0)" ::: "memory");
        }
    }
    __syncthreads();
}

__device__ __forceinline__ unsigned xcd_barrier_arrive(const XcdBarrier& b) {
    unsigned gen = 0u;
    asm volatile("s_waitcnt vmcnt(0)" ::: "memory");
    __syncthreads();
    if (threadIdx.x == 0) {
        unsigned* bar = b.bar;
        __builtin_amdgcn_s_waitcnt(0);
        unsigned nloc = b.st[0], nx = b.st[1];
        if (nloc == 0u) { xcd_barrier_complete(bar, b.x, nloc, nx); b.st[0] = nloc; b.st[1] = nx; }
        const unsigned old = xb_add(&bar[XB_XSUB(b.x)], 1u);
        gen = old / nloc;
        if (old + 1u == (gen + 1u) * nloc) {
            __builtin_amdgcn_fence(__ATOMIC_RELEASE, "agent");
            asm volatile("s_waitcnt vmcnt(0)" ::: "memory");
            const unsigned og = xb_add(&bar[XB_TOP], 1u);
            const unsigned tg = og / nx;
            if (og + 1u == (tg + 1u) * nx) xb_add(&bar[XB_TOPGEN], 1u);
            xb_add(&bar[XB_XGEN(b.x)], 1u);
        }
    }
    return gen;
}
__device__ __forceinline__ void xcd_barrier_poll(const XcdBarrier& b, unsigned gen) {
    if (threadIdx.x == 0) { unsigned* bar = b.bar; XB_SPIN(xb_ld(&bar[XB_TOPGEN]) == gen, bar); }
}
__device__ __forceinline__ void xcd_barrier_wait(const XcdBarrier& b, unsigned gen) {
    if (threadIdx.x == 0) {
        unsigned* bar = b.bar;
        XB_SPIN(xb_ld(&bar[XB_TOPGEN]) == gen, bar);
        __builtin_amdgcn_fence(__ATOMIC_ACQUIRE, "agent");
        asm volatile("s_waitcnt vmcnt(0)" ::: "memory");
    }
    __syncthreads();
}

#define XL_SUB(j) (CW_LB + 64 * (j))
#define XL_GEN(j) (CW_LB + 1024 + 64 * (j))
__device__ __forceinline__ unsigned lb_arrive(const XcdBarrier& b, unsigned* ctl) {
    unsigned gen = 0u;
    asm volatile("s_waitcnt vmcnt(0)" ::: "memory");
    __syncthreads();
    if (threadIdx.x == 0) {
        __builtin_amdgcn_s_waitcnt(0);
        const unsigned nloc = b.st[0];
        const unsigned old = xb_add(&ctl[XL_SUB(b.x)], 1u);
        gen = old / nloc;
        if (old + 1u == (gen + 1u) * nloc) xb_add(&ctl[XL_GEN(b.x)], 1u);
    }
    return gen;
}
__device__ __forceinline__ void lb_wait(const XcdBarrier& b, unsigned* ctl, unsigned gen) {
    if (threadIdx.x == 0) {
        XB_SPIN(xb_ld(&ctl[XL_GEN(b.x)]) == gen, b.bar);
        __builtin_amdgcn_fence(__ATOMIC_ACQUIRE, "agent");
        asm volatile("s_waitcnt vmcnt(0)" ::: "memory");
    }
    __syncthreads();
}

__device__ __forceinline__ void team_barrier(unsigned* cnt, unsigned gen, unsigned* tmo) {
    asm volatile("s_waitcnt vmcnt(0)" ::: "memory");
    __syncthreads();
    if (threadIdx.x == 0) {
        __builtin_amdgcn_s_waitcnt(0);
        (void)xb_add(cnt, 1u);
        XB_SPIN(xb_ld(cnt) < 4u * (gen + 1u), tmo - XB_TMO);
        __builtin_amdgcn_fence(__ATOMIC_ACQUIRE, "agent");
        asm volatile("s_waitcnt vmcnt(0)" ::: "memory");
    }
    __syncthreads();
}

struct EpiInProj {
    static constexpr bool PERM = true, AFTER_DRAIN = false;
    bf16* hbase; bf16* nabase; const float* lbp; const float* rstd0;
    __device__ __forceinline__ void operator()(const pg8::f32x4 (&acc)[2][2][4][2], const pg8::Unit& u, int wr, int wc, int fr, int fq) const {
        const int ot = u.pn;
        const int grp = ot >> 1;
        bf16* base = grp < 5 ? hbase + (size_t)grp * ((size_t)M * GW) : nabase + (size_t)(grp - 5) * ((size_t)M * GW);
        const int row0 = u.pm * 256 + wr * 64 + fr;
        const int col0 = (ot & 1) * 256 + wc * 32 + 8 * fq;
        float rs_[2][4];
#pragma unroll
        for (int ai = 0; ai < 2; ++ai)
#pragma unroll
            for (int m = 0; m < 4; ++m) rs_[ai][m] = rstd0[row0 + ai * 128 + m * 16];
        float lb[2][8];
#pragma unroll
        for (int bj = 0; bj < 2; ++bj)
#pragma unroll
            for (int e = 0; e < 8; ++e) lb[bj][e] = 0.f;
        if (grp == 1 || grp == 2) {
#pragma unroll
            for (int bj = 0; bj < 2; ++bj)
#pragma unroll
                for (int e = 0; e < 8; ++e) { const int c = (grp - 1) * GW + col0 + bj * 128 + e; lb[bj][e] = rcp_(1.f + ex2_(1.44269504089f * (lbp[1024 + c] - lbp[c]))); }
        }
#pragma unroll
        for (int ai = 0; ai < 2; ++ai)
#pragma unroll
            for (int m = 0; m < 4; ++m) { const size_t row = (size_t)(row0 + ai * 128 + m * 16);
#pragma unroll
                for (int bj = 0; bj < 2; ++bj) {
                    float v[8];
#pragma unroll
                    for (int e = 0; e < 4; ++e) { v[e] = acc[ai][bj][m][0][e] * rs_[ai][m]; v[4 + e] = acc[ai][bj][m][1][e] * rs_[ai][m]; }
                    if (grp == 0 || grp == 4) {
#pragma unroll
                        for (int e = 0; e < 8; ++e) v[e] = siluf_(v[e]);
                    } else if (grp == 1 || grp == 2) {
#pragma unroll
                        for (int e = 0; e < 8; ++e) v[e] = __builtin_amdgcn_logf(lb[bj][e] + (1.f - lb[bj][e]) * sigmoidf_(v[e]));
                    }
                    pg8::u32x4 w; w.x = cvtpk(v[0], v[1]); w.y = cvtpk(v[2], v[3]); w.z = cvtpk(v[4], v[5]); w.w = cvtpk(v[6], v[7]);
                    bf16* dst = grp < 5 ? base + (size_t)((ot & 1) * 2 + bj) * ((size_t)M * 128) + row * 128 + wc * 32 + 8 * fq
                                        : base + (size_t)((ot & 1) * 4 + bj * 2 + (wc >> 1)) * ((size_t)M * 64) + row * 64 + (wc & 1) * 32 + 8 * fq;
                    *(pg8::u32x4*)dst = w; } }
    }
};
struct EpiOutProj {
    static constexpr bool PERM = true, AFTER_DRAIN = false;
    const bf16* xb; bf16* x1b; float* ssq;
    __device__ __forceinline__ void operator()(const pg8::f32x4 (&acc)[2][2][4][2], const pg8::Unit& u, int wr, int wc, int fr, int fq) const {
        const int row0 = u.pm * 256 + wr * 64 + fr, col0 = u.pn * 256 + wc * 32 + 8 * fq;
        const bf16* xbase = xb + (size_t)row0 * D + col0;
#pragma unroll
        for (int ai = 0; ai < 2; ++ai) {
            pg8::u32x4 xw[4][2];
#pragma unroll
            for (int m = 0; m < 4; ++m)
#pragma unroll
                for (int bj = 0; bj < 2; ++bj) xw[m][bj] = __builtin_nontemporal_load((const pg8::u32x4*)(xbase + (size_t)(ai * 128 + m * 16) * D + bj * 128));
            __builtin_amdgcn_sched_barrier(0);
            float sq4[4];
#pragma unroll
            for (int m = 0; m < 4; ++m) { const int row = row0 + ai * 128 + m * 16;
                bf16* nrow = x1b + (size_t)row * D + col0;
                float sq = 0.f;
#pragma unroll
                for (int bj = 0; bj < 2; ++bj) {
                    const pg8::u32x4 x_ = xw[m][bj];
                    pg8::f32x4 a0 = acc[ai][bj][m][0], a1 = acc[ai][bj][m][1];
                    a0[0] += bflo(x_.x); a0[1] += bfhi(x_.x); a0[2] += bflo(x_.y); a0[3] += bfhi(x_.y); a1[0] += bflo(x_.z); a1[1] += bfhi(x_.z); a1[2] += bflo(x_.w); a1[3] += bfhi(x_.w);
                    sq += (a0[0] * a0[0] + a0[1] * a0[1]) + (a0[2] * a0[2] + a0[3] * a0[3]) + (a1[0] * a1[0] + a1[1] * a1[1]) + (a1[2] * a1[2] + a1[3] * a1[3]);
                    pg8::u32x4 w; w.x = cvtpk(a0[0], a0[1]); w.y = cvtpk(a0[2], a0[3]); w.z = cvtpk(a1[0], a1[1]); w.w = cvtpk(a1[2], a1[3]);
                    *(pg8::u32x4*)(nrow + bj * 128) = w; }
                sq4[m] = sq; }
#pragma unroll
            for (int m = 0; m < 4; ++m) sq4[m] += __shfl_xor(sq4[m], 16);
#pragma unroll
            for (int m = 0; m < 4; ++m) sq4[m] += __shfl_xor(sq4[m], 32);
            if (fq == 0) {
#pragma unroll
                for (int m = 0; m < 4; ++m) atomicAdd(ssq + row0 + ai * 128 + m * 16, sq4[m]); }
            __builtin_amdgcn_sched_barrier(0);
        }
    }
};
struct EpiGateUp {
    static constexpr bool PERM = true, AFTER_DRAIN = false;
    bf16* h; const float* ssq; unsigned* guard; unsigned need; mutable bool checked;
    __device__ __forceinline__ void operator()(const pg8::f32x4 (&acc)[2][2][4][2], const pg8::Unit& u, int wr, int wc, int fr, int fq) const {
        const int row0 = u.pm * 256 + wr * 64 + fr, col0 = u.pn * 128 + wc * 32 + 8 * fq;
        float sqv[2][4];
#pragma unroll
        for (int ai = 0; ai < 2; ++ai)
#pragma unroll
            for (int m = 0; m < 4; ++m) sqv[ai][m] = ssq[row0 + ai * 128 + m * 16];
        unsigned gv = checked ? need : xb_ld(guard);
        __builtin_amdgcn_sched_barrier(0);
        while (gv < need) { __builtin_amdgcn_s_sleep(2); gv = xb_ld(guard); }
        checked = true;
#pragma unroll
        for (int ai = 0; ai < 2; ++ai)
#pragma unroll
            for (int m = 0; m < 4; ++m) { const int row = row0 + ai * 128 + m * 16;
                const float rstd = rsq_(sqv[ai][m] * (((PROBE) == 5 ? 0.5f : 1.f) / D) + EPS);
                float v[8];
#pragma unroll
                for (int e = 0; e < 4; ++e) { v[e] = siluf_(acc[ai][0][m][0][e] * rstd) * (acc[ai][1][m][0][e] * rstd); v[4 + e] = siluf_(acc[ai][0][m][1][e] * rstd) * (acc[ai][1][m][1][e] * rstd); }
                pg8::u32x4 w; w.x = cvtpk(v[0], v[1]); w.y = cvtpk(v[2], v[3]); w.z = cvtpk(v[4], v[5]); w.w = cvtpk(v[6], v[7]);
                *(pg8::u32x4*)(h + (size_t)row * FF + col0) = w; }
    }
};
struct EpiDown {
    static constexpr bool PERM = true, AFTER_DRAIN = false;
    float* out; const bf16* x1b; unsigned* guard; unsigned need; mutable bool checked;
    __device__ __forceinline__ void operator()(const pg8::f32x4 (&acc)[2][2][4][2], const pg8::Unit& u, int wr, int wc, int fr, int fq) const {
        const int row0 = u.pm * 256 + wr * 64 + fr, col0 = u.pn * 256 + wc * 32 + 8 * fq;
        pg8::u32x4 xw[2][4][2];
#pragma unroll
        for (int ai = 0; ai < 2; ++ai)
#pragma unroll
            for (int m = 0; m < 4; ++m)
#pragma unroll
                for (int bj = 0; bj < 2; ++bj) xw[ai][m][bj] = __builtin_nontemporal_load((const pg8::u32x4*)(x1b + (size_t)(row0 + ai * 128 + m * 16) * D + col0 + bj * 128));
        unsigned gv = checked ? need : xb_ld(guard);
        __builtin_amdgcn_sched_barrier(0);
        while (gv < need) { __builtin_amdgcn_s_sleep(2); gv = xb_ld(guard); }
        checked = true;
#pragma unroll
        for (int ai = 0; ai < 2; ++ai)
#pragma unroll
            for (int m = 0; m < 4; ++m) { float* orow = out + (size_t)(row0 + ai * 128 + m * 16) * D + col0;
#pragma unroll
                for (int bj = 0; bj < 2; ++bj) { const pg8::u32x4 x = xw[ai][m][bj];
                    pg8::f32x4 a0 = acc[ai][bj][m][0], a1 = acc[ai][bj][m][1];
                    a0[0] += bflo(x.x); a0[1] += bfhi(x.x); a0[2] += bflo(x.y); a0[3] += bfhi(x.y); a1[0] += bflo(x.z); a1[1] += bfhi(x.z); a1[2] += bflo(x.w); a1[3] += bfhi(x.w);
                    __builtin_nontemporal_store(a0, (pg8::f32x4*)(orow + bj * 128)); __builtin_nontemporal_store(a1, (pg8::f32x4*)(orow + bj * 128 + 4)); } }
    }
};

__device__ __forceinline__ float wave_sum(float v) { v = sum16_(v); v += __shfl_xor(v, 16); v += __shfl_xor(v, 32); return v; }
__device__ __forceinline__ void tr_load(float (&wv)[32], const float* W, int N, int item, int lane) {
    const int nblk = N / 32, kb = item / nblk, nb = item % nblk, k0 = 64 * kb, n0 = 32 * nb;
#pragma unroll
    for (int i = 0; i < 32; ++i) wv[i] = __builtin_nontemporal_load(W + (size_t)(k0 + 2 * i + (lane >> 5)) * N + n0 + (lane & 31));
}
template <int MODE>
__device__ __forceinline__ void tr_finish(float (&wv)[32], int K, int N, bf16* WT, LAS float* scr, int item, int lane, const float* ksc = nullptr) {
    const int nblk = N / 32, kb = item / nblk, nb = item % nblk, k0 = 64 * kb, n0 = 32 * nb;
    if (ksc) {
#pragma unroll
        for (int i = 0; i < 32; ++i) wv[i] *= ksc[k0 + 2 * i + (lane >> 5)];
    }
#pragma unroll
    for (int i = 0; i < 32; ++i) scr[(2 * i + (lane >> 5)) * 33 + (lane & 31)] = wv[i];
    LDS_WAIT(); asm volatile("" ::: "memory");
    const int c = lane & 7;
    const int d0 = MODE == 0 ? n0 : (256 * (n0 / 128) + (n0 % 128) + (MODE == 2 ? 128 : 0));
#pragma unroll
    for (int j = 0; j < 4; ++j) { const int n = (lane >> 3) + 8 * j; const LAS float* s = scr + (8 * c) * 33 + n;
        v4u o; o.x = pk2(s[0 * 33], s[1 * 33]); o.y = pk2(s[2 * 33], s[3 * 33]); o.z = pk2(s[4 * 33], s[5 * 33]); o.w = pk2(s[6 * 33], s[7 * 33]);
        *(v4u*)(WT + (size_t)(d0 + n) * K + k0 + 8 * c) = o; }
    LDS_WAIT(); asm volatile("" ::: "memory");
}
template <int NR>
__device__ __forceinline__ void rows_to_bf16_rstd(const float* const (&xrow)[NR], bf16* const (&orow)[NR], float* const (&rsp)[NR], int lane) {
    f32x4 v[NR][4];
#pragma unroll
    for (int r = 0; r < NR; ++r)
#pragma unroll
        for (int j = 0; j < 4; ++j) v[r][j] = __builtin_nontemporal_load((const f32x4*)xrow[r] + lane + 64 * j);
#pragma unroll
    for (int r = 0; r < NR; ++r) { float s = 0.f;
#pragma unroll
        for (int j = 0; j < 4; ++j) s += (v[r][j].x * v[r][j].x + v[r][j].y * v[r][j].y) + (v[r][j].z * v[r][j].z + v[r][j].w * v[r][j].w);
        const float rstd = rsq_(wave_sum(s) * (1.f / D) + EPS);
        if (lane == 0) *rsp[r] = rstd;
        unsigned long long* o8 = (unsigned long long*)orow[r] + lane;
#pragma unroll
        for (int j = 0; j < 4; ++j) o8[64 * j] = (unsigned long long)pk2(v[r][j].x, v[r][j].y) | ((unsigned long long)pk2(v[r][j].z, v[r][j].w) << 32); }
}

struct Args { const float* in[14]; float* out; unsigned char* ws; int ph_lo, ph_hi; };

#define LDS_BARRIER() do { asm volatile("s_waitcnt lgkmcnt(0)" ::: "memory"); __builtin_amdgcn_s_barrier(); asm volatile("" ::: "memory"); } while (0)
typedef short s16x8 __attribute__((ext_vector_type(8)));
typedef short s16x4 __attribute__((ext_vector_type(4)));
__device__ __forceinline__ s16x4 tr16(const LAS unsigned char* p) { return __builtin_bit_cast(s16x4, __builtin_amdgcn_ds_read_tr16_b64_v4i16((LAS s16x4*)p)); }
__device__ __forceinline__ s16x8 mk8(s16x4 a, s16x4 b) { s16x8 r; r[0] = a[0]; r[1] = a[1]; r[2] = a[2]; r[3] = a[3]; r[4] = b[0]; r[5] = b[1]; r[6] = b[2]; r[7] = b[3]; return r; }
__device__ __forceinline__ s16x8 mk8u(unsigned a, unsigned b, unsigned c, unsigned d) { v4u t; t.x = a; t.y = b; t.z = c; t.w = d; return __builtin_bit_cast(s16x8, t); }
constexpr int TP = 288, AP = 144, TPQ = 272;
#define SWZ3(row_, colbyte_) ((colbyte_) ^ ((((row_) >> 3) & 1) << 7))
constexpr int HT_Q = 0, HT_G = 18432, HT_V = 36864, HT_QH = 55296, HT_KH = 73728, HT_A = 92160, HT_TOT = 101376, HT_DV = 105472, HT_V2 = 106496;
struct HGRegs { unsigned qw[8], gw[8]; v4u v0, v1; };
#define HG_LOAD(R_, cidx_) do { const size_t rb_ = hbase_ + (size_t)(s0 + 64 * (cidx_)) * 128; \
        _Pragma("unroll") for (int i_ = 0; i_ < 8; ++i_) { R_.qw[i_] = *(const unsigned*)(Hq + rb_ + (size_t)(8 * w + i_) * 128 + 2 * lane); R_.gw[i_] = *(const unsigned*)(Hg + rb_ + (size_t)(8 * w + i_) * 128 + 2 * lane); } \
        R_.v0 = *(const v4u*)(Hv + rb_ + (size_t)lr * 128 + lc * 8); R_.v1 = *(const v4u*)(Hv + rb_ + (size_t)(lr + 32) * 128 + lc * 8); } while (0)
template <int dir>
__device__ __forceinline__ void hgrn_step(LAS unsigned char* lds, const bf16* Hq, bf16* Hg, const bf16* Hv, bf16* Oo, int opitch, int s0, int cfirst, int nsteps, int head, int it, int dmode,
                                          HGRegs& R, f32x4 (&S)[8], float& bacc0, float& bacc1) {
    const int tid = threadIdx.x, lane = tid & 63, w = __builtin_amdgcn_readfirstlane(tid >> 6), h = lane >> 4, i16 = lane & 15, q4 = i16 >> 2, p4 = i16 & 3;
    LAS unsigned char* TQ = lds + HT_Q; LAS unsigned char* TG = lds + HT_G; LAS unsigned char* TV = lds + ((it & 1) ? HT_V2 : HT_V); LAS unsigned char* TQH = lds + HT_QH; LAS unsigned char* TKH = lds + HT_KH;
    LAS unsigned char* AM = lds + HT_A; LAS float* TOT = (LAS float*)(lds + HT_TOT); LAS float* DV = (LAS float*)(lds + HT_DV);
    const int lr = tid >> 4, lc = tid & 15;
    const size_t hbase_ = (size_t)head * ((size_t)M * 128);
    {
        const int cidx = dir ? cfirst - it : cfirst + it;
        *(LAS v4u*)(TV + lr * TP + SWZ3(lr, lc * 16)) = R.v0; *(LAS v4u*)(TV + (lr + 32) * TP + SWZ3(lr, lc * 16)) = R.v1;
        float glo[8], ghi[8], llo[8], lhi[8]; unsigned qws[8];
#pragma unroll
        for (int i = 0; i < 8; ++i) { glo[i] = bflo(R.gw[i]); ghi[i] = bfhi(R.gw[i]); qws[i] = R.qw[i]; }
        if (it + 1 < nsteps) { const int cn = dir ? cidx - 1 : cidx + 1; HG_LOAD(R, cn); }
        { float c0 = 0.f, c1 = 0.f;
          if (!dir) {
#pragma unroll
              for (int i = 0; i < 8; ++i) { c0 += glo[i]; c1 += ghi[i]; llo[i] = c0; lhi[i] = c1; }
          } else {
#pragma unroll
              for (int i = 7; i >= 0; --i) { c0 += glo[i]; c1 += ghi[i]; llo[i] = c0; lhi[i] = c1; }
          }
          *(LAS f32x2*)(TOT + w * 128 + 2 * lane) = (f32x2){c0, c1}; }
        LDS_BARRIER();
        if (!(dmode & 2)) {
            float offs0 = 0.f, offs1 = 0.f, ref0 = 0.f, ref1 = 0.f, all0 = 0.f, all1 = 0.f;
#pragma unroll
            for (int s = 0; s < 8; ++s) { const f32x2 tt = *(const LAS f32x2*)(TOT + s * 128 + 2 * lane); all0 += tt.x; all1 += tt.y;
                const float bo = (dir ? (s > w) : (s < w)) ? 1.f : 0.f;
                offs0 = __builtin_fmaf(bo, tt.x, offs0); offs1 = __builtin_fmaf(bo, tt.y, offs1);
                if (dir ? (s >= 4) : (s < 4)) { ref0 += tt.x; ref1 += tt.y; } }
            const float Er0 = ex2_(ref0), Er1 = ex2_(ref1), Ek0 = ex2_(all0 - ref0), Ek1 = ex2_(all1 - ref1);
            if (w == 0) *(LAS f32x2*)(DV + 2 * lane) = (f32x2){ex2_(all0), ex2_(all1)};
            const float Eg0 = Er0 * ex2_(bacc0), Eg1 = Er1 * ex2_(bacc1);
            bacc0 += all0; bacc1 += all1;
            float f0[8], f1[8], pre0[8], pre1[8];
#pragma unroll
            for (int i = 0; i < 8; ++i) { f0[i] = ex2_(glo[i]); f1[i] = ex2_(ghi[i]); }
            const float sg_ = dir ? -1.f : 1.f;
            float run0 = ex2_(fminf(sg_ * (offs0 + llo[0] - ref0), 115.f)), run1 = ex2_(fminf(sg_ * (offs1 + lhi[0] - ref1), 115.f));
            pre0[7] = ex2_(fminf(-sg_ * (offs0 + llo[7] - ref0), 115.f)); pre1[7] = ex2_(fminf(-sg_ * (offs1 + lhi[7] - ref1), 115.f));
#pragma unroll
            for (int i = 7; i > 0; --i) { pre0[i - 1] = pre0[i] * (dir ? f0[i - 1] : f0[i]); pre1[i - 1] = pre1[i] * (dir ? f1[i - 1] : f1[i]); }
            const int wv_ = tid >> 6;
            const int aq_ = HT_Q + (8 * wv_) * TP + lane * 4, aqh_ = HT_QH + (8 * wv_) * TPQ + lane * 4, akh_ = HT_KH + (8 * wv_) * TP + SWZ3(8 * wv_, lane * 4);
            bf16* gq_ = Hg + (size_t)head * ((size_t)M * 128) + (size_t)(s0 + 64 * cidx + 8 * wv_) * 128 + 2 * lane;
#pragma unroll
            for (int i = 0; i < 8; ++i) {
                const unsigned qw_ = qws[i]; const float q0 = bflo(qw_), q1 = bfhi(qw_);
                if (i > 0) { run0 *= dir ? f0[i - 1] : f0[i]; run1 *= dir ? f1[i - 1] : f1[i]; }
                const float e10 = dir ? pre0[i] : run0, e11 = dir ? pre1[i] : run1, e20 = dir ? run0 : pre0[i], e21 = dir ? run1 : pre1[i];
                const float k0 = 1.f - f0[i], k1 = 1.f - f1[i];
                const float qt0 = q0 * e10, qt1 = q1 * e11, kt0 = k0 * e20, kt1 = k1 * e21;
                *(LAS unsigned*)(lds + aq_ + i * TP) = cvtpk(qt0, qt1); *(LAS unsigned*)(lds + aq_ + (HT_G - HT_Q) + i * TP) = cvtpk(kt0, kt1);
                *(LAS unsigned*)(lds + aqh_ + i * TPQ) = cvtpk(qt0 * Er0, qt1 * Er1); *(LAS unsigned*)(lds + akh_ + i * TP) = cvtpk(kt0 * Ek0, kt1 * Ek1);
                if (!(dmode & 1)) *(unsigned*)(gq_ + i * 128) = cvtpk(qt0 * Eg0, qt1 * Eg1); }
        }
        LDS_BARRIER();
        if (!(dmode & 4)) {
            const int I = w >> 1;
            s16x8 qf[4], kf[2][4];
#pragma unroll
            for (int ks = 0; ks < 4; ++ks) qf[ks] = *(const LAS s16x8*)(TQ + (16 * I + i16) * TP + (32 * ks + 8 * h) * 2);
#pragma unroll
            for (int jj = 0; jj < 2; ++jj)
#pragma unroll
                for (int ks = 0; ks < 4; ++ks) kf[jj][ks] = *(const LAS s16x8*)(TG + (16 * (2 * (w & 1) + jj) + i16) * TP + (32 * ks + 8 * h) * 2);
            __builtin_amdgcn_sched_barrier(0);
            f32x4 a2[2];
#pragma unroll
            for (int jj = 0; jj < 2; ++jj) { a2[jj] = (f32x4){0.f, 0.f, 0.f, 0.f};
#pragma unroll
                for (int ks = 0; ks < 4; ++ks) a2[jj] = __builtin_amdgcn_mfma_f32_16x16x32_bf16(kf[jj][ks], qf[ks], a2[jj], 0, 0, 0); }
#pragma unroll
            for (int jj = 0; jj < 2; ++jj) { const int J = 2 * (w & 1) + jj; const int t = 16 * I + i16, sb = 16 * J + 4 * h;
                float vv[4];
#pragma unroll
                for (int r = 0; r < 4; ++r) { const bool keep = dir ? (sb + r >= t) : (sb + r <= t); vv[r] = keep ? a2[jj][r] : 0.f; }
                *(LAS v2u*)(AM + t * AP + sb * 2) = (v2u){cvtpk(vv[0], vv[1]), cvtpk(vv[2], vv[3])}; }
        }
        LDS_BARRIER();
        if (!(dmode & 8)) {
            s16x8 sf[4], vf[2];
#pragma unroll
            for (int ks = 0; ks < 4; ++ks) sf[ks] = mk8u(cvtpk(S[2 * ks][0], S[2 * ks][1]), cvtpk(S[2 * ks][2], S[2 * ks][3]), cvtpk(S[2 * ks + 1][0], S[2 * ks + 1][1]), cvtpk(S[2 * ks + 1][2], S[2 * ks + 1][3]));
#pragma unroll
            for (int ks = 0; ks < 2; ++ks) vf[ks] = mk8(tr16(TV + (32 * ks + 8 * h + q4) * TP + SWZ3(8 * h, (16 * w + 4 * p4) * 2)), tr16(TV + (32 * ks + 8 * h + 4 + q4) * TP + SWZ3(8 * h, (16 * w + 4 * p4) * 2)));
            f32x4 oo[4];
#pragma unroll
            for (int ip = 0; ip < 2; ++ip) {
                s16x8 afr[2][2], qfr[2][4];
#pragma unroll
                for (int ii = 0; ii < 2; ++ii) { const int i = 2 * ip + ii;
#pragma unroll
                    for (int ks = 0; ks < 2; ++ks) afr[ii][ks] = *(const LAS s16x8*)(AM + (16 * i + i16) * AP + (32 * ks + 8 * h) * 2);
#pragma unroll
                    for (int ks = 0; ks < 4; ++ks) { const v2u lo = *(const LAS v2u*)(TQH + (16 * i + i16) * TPQ + (32 * ks + 4 * h) * 2), hi = *(const LAS v2u*)(TQH + (16 * i + i16) * TPQ + (32 * ks + 16 + 4 * h) * 2);
                        qfr[ii][ks] = mk8u(lo.x, lo.y, hi.x, hi.y); } }
                __builtin_amdgcn_sched_barrier(0);
#pragma unroll
                for (int ii = 0; ii < 2; ++ii) { f32x4 o = (f32x4){0.f, 0.f, 0.f, 0.f};
#pragma unroll
                    for (int ks = 0; ks < 2; ++ks) o = __builtin_amdgcn_mfma_f32_16x16x32_bf16(vf[ks], afr[ii][ks], o, 0, 0, 0);
#pragma unroll
                    for (int ks = 0; ks < 4; ++ks) o = __builtin_amdgcn_mfma_f32_16x16x32_bf16(sf[ks], qfr[ii][ks], o, 0, 0, 0);
                    oo[2 * ip + ii] = o; }
                __builtin_amdgcn_sched_barrier(0);
            }
            s16x8 kfr[8][2]; f32x4 d4[8];
#pragma unroll
            for (int T = 0; T < 8; ++T) { d4[T] = *(const LAS f32x4*)(DV + 16 * T + 4 * h);
#pragma unroll
                for (int ks = 0; ks < 2; ++ks) kfr[T][ks] = mk8(tr16(TKH + (32 * ks + 8 * h + q4) * TP + SWZ3(8 * h, (16 * T + 4 * p4) * 2)), tr16(TKH + (32 * ks + 8 * h + 4 + q4) * TP + SWZ3(8 * h, (16 * T + 4 * p4) * 2))); }
#pragma unroll
            for (int i = 0; i < 4; ++i) *(v2u*)(Oo + (size_t)(s0 + 64 * cidx + 16 * i + i16) * opitch + 16 * w + 4 * h) = (v2u){cvtpk(oo[i][0], oo[i][1]), cvtpk(oo[i][2], oo[i][3])};
            __builtin_amdgcn_sched_barrier(0);
#pragma unroll
            for (int T = 0; T < 8; ++T) { S[T] = S[T] * d4[T];
#pragma unroll
                for (int ks = 0; ks < 2; ++ks) S[T] = __builtin_amdgcn_mfma_f32_16x16x32_bf16(kfr[T][ks], vf[ks], S[T], 0, 0, 0); }
        }
        if (it + 1 == nsteps) LDS_BARRIER();
    }
}
template <int dir>
__device__ __forceinline__ void hgrn_chain(LAS unsigned char* lds, const bf16* Hq, bf16* Hg, const bf16* Hv, bf16* Oo, int opitch, int s0, int cfirst, int nsteps, int head, float* SLc, float* Btc, int dmode = 0) {
    const int tid = threadIdx.x, lane = tid & 63, w = __builtin_amdgcn_readfirstlane(tid >> 6);
    const int lr = tid >> 4, lc = tid & 15;
    const size_t hbase_ = (size_t)head * ((size_t)M * 128);
    HGRegs A;
    HG_LOAD(A, cfirst);
    f32x4 S[8];
#pragma unroll
    for (int T = 0; T < 8; ++T) S[T] = (f32x4){0.f, 0.f, 0.f, 0.f};
    float bacc0 = 0.f, bacc1 = 0.f;
    for (int it = 0; it < nsteps; ++it)
        hgrn_step<dir>(lds, Hq, Hg, Hv, Oo, opitch, s0, cfirst, nsteps, head, it, dmode, A, S, bacc0, bacc1);
#undef HG_LOAD
#pragma unroll
    for (int T = 0; T < 8; ++T) *(f32x4*)(SLc + ((w * 8 + T) * 64 + lane) * 4) = S[T];
    if (w == 0) *(f32x2*)(Btc + 2 * lane) = (f32x2){bacc0, bacc1};
}
__device__ __forceinline__ void hgrn_scan(const float* SL, const float* Bt, v4u* SF, int gid, int nthreads, int own_x = -1) {
    for (int item = gid; item < 48 * 2048; item += nthreads) {
        const int g = item >> 11, e = item & 2047, seq = g >> 3, head = (g >> 1) & 3, dir = g & 1;
        const int ns = seq < 4 ? 4 : 8, sgbase = seq < 4 ? seq * 4 : 16 + (seq - 4) * 8;
        const int wq = e >> 8, ks = (e >> 6) & 3, ln = e & 63, dk0 = 32 * ks + 4 * (ln >> 4);
        f32x4 ta[8], tb[8], ba[8], bb[8];
#pragma unroll
        for (int jj = 0; jj < 8; ++jj) if (jj < ns) { const int j = dir ? ns - 1 - jj : jj; const int ch = ((sgbase + j) << 3) | (head << 1) | dir;
            const f32x4* p = (const f32x4*)(SL + (size_t)ch * 16384) + (wq * 8 + 2 * ks) * 64 + ln;
            ta[jj] = p[0]; tb[jj] = p[64]; ba[jj] = *(const f32x4*)(Bt + ch * 128 + dk0); bb[jj] = *(const f32x4*)(Bt + ch * 128 + dk0 + 16); }
        f32x4 ca = (f32x4){0.f, 0.f, 0.f, 0.f}, cb = ca;
#pragma unroll
        for (int jj = 0; jj < 8; ++jj) if (jj < ns) { const int j = dir ? ns - 1 - jj : jj; const int ch = ((sgbase + j) << 3) | (head << 1) | dir;
            v4u fr; fr.x = cvtpk(ca.x, ca.y); fr.y = cvtpk(ca.z, ca.w); fr.z = cvtpk(cb.x, cb.y); fr.w = cvtpk(cb.z, cb.w);
            if (own_x < 0 || ((sgbase + j) >> 2) == own_x) SF[(size_t)ch * 2048 + e] = fr;
            ca.x = ex2_(ba[jj].x) * ca.x + ta[jj].x; ca.y = ex2_(ba[jj].y) * ca.y + ta[jj].y; ca.z = ex2_(ba[jj].z) * ca.z + ta[jj].z; ca.w = ex2_(ba[jj].w) * ca.w + ta[jj].w;
            cb.x = ex2_(bb[jj].x) * cb.x + tb[jj].x; cb.y = ex2_(bb[jj].y) * cb.y + tb[jj].y; cb.z = ex2_(bb[jj].z) * cb.z + tb[jj].z; cb.w = ex2_(bb[jj].w) * cb.w + tb[jj].w; }
    }
}
constexpr int P2_QF = 0, P2_QB = 18432, P2_BUF = 36864, P2_OC = 73728, P2_OCP = 528;
__device__ __forceinline__ void hgrn_pass2(LAS unsigned char* lds, const bf16* Hqf, const bf16* Hqb, const bf16* Hgate, const float* gnw, const v4u* SF, const bf16* O, bf16* Ow, int opw, const bf16* OBk,
                                           int s0, int seg, int sg, int head, int half, int mode = 0) {
    const int tid = threadIdx.x, lane = tid & 63, w = __builtin_amdgcn_readfirstlane(tid >> 6), h = lane >> 4, i16 = lane & 15;
    const int ti = w >> 1, dh = w & 1;
    const int chf = (sg << 3) | (head << 1), chb = chf | 1;
    s16x8 sfF[4][4], sfB[4][4];
#pragma unroll
    for (int n = 0; n < 4; ++n)
#pragma unroll
        for (int ks = 0; ks < 4; ++ks) { const size_t fo = (size_t)((4 * dh + n) * 4 + ks) * 64 + lane;
            sfF[n][ks] = __builtin_bit_cast(s16x8, SF[(size_t)chf * 2048 + fo]); sfB[n][ks] = __builtin_bit_cast(s16x8, SF[(size_t)chb * 2048 + fo]); }
    const int lr = tid >> 4, lc = tid & 15; const size_t gcol = (size_t)head * 128 + lc * 8, hcol = (size_t)head * ((size_t)M * 128) + lc * 8;
    const f32x4 gn0 = *(const f32x4*)(gnw + 8 * lc), gn1 = *(const f32x4*)(gnw + 8 * lc + 4);
    LAS unsigned char* OC = lds + P2_OC;
    v4u pa0, pa1, pb0, pb1, rf0, rf1, rb0, rb1, rg0, rg1;
#define P2_LOAD(cidx_) do { const size_t o0_ = (size_t)(s0 + 64 * (cidx_) + lr) * 128 + hcol, o1_ = o0_ + (size_t)32 * 128; \
        pa0 = __builtin_nontemporal_load((const v4u*)(Hqf + o0_)); pa1 = __builtin_nontemporal_load((const v4u*)(Hqf + o1_)); pb0 = __builtin_nontemporal_load((const v4u*)(Hqb + o0_)); pb1 = __builtin_nontemporal_load((const v4u*)(Hqb + o1_)); } while (0)
#define P2_LOADR(cidx_) do { const size_t r0_ = (size_t)(s0 + 64 * (cidx_) + lr), r1_ = r0_ + 32; \
        rf0 = __builtin_nontemporal_load((const v4u*)(O + r0_ * D + gcol)); rf1 = __builtin_nontemporal_load((const v4u*)(O + r1_ * D + gcol)); rb0 = __builtin_nontemporal_load((const v4u*)(OBk + r0_ * 128 + hcol)); rb1 = __builtin_nontemporal_load((const v4u*)(OBk + r1_ * 128 + hcol)); \
        rg0 = __builtin_nontemporal_load((const v4u*)(Hgate + r0_ * 128 + hcol)); rg1 = __builtin_nontemporal_load((const v4u*)(Hgate + r1_ * 128 + hcol)); } while (0)
    P2_LOAD(16 * seg + 8 * half); P2_LOADR(16 * seg + 8 * half);
    for (int u = 0; u < 8; ++u) {
        const int cidx = 16 * seg + 8 * half + u;
        LAS unsigned char* TQF = lds + (u & 1) * P2_BUF + P2_QF; LAS unsigned char* TQB = lds + (u & 1) * P2_BUF + P2_QB;
        *(LAS v4u*)(TQF + lr * TPQ + lc * 16) = pa0; *(LAS v4u*)(TQF + (lr + 32) * TPQ + lc * 16) = pa1;
        *(LAS v4u*)(TQB + lr * TPQ + lc * 16) = pb0; *(LAS v4u*)(TQB + (lr + 32) * TPQ + lc * 16) = pb1;
        if (u + 1 < 8 && mode != 1) P2_LOAD(cidx + 1);
        LDS_BARRIER();
        if (mode != 2) {
            s16x8 ff[4], fb[4];
#pragma unroll
            for (int ks = 0; ks < 4; ++ks) { const int ro = (16 * ti + i16) * TPQ + (32 * ks + 4 * h) * 2;
                const v2u lo = *(const LAS v2u*)(TQF + ro), hi = *(const LAS v2u*)(TQF + ro + 32), lo2 = *(const LAS v2u*)(TQB + ro), hi2 = *(const LAS v2u*)(TQB + ro + 32);
                ff[ks] = mk8u(lo.x, lo.y, hi.x, hi.y); fb[ks] = mk8u(lo2.x, lo2.y, hi2.x, hi2.y); }
            __builtin_amdgcn_sched_barrier(0);
#pragma unroll
            for (int n = 0; n < 4; ++n) { f32x4 o = (f32x4){0.f, 0.f, 0.f, 0.f};
#pragma unroll
                for (int ks = 0; ks < 4; ++ks) { o = __builtin_amdgcn_mfma_f32_16x16x32_bf16(sfF[n][ks], ff[ks], o, 0, 0, 0); o = __builtin_amdgcn_mfma_f32_16x16x32_bf16(sfB[n][ks], fb[ks], o, 0, 0, 0); }
                *(LAS f32x4*)(OC + (16 * ti + i16) * P2_OCP + (16 * (4 * dh + n) + 4 * h) * 4) = o; }
            __builtin_amdgcn_sched_barrier(0);
        }
        LDS_BARRIER();
        {
            const v4u f0 = rf0, f1 = rf1, b0 = rb0, b1 = rb1, g0 = rg0, g1 = rg1;
            if (u + 1 < 8 && mode != 1) P2_LOADR(cidx + 1);
#pragma unroll
            for (int rr = 0; rr < 2; ++rr) { const int row = lr + 32 * rr; const v4u fw = rr ? f1 : f0, bw = rr ? b1 : b0, gw_ = rr ? g1 : g0;
                const f32x4 c0_ = *(const LAS f32x4*)(OC + row * P2_OCP + lc * 32), c1_ = *(const LAS f32x4*)(OC + row * P2_OCP + lc * 32 + 16);
                float o[8];
                o[0] = c0_.x + bflo(fw.x) + bflo(bw.x); o[1] = c0_.y + bfhi(fw.x) + bfhi(bw.x); o[2] = c0_.z + bflo(fw.y) + bflo(bw.y); o[3] = c0_.w + bfhi(fw.y) + bfhi(bw.y);
                o[4] = c1_.x + bflo(fw.z) + bflo(bw.z); o[5] = c1_.y + bfhi(fw.z) + bfhi(bw.z); o[6] = c1_.z + bflo(fw.w) + bflo(bw.w); o[7] = c1_.w + bfhi(fw.w) + bfhi(bw.w);
                float sq = (o[0] * o[0] + o[1] * o[1]) + (o[2] * o[2] + o[3] * o[3]) + (o[4] * o[4] + o[5] * o[5]) + (o[6] * o[6] + o[7] * o[7]);
                sq = sum16_(sq);
                const float r = rsq_(sq * (1.f / 128.f) + EPS);
                v4u ov; ov.x = cvtpk(o[0] * r * gn0.x * bflo(gw_.x), o[1] * r * gn0.y * bfhi(gw_.x)); ov.y = cvtpk(o[2] * r * gn0.z * bflo(gw_.y), o[3] * r * gn0.w * bfhi(gw_.y));
                ov.z = cvtpk(o[4] * r * gn1.x * bflo(gw_.z), o[5] * r * gn1.y * bfhi(gw_.z)); ov.w = cvtpk(o[6] * r * gn1.z * bflo(gw_.w), o[7] * r * gn1.w * bfhi(gw_.w));
                *(v4u*)(Ow + (size_t)(s0 + 64 * cidx + row) * opw + gcol) = ov; }
        }
    }
    LDS_BARRIER();
#undef P2_LOAD
#undef P2_LOADR
}
constexpr int NKP = 128, NROWB = 64 * NKP, NA_K = 0, NA_V = 9 * NROWB, NA_RPB = 18 * NROWB;
#define NA_KOFF(key_, chunk_) ((key_) * NKP + 16 * ((chunk_) ^ (((key_) >> 1) & 7)))
#define NA_VOFF(key_, unit_) ((key_) * NKP + 8 * ((unit_) ^ (4 * (((key_) >> 1) & 3))))
static_assert(NA_RPB + 480 * 4 <= LDSCTL_OFF, "NA LDS map");
__device__ __forceinline__ void na_store_krow(LAS unsigned char* KR, int row, int key, int c, v4u kr, const float* kw) {
    float x[8]; x[0] = bflo(kr.x); x[1] = bfhi(kr.x); x[2] = bflo(kr.y); x[3] = bfhi(kr.y); x[4] = bflo(kr.z); x[5] = bfhi(kr.z); x[6] = bflo(kr.w); x[7] = bfhi(kr.w);
    float ss = 0.f;
#pragma unroll
    for (int e = 0; e < 8; ++e) ss += x[e] * x[e];
    ss = sum8_(ss);
    const float sc = rsq_(ss * (1.f / 64.f) + EPS);
    const f32x4 w0 = *(const f32x4*)(kw + c * 8), w1 = *(const f32x4*)(kw + c * 8 + 4);
    v4u o; o.x = cvtpk(x[0] * sc * w0.x, x[1] * sc * w0.y); o.y = cvtpk(x[2] * sc * w0.z, x[3] * sc * w0.w); o.z = cvtpk(x[4] * sc * w1.x, x[5] * sc * w1.y); o.w = cvtpk(x[6] * sc * w1.z, x[7] * sc * w1.w);
    *(LAS v4u*)(KR + (row % 9) * NROWB + NA_KOFF(key, c)) = o;
}
__device__ __forceinline__ void na_store_vrow(LAS unsigned char* VR, int row, int key, int c, v4u vr) {
    *(LAS v4u*)(VR + (row % 9) * NROWB + NA_VOFF(key, 2 * c)) = vr;
}
__device__ __forceinline__ void na_qfrag(s16x8 (&qf)[2], v4u a, v4u b, const float* qw, int h) {
    float x[16]; x[0] = bflo(a.x); x[1] = bfhi(a.x); x[2] = bflo(a.y); x[3] = bfhi(a.y); x[4] = bflo(a.z); x[5] = bfhi(a.z); x[6] = bflo(a.w); x[7] = bfhi(a.w);
    x[8] = bflo(b.x); x[9] = bfhi(b.x); x[10] = bflo(b.y); x[11] = bfhi(b.y); x[12] = bflo(b.z); x[13] = bfhi(b.z); x[14] = bflo(b.w); x[15] = bfhi(b.w);
    float ss = 0.f;
#pragma unroll
    for (int e = 0; e < 16; ++e) ss += x[e] * x[e];
    ss += __shfl_xor(ss, 16); ss += __shfl_xor(ss, 32);
    const float sc = (0.125f * 1.44269504089f) * rsq_(ss * (1.f / 64.f) + EPS);
    const f32x4 wa0 = *(const f32x4*)(qw + 8 * h), wa1 = *(const f32x4*)(qw + 8 * h + 4), wb0 = *(const f32x4*)(qw + 32 + 8 * h), wb1 = *(const f32x4*)(qw + 32 + 8 * h + 4);
    qf[0] = mk8u(cvtpk(x[0] * sc * wa0.x, x[1] * sc * wa0.y), cvtpk(x[2] * sc * wa0.z, x[3] * sc * wa0.w), cvtpk(x[4] * sc * wa1.x, x[5] * sc * wa1.y), cvtpk(x[6] * sc * wa1.z, x[7] * sc * wa1.w));
    qf[1] = mk8u(cvtpk(x[8] * sc * wb0.x, x[9] * sc * wb0.y), cvtpk(x[10] * sc * wb0.z, x[11] * sc * wb0.w), cvtpk(x[12] * sc * wb1.x, x[13] * sc * wb1.y), cvtpk(x[14] * sc * wb1.z, x[15] * sc * wb1.w));
}
__device__ __forceinline__ void na_run(LAS unsigned char* lds, const bf16* NQ, const bf16* NK, const bf16* NV, const float* qw, const float* kw, const float* rpb, bf16* O, int s0, int rows, int head, int r0, int nr) {
    const int tid = threadIdx.x, lane = tid & 63, w = __builtin_amdgcn_readfirstlane(tid >> 6), h = lane >> 4, i16 = lane & 15, q4 = i16 >> 2, p4 = i16 & 3;
    LAS unsigned char* KR = lds + NA_K; LAS unsigned char* VR = lds + NA_V; LAS float* RB = (LAS float*)(lds + NA_RPB);
    for (int i = tid; i < 480; i += NWAVES * 64) { const int rw = i >> 5, cl = i & 31; RB[i] = cl < 31 ? rpb[head * 465 + rw * 31 + cl] * 1.44269504089f : -1e30f; }
    const int lkey = tid >> 3, lc = tid & 7; const size_t hbase = (size_t)head * ((size_t)M * 64);
    const int rr = w >> 2, j = w & 3, qcol = 16 * j + i16, bs = min(max(16 * j - 8, 0), 32), wsn = min(max(qcol - 8, 0), 48);
    {
        const int rs0 = min(max(r0 - 4, 0), rows - 8), hi0 = min(max(r0 - 3, 0), rows - 8) + 7; v4u kk[9], vv[9];
#pragma unroll
        for (int k = 0; k < 9; ++k) { const int row = min(rs0 + k, hi0); const size_t go = hbase + (size_t)(s0 + row * 64 + lkey) * 64 + lc * 8; kk[k] = *(const v4u*)(NK + go); vv[k] = *(const v4u*)(NV + go); }
#pragma unroll
        for (int k = 0; k < 9; ++k) { const int row = min(rs0 + k, hi0); na_store_krow(KR, row, lkey, lc, kk[k], kw); na_store_vrow(VR, row, lkey, lc, vv[k]); }
    }
    v4u qa, qb;
    { const size_t qrow = (size_t)(s0 + (r0 + rr) * 64 + qcol); qa = *(const v4u*)(NQ + hbase + qrow * 64 + 8 * h); qb = *(const v4u*)(NQ + hbase + qrow * 64 + 32 + 8 * h); }
    for (int st = 0; st < nr; st += 2) {
        const int r = r0 + st + rr, rs = min(max(r - 4, 0), rows - 8);
        const bool more = st + 2 < nr;
        const int hic = min(max(r0 + st - 3, 0), rows - 8) + 7, hin = min(max(r0 + st - 1, 0), rows - 8) + 7;
        const int nrA = min(hic + 1, hin), nrB = min(hic + 2, hin);
        const bool ldA = more && (hic + 1 <= hin), ldB = more && (hic + 2 <= hin);
        s16x8 qf[2]; na_qfrag(qf, qa, qb, qw, h);
        LDS_BARRIER();
        v4u nkA, nvA, nkB, nvB;
        if (ldA) { const size_t go = hbase + (size_t)(s0 + nrA * 64 + lkey) * 64 + lc * 8; nkA = *(const v4u*)(NK + go); nvA = *(const v4u*)(NV + go); }
        if (ldB) { const size_t go = hbase + (size_t)(s0 + nrB * 64 + lkey) * 64 + lc * 8; nkB = *(const v4u*)(NK + go); nvB = *(const v4u*)(NV + go); }
        const size_t qrow = (size_t)(s0 + r * 64 + qcol);
        if (more) { const size_t qn = qrow + 128; qa = *(const v4u*)(NQ + hbase + qn * 64 + 8 * h); qb = *(const v4u*)(NQ + hbase + qn * 64 + 32 + 8 * h); }
        {
            int dci[2][4];
#pragma unroll
            for (int ch = 0; ch < 2; ++ch)
#pragma unroll
                for (int rg = 0; rg < 4; ++rg) { const int kcol = bs + 16 * ch + 4 * h + rg; dci[ch][rg] = ((kcol >= wsn) && (kcol < wsn + 16)) ? kcol - qcol + 15 : 31; }
            const LAS float* rbp[2][4];
#pragma unroll
            for (int ch = 0; ch < 2; ++ch)
#pragma unroll
                for (int rg = 0; rg < 4; ++rg) rbp[ch][rg] = RB + (rs - r + 7) * 32 + dci[ch][rg];
            const s16x8 ones = {0x3F80, 0x3F80, 0x3F80, 0x3F80, 0x3F80, 0x3F80, 0x3F80, 0x3F80};
            f32x4 ls = (f32x4){0.f, 0.f, 0.f, 0.f}; s16x8 pf[8];
            float bv[2][2][2][4]; s16x8 kf[2][2][2][2];
#define NA_LOADK(B_, KP_) do { _Pragma("unroll") for (int k2 = 0; k2 < 2; ++k2) { const int kr_ = 2 * (KP_) + k2; const int slot_ = (rs + kr_) % 9; \
                _Pragma("unroll") for (int ch = 0; ch < 2; ++ch) { \
                    _Pragma("unroll") for (int rg = 0; rg < 4; ++rg) bv[B_][k2][ch][rg] = rbp[ch][rg][kr_ * 32]; \
                    _Pragma("unroll") for (int ks = 0; ks < 2; ++ks) { kf[B_][k2][ch][ks] = *(const LAS s16x8*)(KR + slot_ * NROWB + NA_KOFF(bs + 16 * ch + i16, 4 * ks + h)); } } } } while (0)
            NA_LOADK(0, 0);
#pragma unroll
            for (int kp = 0; kp < 4; ++kp) {
                if (kp < 3) NA_LOADK((kp + 1) & 1, kp + 1);
                __builtin_amdgcn_sched_barrier(0);
#pragma unroll
                for (int k2 = 0; k2 < 2; ++k2) { const int kr = 2 * kp + k2; float pp[2][4];
#pragma unroll
                    for (int ch = 0; ch < 2; ++ch) { f32x4 a = (f32x4){bv[kp & 1][k2][ch][0], bv[kp & 1][k2][ch][1], bv[kp & 1][k2][ch][2], bv[kp & 1][k2][ch][3]};
#pragma unroll
                        for (int ks = 0; ks < 2; ++ks) a = __builtin_amdgcn_mfma_f32_16x16x32_bf16(kf[kp & 1][k2][ch][ks], qf[ks], a, 0, 0, 0);
#pragma unroll
                        for (int rg = 0; rg < 4; ++rg) pp[ch][rg] = ex2_(a[rg]); }
                    pf[kr] = mk8u(cvtpk(pp[0][0], pp[0][1]), cvtpk(pp[0][2], pp[0][3]), cvtpk(pp[1][0], pp[1][1]), cvtpk(pp[1][2], pp[1][3]));
                    ls = __builtin_amdgcn_mfma_f32_16x16x32_bf16(ones, pf[kr], ls, 0, 0, 0); }
                __builtin_amdgcn_sched_barrier(0);
            }
#undef NA_LOADK
            const float il = rcp_(ls[0]);
            s16x8 vfr[2][8];
#define NA_LOADV(B_, N_) do { _Pragma("unroll") for (int kr = 0; kr < 8; ++kr) { const int slot_ = (rs + kr) % 9; \
                vfr[B_][kr] = mk8(tr16(VR + slot_ * NROWB + NA_VOFF(bs + 4 * h + q4, 4 * (N_) + p4)), tr16(VR + slot_ * NROWB + NA_VOFF(bs + 16 + 4 * h + q4, 4 * (N_) + p4))); } } while (0)
            NA_LOADV(0, 0);
#pragma unroll
            for (int n = 0; n < 4; ++n) {
                if (n < 3) NA_LOADV((n + 1) & 1, n + 1);
                __builtin_amdgcn_sched_barrier(0);
                f32x4 o = (f32x4){0.f, 0.f, 0.f, 0.f};
#pragma unroll
                for (int kr = 0; kr < 8; ++kr) o = __builtin_amdgcn_mfma_f32_16x16x32_bf16(vfr[n & 1][kr], pf[kr], o, 0, 0, 0);
                *(v2u*)(O + qrow * D + GW + head * 64 + 16 * n + 4 * h) = (v2u){cvtpk(o[0] * il, o[1] * il), cvtpk(o[2] * il, o[3] * il)};
                __builtin_amdgcn_sched_barrier(0);
            }
#undef NA_LOADV
        }
        LDS_BARRIER();
        if (ldA) { na_store_krow(KR, nrA, lkey, lc, nkA, kw); na_store_vrow(VR, nrA, lkey, lc, nvA); }
        if (ldB) { na_store_krow(KR, nrB, lkey, lc, nkB, kw); na_store_vrow(VR, nrB, lkey, lc, nvB); }
    }
    LDS_BARRIER();
}
constexpr int N_PHASES = 8;
#define REP(k) for (int rep_ = 0; rep_ < ((PROBE) == (k) ? 2 : 1); ++rep_)
__global__ void __launch_bounds__(NWAVES * 64, 2) fwd_kernel(Args args) {
    extern __shared__ __attribute__((aligned(16))) unsigned char lds_raw[];
    LAS unsigned char* lds = (LAS unsigned char*)lds_raw;
    volatile LAS unsigned* MISC = (volatile LAS unsigned*)(lds + MISC_OFF);
    const int tid = threadIdx.x, lane = tid & 63, wave = __builtin_amdgcn_readfirstlane(tid >> 6);
    const int G = gridDim.x; const int bx = blockIdx.x; const int vcu = (G % 8 == 0) ? (bx % 8) * (G / 8) + bx / 8 : bx;
    unsigned char* ws = args.ws;
    unsigned* ctl = (unsigned*)(ws + WS_CTL);
    const float* xp = args.in[0]; const float* xs = args.in[1]; const float* w_mix = args.in[2]; const float* w_in = args.in[3]; const float* lbp = args.in[4];
    const float* gnw = args.in[5]; const float* qnw = args.in[6]; const float* knw = args.in[7]; const float* rpb = args.in[8]; const float* w_out = args.in[9];
    const float* w_ffn = args.in[10]; const float* w_gate = args.in[11]; const float* w_up = args.in[12]; const float* w_down = args.in[13];
    float* out = args.out;
    bf16* Wgu_t = (bf16*)(ws + WS_WGU); bf16* Win_t = (bf16*)(ws + WS_WIN); bf16* Wout_t = (bf16*)(ws + WS_WOUT); bf16* Wdown_t = (bf16*)(ws + WS_WDOWN);
    bf16* XN = (bf16*)(ws + WS_A); bf16* OBk = (bf16*)out + 3 * (size_t)M * GW; bf16* Hb = (bf16*)(ws + WS_H); bf16* Ob = (bf16*)(ws + WS_O);
    bf16* X1b = (bf16*)(ws + WS_X1); bf16* HFF = (bf16*)(ws + WS_HFF); bf16* NAb = (bf16*)out; float* ssq = (float*)(ctl + CW_SSQ); float* SLb = (float*)(ws + WS_SL); float* Btb = (float*)(ctl + CW_BT);
    v4u* SFb = (v4u*)(ws + WS_SF);
    for (int u = tid; u < (LDS_BYTES - LDSCTL_OFF) / 4; u += NWAVES * 64) ((LAS unsigned*)(lds + LDSCTL_OFF))[u] = 0u;
    __syncthreads();
    const int lo = args.ph_lo, hi = args.ph_hi;
    XcdBarrier bar; bar.bar = ctl + CW_BAR; bar.x = 0; bar.st = nullptr;
    if (hi - lo > 1) bar = xcd_barrier_post(ctl + CW_BAR, MISC + 8);
#define IN(k) (lo <= (k) && (k) < hi)
#define SEAM(k) do { if (IN(k) && IN((k) + 1)) xcd_barrier(bar); } while (0)
#define SEAM_ARRIVE(k) do { if (IN(k) && IN((k) + 1)) bgen = xcd_barrier_arrive(bar); } while (0)
#define SEAM_WAIT(k) do { if (IN(k) && IN((k) + 1)) xcd_barrier_wait(bar, bgen); else __syncthreads(); } while (0)
    const int gw = vcu * NWAVES + wave, NGW = G * NWAVES;
    const bool full = (lo == 0 && hi == N_PHASES);
    unsigned bgen = 0u;
    if (full) { if (tid == 0 && bx < 8) __hip_atomic_store(&ctl[CW_XMAP + bx], xb_xcc_id() + 1u, __ATOMIC_RELAXED, __HIP_MEMORY_SCOPE_AGENT);
                bgen = xcd_barrier_arrive(bar); }

    if (IN(0)) REP(0) {
        LAS float* scr = (LAS float*)(lds + RING_OFF + wave * 16384);
        constexpr int I_IN = (D / 64) * (INC / 32), I_OUT = (D / 64) * (D / 32);
#define P0_LOAD(wv_, it_) do { if ((it_) < I_IN) tr_load(wv_, w_in, INC, (it_), lane); else tr_load(wv_, w_out, D, (it_) - I_IN, lane); } while (0)
#define P0_FIN(wv_, it_) do { if ((it_) < I_IN) tr_finish<0>(wv_, D, INC, Win_t, scr, (it_), lane, w_mix); else tr_finish<0>(wv_, D, D, Wout_t, scr, (it_) - I_IN, lane); } while (0)
        for (int it = gw; it < I_IN + I_OUT; it += 2 * NGW) { float wa[32], wb[32]; const bool two = it + NGW < I_IN + I_OUT;
            P0_LOAD(wa, it); if (two) P0_LOAD(wb, it + NGW);
            P0_FIN(wa, it); if (two) P0_FIN(wb, it + NGW); }
#undef P0_LOAD
#undef P0_FIN
        if (full) { xcd_barrier_poll(bar, bgen);
                    if (tid == 0 && (G % 8 != 0 || xb_ld(&ctl[CW_XMAP + (bx & 7)]) != xb_xcc_id() + 1u)) atomicOr(&ctl[CW_NONCANON], 1u);
                    bgen = xcd_barrier_arrive(bar); }
        for (int i = bx * (NWAVES * 64) + tid; i < M; i += G * NWAVES * 64) ssq[i] = 0.f;
        { float* rstd0 = (float*)(ctl + CW_RSTD0);
          if (G == 256) {
              const int tp0 = 16 * (bx & 7) + ((bx >> 3) & 7), rw0 = 64 * (bx >> 6) + 8 * wave;
#pragma unroll 1
              for (int it = 0; it < 4; ++it) { const float* xr[4]; bf16* orw[4]; float* rsp[4];
#pragma unroll
                  for (int r = 0; r < 4; ++r) { const int mm = 256 * (tp0 + 8 * (it >> 1)) + rw0 + 4 * (it & 1) + r; xr[r] = mm < MP ? xp + (size_t)mm * D : xs + (size_t)(mm - MP) * D; orw[r] = XN + (size_t)mm * D; rsp[r] = rstd0 + mm; }
                  rows_to_bf16_rstd<4>(xr, orw, rsp, lane); }
          } else
          for (int m = gw; m < M; m += 4 * NGW) {
              const float* xr[4]; bf16* orw[4]; float* rsp[4];
#pragma unroll
              for (int r = 0; r < 4; ++r) { const int mm = min(m + r * NGW, M - 1); xr[r] = mm < MP ? xp + (size_t)mm * D : xs + (size_t)(mm - MP) * D; orw[r] = XN + (size_t)mm * D; rsp[r] = rstd0 + mm; }
              rows_to_bf16_rstd<4>(xr, orw, rsp, lane); } }
    }
    unsigned* tcnt = ctl + CW_TB + 16 * (((bx & 7) << 3) | ((bx >> 3) & 7));
    if (full) { xcd_barrier_poll(bar, bgen); if (tid == 0) MISC[12] = xb_ld(&ctl[CW_NONCANON]); } else { SEAM(0); if (tid == 0) MISC[12] = 1u; }
    __syncthreads();
    const bool local_ok = (MISC[12] == 0u);
    const bool team_ok = local_ok && G == 256;
    unsigned lgen = 0u;
    if (full) { if (team_ok) team_barrier(tcnt, 0u, ctl + CW_BAR + XB_TMO); else xcd_barrier(bar); }
    if ((PROBE) == 100) { SEAM(0); SEAM(0); SEAM(0); SEAM(0); }
    if (IN(1)) REP(1) {
        pg8::Gemm g{XN, Win_t, M, INC, D}; pg8::StaticOrder S; S.init(M, INC, G, bx);
        EpiInProj E{Hb, NAb, lbp, (const float*)(ctl + CW_RSTD0)};
        pg8::gemm_phase<EpiInProj, pg8::StaticOrder, true, true>(lds + RING_OFF, g, S, E);
    }
    if (local_ok) { lgen = lb_arrive(bar, ctl); bgen = xcd_barrier_arrive(bar); lb_wait(bar, ctl, lgen); } else SEAM(1);
    if (wave >= 4) __builtin_amdgcn_s_setprio(1);
    if (IN(2)) {
        for (int rep_ = 0; rep_ < (((PROBE) == 20 || (PROBE) / 10 == 20) ? 2 : 1); ++rep_) for (int ch = vcu; ch < 256; ch += G) { const int dir = ch & 1, head = (ch >> 1) & 3, sg = ch >> 3;
            const int seq = sg < 16 ? sg >> 2 : 4 + ((sg - 16) >> 3), seg = sg < 16 ? sg & 3 : (sg - 16) & 7;
            const int s0 = seq < 4 ? seq * 4096 : MP + (seq - 4) * 8192;
            const int dm_ = (((PROBE) / 10 == 20 || (PROBE) == 20) && rep_ == 0) ? (1 | (((PROBE) / 10 == 20) ? ((PROBE) % 10) * 2 : 0)) : 0;
            if (dir) hgrn_chain<1>(lds, Hb, Hb + 2 * (size_t)M * GW, Hb + 3 * (size_t)M * GW, OBk + (size_t)head * ((size_t)M * 128), 128, s0, 16 * seg + 15, 16, head, SLb + (size_t)ch * 16384, Btb + ch * 128, dm_);
            else     hgrn_chain<0>(lds, Hb, Hb + (size_t)M * GW, Hb + 3 * (size_t)M * GW, Ob + head * 128, D, s0, 16 * seg, 16, head, SLb + (size_t)ch * 16384, Btb + ch * 128, dm_); }
        if (local_ok) xcd_barrier_wait(bar, bgen);
        if (team_ok) bgen = xcd_barrier_arrive(bar);
        REP(21) for (int ru = vcu; ru < 256; ru += G) { int seq, head, run;
            if (ru < 128) { seq = ru >> 5; head = (ru >> 2) & 7; run = ru & 3; } else { const int r2 = ru - 128, x2 = r2 >> 5, q2 = r2 & 31; seq = 4 + (x2 >> 1); head = q2 >> 2; run = 4 * (x2 & 1) + (q2 & 3); }
            const int s0 = seq < 4 ? seq * 4096 : MP + (seq - 4) * 8192, rows = seq < 4 ? 64 : 128;
            na_run(lds, NAb, NAb + (size_t)M * GW, NAb + 2 * (size_t)M * GW, qnw, knw, rpb, Ob, s0, rows, head, run * 16, 16); }
        if (team_ok) { __syncthreads(); if (tid == 0) (void)xb_add(&ctl[CW_NADONE], 1u); }
    }
    if (team_ok) {
        xcd_barrier_wait(bar, bgen);
        { const int xk = bx & 7, e_all = (bx >> 3) * (NWAVES * 64) + tid, seq = xk < 4 ? xk : 4 + ((xk - 4) >> 1);
          hgrn_scan(SLb, Btb, SFb, ((seq << 3) | (e_all >> 11)) * 2048 + (e_all & 2047), 1 << 30, xk); }
        lgen = lb_arrive(bar, ctl); lb_wait(bar, ctl, lgen);
    } else {
        SEAM(2);
        if (IN(3)) hgrn_scan(SLb, Btb, SFb, bx * (NWAVES * 64) + tid, G * NWAVES * 64);
        SEAM(3);
    }
    if (IN(4)) for (int rep_ = 0; rep_ < (((PROBE) == 4 || (PROBE) == 41 || (PROBE) == 42) ? 2 : 1); ++rep_) {
        const bool dry_ = ((PROBE) == 4 || (PROBE) == 41 || (PROBE) == 42) && rep_ == 0; const int mode_ = dry_ ? ((PROBE) == 41 ? 1 : ((PROBE) == 42 ? 2 : 0)) : 0;
        for (int un = vcu; un < 256; un += G) { const int half = un & 1, head = (un >> 1) & 3, sg = un >> 3;
            const int seq = sg < 16 ? sg >> 2 : 4 + ((sg - 16) >> 3), seg = sg < 16 ? sg & 3 : (sg - 16) & 7;
            const int s0 = seq < 4 ? seq * 4096 : MP + (seq - 4) * 8192;
            hgrn_pass2(lds, Hb + (size_t)M * GW, Hb + 2 * (size_t)M * GW, Hb + 4 * (size_t)M * GW, gnw, SFb, Ob, dry_ ? Hb + 3 * (size_t)M * GW : Ob, dry_ ? GW : D, OBk, s0, seg, sg, head, half, mode_); }
    }
    __builtin_amdgcn_s_setprio(0);
    SEAM_ARRIVE(4);
    if (team_ok) { if (tid == 0) XB_SPIN(xb_ld(&ctl[CW_NADONE]) < (unsigned)G, ctl + CW_BAR); __syncthreads(); }
    constexpr int I_G = (D / 64) * (FF / 32), I_D = (FF / 64) * (D / 32);
    if (IN(5)) {
        LAS float* scr = (LAS float*)(lds + RING_OFF + wave * 16384);
#define P5_LOAD(wv_, it_) do { if ((it_) < I_G) tr_load(wv_, w_gate, FF, (it_), lane); else if ((it_) < 2 * I_G) tr_load(wv_, w_up, FF, (it_) - I_G, lane); else tr_load(wv_, w_down, D, (it_) - 2 * I_G, lane); } while (0)
#define P5_FIN(wv_, it_) do { if ((it_) < I_G) tr_finish<1>(wv_, D, FF, Wgu_t, scr, (it_), lane, w_ffn); else if ((it_) < 2 * I_G) tr_finish<2>(wv_, D, FF, Wgu_t, scr, (it_) - I_G, lane, w_ffn); \
                else tr_finish<0>(wv_, FF, D, Wdown_t, scr, (it_) - 2 * I_G, lane); } while (0)
        for (int it = gw; it < 2 * I_G + I_D; it += 2 * NGW) { float wa[32], wb[32]; const bool two = it + NGW < 2 * I_G + I_D;
            P5_LOAD(wa, it); if (two) P5_LOAD(wb, it + NGW);
            P5_FIN(wa, it); if (two) P5_FIN(wb, it + NGW); }
#undef P5_LOAD
#undef P5_FIN
    }
    SEAM_WAIT(4);
    if (local_ok) bgen = xcd_barrier_arrive(bar);
    if (IN(5)) REP(5) {
        pg8::Gemm g{Ob, Wout_t, M, D, D}; pg8::StaticOrder S; S.init(M, D, G, bx);
        EpiOutProj E{XN, X1b, ssq};
        pg8::gemm_phase<EpiOutProj, pg8::StaticOrder, true, true>(lds + RING_OFF, g, S, E);
        __syncthreads(); if (tid == 0) (void)xb_add(&ctl[CW_P5DONE], 1u);
    }
    if (team_ok) { xcd_barrier_poll(bar, bgen); team_barrier(tcnt, 1u, ctl + CW_BAR + XB_TMO); }
    else if (local_ok) { lgen = lb_arrive(bar, ctl); lb_wait(bar, ctl, lgen); xcd_barrier_wait(bar, bgen); } else SEAM(5);
    if (IN(6)) REP(6) {
        pg8::Gemm g{X1b, Wgu_t, M, 2 * FF, D}; pg8::StaticOrder S; S.init(M, 2 * FF, G, bx);
        EpiGateUp E{HFF, ssq, ctl + CW_P5DONE, full ? (unsigned)G : 0u, false};
        pg8::gemm_phase<EpiGateUp, pg8::StaticOrder, true, true>(lds + RING_OFF, g, S, E);
        __syncthreads(); if (tid == 0) (void)xb_add(&ctl[CW_P6DONE], 1u);
    }
    if (team_ok) team_barrier(tcnt, 2u, ctl + CW_BAR + XB_TMO);
    else if (local_ok) { lgen = lb_arrive(bar, ctl); lb_wait(bar, ctl, lgen); } else SEAM(6);
    if (IN(7)) REP(7) {
        pg8::Gemm g{HFF, Wdown_t, M, D, FF}; pg8::StaticOrder S; S.init(M, D, G, bx);
        EpiDown E{out, X1b, ctl + CW_P6DONE, full ? (unsigned)G : 0u, false};
        pg8::gemm_phase<EpiDown, pg8::StaticOrder, true, true>(lds + RING_OFF, g, S, E);
    }
#undef IN
#undef SEAM
}

#ifndef N_LAUNCHES
#define N_LAUNCHES 1
#endif
extern "C" void kernel_launch(void* const* d_in, const int* in_sizes, int n_in, void* d_out, int out_size, void* d_ws, size_t ws_size, hipStream_t stream) {
    static int grid = 0;
    if (grid == 0) {
        if (n_in != 14 || out_size != 2 * MP * D || ws_size < WS_END) { fprintf(stderr, "kernel_launch: unexpected shapes (n_in %d out %d ws %zu)\n", n_in, out_size, ws_size); grid = -1; return; }
        int dev = 0, cus = 0;
        if (hipGetDevice(&dev) != hipSuccess || hipDeviceGetAttribute(&cus, hipDeviceAttributeMultiprocessorCount, dev) != hipSuccess) { grid = -1; return; }
        if (hipFuncSetAttribute((const void*)fwd_kernel, hipFuncAttributeMaxDynamicSharedMemorySize, LDS_BYTES) != hipSuccess) { fprintf(stderr, "kernel_launch: hipFuncSetAttribute failed\n"); grid = -1; return; }
        grid = cus;
    }
    if (grid < 0) return;
    (void)hipMemsetAsync((char*)d_ws + WS_CTL, 0, CTL_ZERO_BYTES, stream);
    Args a{};
    for (int i = 0; i < 14; ++i) a.in[i] = (const float*)d_in[i];
    a.out = (float*)d_out; a.ws = (unsigned char*)d_ws;
    if (N_LAUNCHES == 1) { a.ph_lo = 0; a.ph_hi = N_PHASES; hipLaunchKernelGGL(fwd_kernel, dim3(grid), dim3(NWAVES * 64), LDS_BYTES, stream, a); }
    else for (int p = 0; p < N_PHASES; ++p) { a.ph_lo = p; a.ph_hi = p + 1; hipLaunchKernelGGL(fwd_kernel, dim3(grid), dim3(NWAVES * 64), LDS_BYTES, stream, a); }
}
```

```cpp
#include <hip/hip_runtime.h>
#include <cstdio>
#include <cstdint>
namespace pg8 {
#define PG8_LAS __attribute__((address_space(3)))
typedef unsigned short bf16_t;
typedef short bf16x8 __attribute__((ext_vector_type(8)));
typedef float f32x4 __attribute__((ext_vector_type(4)));
typedef unsigned u32x4 __attribute__((ext_vector_type(4)));
constexpr int BM = 256, BK = 64, HALF = 128, HTB = HALF * BK * 2  , STAGE_BYTES = 8 * HTB, NXCD = 8, WGM = 8;

__host__ __device__ __forceinline__ int lds_byte(int r, int c) { const int st = (r >> 4) * 2 + (c >> 5), rr = r & 15, cc = c & 31, ob = rr * 64 + cc * 2; return st * 1024 + (ob ^ (((ob >> 9) & 1) << 5)); }
__host__ __device__ __forceinline__ void stage_rc(int b, int& R, int& C) { const int st = b / 1024, sb = b % 1024, swz = sb ^ (((sb >> 9) & 1) << 5); R = (st >> 1) * 16 + swz / 64; C = (st & 1) * 32 + (swz % 64) / 2; }
__host__ __device__ __forceinline__ int perm32(int rho) { const int n = rho >> 4, i = rho & 15; return 8 * (i >> 2) + 4 * n + (i & 3); }

struct Unit { int pm, pn; };
struct Gemm { const bf16_t* A; const bf16_t* Bt; int M, N, K; };

struct StaticOrder {
    int nM, nN, nwg, G, c;
    __host__ __device__ void init(int M, int N, int G_, int c_) { nM = M / BM; nN = N / BM; nwg = nM * nN; G = G_; c = c_; }
    __host__ __device__ bool next(int i, Unit& u) const {
        const long L = (long)i * G + c; if (L >= nwg) return false;
        int wgid = (int)L; { const int q = nwg / NXCD, r = nwg % NXCD, xcd = wgid % NXCD, off = wgid / NXCD; wgid = (xcd < r ? xcd * (q + 1) : r * (q + 1) + (xcd - r) * q) + off; }
        const int nig = WGM * nN, gid = wgid / nig, fm = gid * WGM, gsz = (nM - fm) < WGM ? (nM - fm) : WGM;
        u.pm = fm + ((wgid % nig) % gsz); u.pn = (wgid % nig) / gsz; return true;
    }
    __device__ __forceinline__ void a_ready(const Unit&) const {}
    __device__ __forceinline__ void done(const Unit&) const {}
};

__device__ __forceinline__ unsigned cvt_pk_bf16(float lo, float hi) { unsigned r; asm volatile("v_cvt_pk_bf16_f32 %0, %1, %2" : "=v"(r) : "v"(lo), "v"(hi)); return r; }
template <class Epi, class Sched, bool ALIGN_EPI = false, bool SP2 = false>
__device__ __forceinline__ void gemm_phase(PG8_LAS unsigned char* lds, const Gemm g, const Sched& S, const Epi& E) {
    const int tid = threadIdx.x, wid = __builtin_amdgcn_readfirstlane(tid >> 6), lane = tid & 63, wr = wid >> 2, wc = wid & 3, fr = lane & 15, fq = lane >> 4;
    const int K = g.K, nt = K / BK;
    unsigned voffA[2], voffB[2];
#pragma unroll
    for (int i = 0; i < 2; ++i) { int R, C; stage_rc(tid * 16 + i * 8192, R, C); const int Rb = Epi::PERM ? ((R & ~31) + perm32(R & 31)) : R;
        voffA[i] = (unsigned)(R * K + C) * 2u; voffB[i] = (unsigned)(Rb * K + C) * 2u; }
    const size_t kstep = (size_t)(BK * 2);
    const size_t hstep = (size_t)HALF * K * 2;
    const size_t tstep = 2 * hstep;
    const unsigned ldsw = (unsigned)wid * 1024u;
    const int aoff = lds_byte(wr * 64 + fr, fq * 8), boff = lds_byte(wc * 32 + fr, fq * 8);
#define PG8_SA(b, h) (((b) * 2 + (h)) * HTB)
#define PG8_SB(b, h) ((4 + (b) * 2 + (h)) * HTB)
#define PG8_STAGE(bufoff, gbase, voff) do { _Pragma("unroll") for (int _i = 0; _i < 2; ++_i) \
        __builtin_amdgcn_global_load_lds((const unsigned*)((const char*)(gbase) + (voff)[_i]), (PG8_LAS unsigned*)(lds + (bufoff) + ldsw + _i * 8192), 16, 0, 0); } while (0)
#define PG8_LDA(dst, b, h) do { _Pragma("unroll") for (int m = 0; m < 4; ++m) _Pragma("unroll") for (int k = 0; k < 2; ++k) dst[m][k] = *(const PG8_LAS bf16x8*)(lds + PG8_SA(b, h) + aoff + m * 2048 + k * 1024); } while (0)
#define PG8_LDB(dst, b, h) do { _Pragma("unroll") for (int n = 0; n < 2; ++n) _Pragma("unroll") for (int k = 0; k < 2; ++k) dst[n][k] = *(const PG8_LAS bf16x8*)(lds + PG8_SB(b, h) + boff + n * 2048 + k * 1024); } while (0)
#define PG8_MMA(ai, bj, At, Bt) do { __builtin_amdgcn_s_setprio(1); _Pragma("unroll") for (int m = 0; m < 4; ++m) _Pragma("unroll") for (int n = 0; n < 2; ++n) _Pragma("unroll") for (int k = 0; k < 2; ++k) \
        acc[ai][bj][m][n] = __builtin_amdgcn_mfma_f32_16x16x32_bf16(Bt[n][k], At[m][k], acc[ai][bj][m][n], 0, 0, 0); __builtin_amdgcn_s_setprio(0); } while (0)
#define PG8_WAIT_V(n) asm volatile("s_waitcnt vmcnt(" #n ")" ::: "memory")
#define PG8_WAIT_L(n) asm volatile("s_waitcnt lgkmcnt(" #n ")" ::: "memory")
#define PG8_BAR __builtin_amdgcn_s_barrier()
#define PG8_SCHED __builtin_amdgcn_sched_barrier(0)
    Unit cur, nxt; int ui = 0;
    if (!S.next(0, cur)) return;
    f32x4 acc[2][2][4][2];
#pragma unroll
    for (int a = 0; a < 2; ++a)
#pragma unroll
        for (int b = 0; b < 2; ++b)
#pragma unroll
            for (int m = 0; m < 4; ++m)
#pragma unroll
                for (int n = 0; n < 2; ++n) acc[a][b][m][n] = (f32x4){0.f, 0.f, 0.f, 0.f};
    bf16x8 At[4][2], B0[2][2], B1[2][2];
    const char* cA = (const char*)g.A + (size_t)cur.pm * tstep; const char* cB = (const char*)g.Bt + (size_t)cur.pn * tstep;
    S.a_ready(cur);
    if constexpr (SP2) {
        PG8_STAGE(PG8_SB(0, 0), cB, voffB); PG8_STAGE(PG8_SB(0, 1), cB + hstep, voffB); PG8_STAGE(PG8_SA(0, 0), cA, voffA); PG8_STAGE(PG8_SA(0, 1), cA + hstep, voffA);
        if (wr == 1) PG8_BAR;
        PG8_WAIT_V(2); PG8_BAR;
        PG8_STAGE(PG8_SB(1, 0), cB + kstep, voffB); PG8_STAGE(PG8_SA(1, 0), cA + kstep, voffA); PG8_STAGE(PG8_SB(1, 1), cB + hstep + kstep, voffB);
        PG8_WAIT_V(6); PG8_BAR;
    } else {
        PG8_STAGE(PG8_SB(0, 0), cB, voffB); PG8_STAGE(PG8_SA(0, 0), cA, voffA); PG8_STAGE(PG8_SB(0, 1), cB + hstep, voffB); PG8_STAGE(PG8_SA(0, 1), cA + hstep, voffA);
        if (wr == 1) PG8_BAR;
        PG8_WAIT_V(4); PG8_BAR;
        PG8_STAGE(PG8_SB(1, 0), cB + kstep, voffB); PG8_STAGE(PG8_SA(1, 0), cA + kstep, voffA); PG8_STAGE(PG8_SB(1, 1), cB + hstep + kstep, voffB);
        PG8_WAIT_V(6); PG8_BAR;
    }
    for (;;) {
        const bool has_next = S.next(ui + 1, nxt);
        const char* nA = has_next ? (const char*)g.A + (size_t)nxt.pm * tstep : cA; const char* nB = has_next ? (const char*)g.Bt + (size_t)nxt.pn * tstep : cB;
        for (int t = 0; t < nt; t += 2) {
            const bool last = (t == nt - 2);
            const char* a1 = cA + (size_t)(t + 1) * kstep;
            const char* a2 = last ? nA : cA + (size_t)(t + 2) * kstep; const char* b2 = last ? nB : cB + (size_t)(t + 2) * kstep;
            const char* a3 = a2 + kstep; const char* b3 = b2 + kstep;
            if (last && has_next) S.a_ready(nxt);
            if constexpr (SP2) {
            PG8_LDB(B0, 0, 0); PG8_LDB(B1, 0, 1); PG8_SCHED; PG8_LDA(At, 0, 0); PG8_STAGE(PG8_SA(1, 1), a1 + hstep, voffA);
            PG8_WAIT_V(8); PG8_WAIT_L(0); PG8_BAR; PG8_MMA(0, 0, At, B0); PG8_MMA(0, 1, At, B1); PG8_BAR; PG8_SCHED;
            PG8_LDA(At, 0, 1); PG8_STAGE(PG8_SB(0, 0), b2, voffB); PG8_STAGE(PG8_SB(0, 1), b2 + hstep, voffB); PG8_STAGE(PG8_SA(0, 0), a2, voffA);
            PG8_WAIT_V(8); PG8_WAIT_L(0); PG8_BAR; PG8_MMA(1, 0, At, B0); PG8_MMA(1, 1, At, B1); PG8_BAR; PG8_SCHED;
            PG8_LDB(B0, 1, 0); PG8_LDB(B1, 1, 1); PG8_SCHED; PG8_LDA(At, 1, 0); PG8_STAGE(PG8_SA(0, 1), a2 + hstep, voffA);
            PG8_WAIT_V(8); PG8_WAIT_L(0); PG8_BAR; PG8_MMA(0, 0, At, B0); PG8_MMA(0, 1, At, B1); PG8_BAR; PG8_SCHED;
            PG8_LDA(At, 1, 1); PG8_STAGE(PG8_SB(1, 0), b3, voffB); PG8_STAGE(PG8_SB(1, 1), b3 + hstep, voffB); PG8_STAGE(PG8_SA(1, 0), a3, voffA);
            PG8_WAIT_V(8); PG8_WAIT_L(0); PG8_BAR; PG8_MMA(1, 0, At, B0); PG8_MMA(1, 1, At, B1); PG8_BAR; PG8_SCHED;
            } else {
            PG8_LDB(B0, 0, 0); PG8_SCHED; PG8_LDA(At, 0, 0); PG8_STAGE(PG8_SA(1, 1), a1 + hstep, voffA);
            PG8_WAIT_L(8); PG8_BAR; PG8_WAIT_L(0); PG8_MMA(0, 0, At, B0); PG8_BAR; PG8_SCHED;
            PG8_LDB(B1, 0, 1); PG8_STAGE(PG8_SB(0, 0), b2, voffB);
            PG8_BAR; PG8_WAIT_L(0); PG8_MMA(0, 1, At, B1); PG8_BAR;
            PG8_LDA(At, 0, 1); PG8_STAGE(PG8_SA(0, 0), a2, voffA);
            PG8_BAR; PG8_WAIT_L(0); PG8_MMA(1, 0, At, B0); PG8_BAR; PG8_SCHED;
            PG8_STAGE(PG8_SB(0, 1), b2 + hstep, voffB);
            PG8_WAIT_V(6); PG8_BAR; PG8_MMA(1, 1, At, B1); PG8_BAR;
            PG8_LDB(B0, 1, 0); PG8_SCHED; PG8_LDA(At, 1, 0); PG8_STAGE(PG8_SA(0, 1), a2 + hstep, voffA);
            PG8_WAIT_L(8); PG8_BAR; PG8_WAIT_L(0); PG8_MMA(0, 0, At, B0); PG8_BAR; PG8_SCHED;
            PG8_LDB(B1, 1, 1); PG8_STAGE(PG8_SB(1, 0), b3, voffB);
            PG8_BAR; PG8_WAIT_L(0); PG8_MMA(0, 1, At, B1); PG8_BAR;
            PG8_LDA(At, 1, 1); PG8_STAGE(PG8_SA(1, 0), a3, voffA);
            PG8_BAR; PG8_WAIT_L(0); PG8_MMA(1, 0, At, B0); PG8_BAR; PG8_SCHED;
            PG8_STAGE(PG8_SB(1, 1), b3 + hstep, voffB);
            PG8_WAIT_V(6); PG8_BAR; PG8_MMA(1, 1, At, B1); PG8_BAR;
            }
        }
        if constexpr (ALIGN_EPI) { if (wr == 0) PG8_BAR; }
        if constexpr (!Epi::AFTER_DRAIN) { E(acc, cur, wr, wc, fr, fq); S.done(cur); }
        if (!has_next) break;
#pragma unroll
        for (int a = 0; a < 2; ++a)
#pragma unroll
            for (int b = 0; b < 2; ++b)
#pragma unroll
                for (int m = 0; m < 4; ++m)
#pragma unroll
                    for (int n = 0; n < 2; ++n) acc[a][b][m][n] = (f32x4){0.f, 0.f, 0.f, 0.f};
        cur = nxt; cA = nA; cB = nB; ++ui;
        if constexpr (ALIGN_EPI) { if (wr == 1) PG8_BAR; }
    }
    PG8_WAIT_V(0);
    if constexpr (!ALIGN_EPI) { if (wr == 0) PG8_BAR; }
    PG8_BAR;
    if constexpr (Epi::AFTER_DRAIN) { E.fused(acc, cur, wr, wc, fr, fq, lds, wid, lane); S.done(cur); }
#undef PG8_SA
#undef PG8_SB
#undef PG8_STAGE
#undef PG8_LDA
#undef PG8_LDB
#undef PG8_MMA
#undef PG8_WAIT_V
#undef PG8_WAIT_L
#undef PG8_BAR
#undef PG8_SCHED
}
}

#ifndef PROBE
#define PROBE -1
#endif

constexpr int NWAVES = 8;
constexpr int M = 32768, MP = 16384, D = 1024, INC = 4096, FF = 2816, GW = 512;
constexpr float EPS = 1e-6f;
constexpr size_t MiB = 1u << 20;
constexpr size_t WS_CTL = 0, CTL_BYTES = 1 * MiB, CTL_ZERO_BYTES = 32768;
constexpr size_t WS_WIN = 1 * MiB;
constexpr size_t WS_WOUT = 9 * MiB;
constexpr size_t WS_WGU = 11 * MiB;
constexpr size_t WS_WDOWN = 22 * MiB;
constexpr size_t WS_A = 28 * MiB;
constexpr size_t WS_O = 92 * MiB;
constexpr size_t WS_H = 156 * MiB;
constexpr size_t WS_SL = 316 * MiB;
constexpr size_t WS_SF = 332 * MiB;
constexpr size_t WS_X1 = 340 * MiB;
constexpr size_t WS_HFF = WS_H;
constexpr size_t WS_END = 404 * MiB;
static_assert(WS_HFF + (size_t)M * FF * 2 <= WS_SF && WS_SL + 16 * MiB <= WS_SF, "ws map");
constexpr int CW_BAR = 4096;
constexpr int CW_LB = 0;
constexpr int CW_NONCANON = 3072;
constexpr int CW_TB = 2048;
constexpr int CW_P4DONE = 3264;
constexpr int CW_XMAP = 3136;
constexpr int CW_RSTD0 = 98304;
constexpr int CW_SSQ = 65536;
constexpr int CW_BT = 131072;
static_assert((CW_SSQ + M) <= CW_BT && (CW_BT + 256 * 128) * 4 <= (int)CTL_BYTES && (CW_BAR + 3456) * 4 <= (int)CTL_ZERO_BYTES, "ctl");
constexpr int RING_OFF = 0, RING_BYTES = 131072;
constexpr int LDS_BYTES = 163840;
constexpr int LDSCTL_OFF = 159744, MISC_OFF = LDSCTL_OFF + 320;

#define GAS __attribute__((address_space(1)))
#define LAS __attribute__((address_space(3)))
typedef unsigned short bf16;
typedef unsigned v4u __attribute__((ext_vector_type(4)));
typedef unsigned v2u __attribute__((ext_vector_type(2)));
typedef float f32x4 __attribute__((ext_vector_type(4)));
typedef float f32x2 __attribute__((ext_vector_type(2)));
#define LDS_WAIT() asm volatile("s_waitcnt lgkmcnt(0)" ::: "memory")
#define VM_WAIT() asm volatile("s_waitcnt vmcnt(0)" ::: "memory")
__device__ __forceinline__ unsigned f2bf(float f) { unsigned u = __builtin_bit_cast(unsigned, f); return (u + 0x7fffu + ((u >> 16) & 1u)) >> 16; }
__device__ __forceinline__ unsigned pk2(float lo, float hi) { return f2bf(lo) | (f2bf(hi) << 16); }
__device__ __forceinline__ float bflo(unsigned w) { return __builtin_bit_cast(float, w << 16); }
__device__ __forceinline__ float bfhi(unsigned w) { return __builtin_bit_cast(float, w & 0xffff0000u); }
typedef float f32x2_t __attribute__((ext_vector_type(2))); typedef __bf16 bf16x2_t __attribute__((ext_vector_type(2)));
__device__ __forceinline__ unsigned cvtpk(float lo, float hi) { f32x2_t v = {lo, hi}; bf16x2_t b = __builtin_convertvector(v, bf16x2_t); return __builtin_bit_cast(unsigned, b); }
__device__ __forceinline__ float ex2_(float x) { return __builtin_amdgcn_exp2f(x); }
__device__ __forceinline__ float rcp_(float x) { return __builtin_amdgcn_rcpf(x); }
__device__ __forceinline__ float rsq_(float x) { return __builtin_amdgcn_rsqf(x); }
template <int CTRL> __device__ __forceinline__ float dpp_(float v) { return __builtin_bit_cast(float, __builtin_amdgcn_update_dpp(0, __builtin_bit_cast(int, v), CTRL, 0xF, 0xF, false)); }
__device__ __forceinline__ float sum8_(float v) { v += dpp_<0xB1>(v); v += dpp_<0x4E>(v); v += dpp_<0x141>(v); return v; }
__device__ __forceinline__ float sum16_(float v) { v = sum8_(v); v += dpp_<0x140>(v); return v; }
__device__ __forceinline__ float sigmoidf_(float x) { return rcp_(1.f + ex2_(-1.44269504089f * x)); }
__device__ __forceinline__ float siluf_(float x) { return x * rcp_(1.f + ex2_(-1.44269504089f * x)); }

#define XB_TMO      128
#define XB_XCNT(j)  (256  + 64 * (j))
#define XB_XSUB(j)  (1280 + 64 * (j))
#define XB_XGEN(j)  (2304 + 64 * (j))
#define XB_TOP      3328
#define XB_TOPGEN   3392
#define XCD_BAR_WORDS 3456
#define XB_SPIN_CAP (1u << 18)
__device__ __forceinline__ unsigned xb_ld(unsigned* p)              { return __hip_atomic_load(p, __ATOMIC_RELAXED, __HIP_MEMORY_SCOPE_AGENT); }
__device__ __forceinline__ unsigned xb_add(unsigned* p, unsigned v) { return __hip_atomic_fetch_add(p, v, __ATOMIC_RELAXED, __HIP_MEMORY_SCOPE_AGENT); }
__device__ __forceinline__ unsigned xb_xcc_id() { return (unsigned)__builtin_amdgcn_s_getreg((3 << 11) | 20) & 0xFu; }
#define XB_SPIN(cond, bar) do { unsigned _sp = 0; while (cond) { __builtin_amdgcn_s_sleep(1); \
    if ((++_sp & 255u) == 0u) { if (xb_ld(&(bar)[XB_TMO])) break; if (_sp > XB_SPIN_CAP) { atomicAdd(&(bar)[XB_TMO], 1u); break; } } } } while (0)
struct XcdBarrier { unsigned* bar; unsigned x; volatile LAS unsigned* st; };
__device__ __forceinline__ XcdBarrier xcd_barrier_post(unsigned* bar, volatile LAS unsigned* st) {
    XcdBarrier b; b.bar = bar; b.x = xb_xcc_id(); b.st = st;
    if (threadIdx.x == 0) (void)xb_add(&bar[XB_XCNT(b.x)], 1u);
    return b;
}
__device__ __forceinline__ void xcd_barrier_complete(unsigned* bar, unsigned x, unsigned& nloc, unsigned& nx) {
    const unsigned G = gridDim.x * gridDim.y * gridDim.z;
    unsigned sum, cnt, mine, sp = 0u;
    for (;;) {
        sum = 0u; cnt = 0u; mine = 0u;
#pragma unroll
        for (unsigned j = 0; j < 16; ++j) { const unsigned c = xb_ld(&bar[XB_XCNT(j)]); sum += c; cnt += (c > 0u) ? 1u : 0u; mine = (j == x) ? c : mine; }
        if (sum == G) break;
        __builtin_amdgcn_s_sleep(1);
        if ((++sp & 255u) == 0u) { if (xb_ld(&bar[XB_TMO])) break; if (sp > XB_SPIN_CAP) { atomicAdd(&bar[XB_TMO], 1u); break; } }
    }
    nloc = mine > 0u ? mine : 1u; nx = cnt > 0u ? cnt : 1u;
}
__device__ __forceinline__ void xcd_barrier(const XcdBarrier& b) {
    asm volatile("s_waitcnt vmcnt(0)" ::: "memory");
    __syncthreads();
    if (threadIdx.x == 0) {
        unsigned* bar = b.bar;
        __builtin_amdgcn_s_waitcnt(0);
        unsigned nloc = b.st[0], nx = b.st[1];
        if (nloc == 0u) { xcd_barrier_complete(bar, b.x, nloc, nx); b.st[0] = nloc; b.st[1] = nx; }
        const unsigned old = xb_add(&bar[XB_XSUB(b.x)], 1u);
        const unsigned gen = old / nloc;
        if (old + 1u == (gen + 1u) * nloc) {
            __builtin_amdgcn_fence(__ATOMIC_RELEASE, "agent");
            asm volatile("s_waitcnt vmcnt(0)" ::: "memory");
            const unsigned og = xb_add(&bar[XB_TOP], 1u);
            const unsigned tg = og / nx;
            if (og + 1u == (tg + 1u) * nx) xb_add(&bar[XB_TOPGEN], 1u);
            else XB_SPIN(xb_ld(&bar[XB_TOPGEN]) == tg, bar);
            __builtin_amdgcn_fence(__ATOMIC_ACQUIRE, "agent");
            xb_add(&bar[XB_XGEN(b.x)], 1u);
            asm volatile("s_waitcnt vmcnt(0)" ::: "memory");
        } else {
            XB_SPIN(xb_ld(&bar[XB_XGEN(b.x)]) == gen, bar);
            __builtin_amdgcn_fence(__ATOMIC_ACQUIRE, "agent");
            asm volatile("s_waitcnt vmcnt(0)" ::: "memory");
        }
    }
    __syncthreads();
}

__device__ __forceinline__ unsigned xcd_barrier_arrive(const XcdBarrier& b) {
    unsigned gen = 0u;
    asm volatile("s_waitcnt vmcnt(0)" ::: "memory");
    __syncthreads();
    if (threadIdx.x == 0) {
        unsigned* bar = b.bar;
        __builtin_amdgcn_s_waitcnt(0);
        unsigned nloc = b.st[0], nx = b.st[1];
        if (nloc == 0u) { xcd_barrier_complete(bar, b.x, nloc, nx); b.st[0] = nloc; b.st[1] = nx; }
        const unsigned old = xb_add(&bar[XB_XSUB(b.x)], 1u);
        gen = old / nloc;
        if (old + 1u == (gen + 1u) * nloc) {
            __builtin_amdgcn_fence(__ATOMIC_RELEASE, "agent");
            asm volatile("s_waitcnt vmcnt(0)" ::: "memory");
            const unsigned og = xb_add(&bar[XB_TOP], 1u);
            const unsigned tg = og / nx;
            if (og + 1u == (tg + 1u) * nx) xb_add(&bar[XB_TOPGEN], 1u);
            xb_add(&bar[XB_XGEN(b.x)], 1u);
        }
    }
    return gen;
}
__device__ __forceinline__ void xcd_barrier_poll(const XcdBarrier& b, unsigned gen) {
    if (threadIdx.x == 0) { unsigned* bar = b.bar; XB_SPIN(xb_ld(&bar[XB_TOPGEN]) == gen, bar); }
}
__device__ __forceinline__ void xcd_barrier_wait(const XcdBarrier& b, unsigned gen) {
    if (threadIdx.x == 0) {
        unsigned* bar = b.bar;
        XB_SPIN(xb_ld(&bar[XB_TOPGEN]) == gen, bar);
        __builtin_amdgcn_fence(__ATOMIC_ACQUIRE, "agent");
        asm volatile("s_waitcnt vmcnt(0)" ::: "memory");
    }
    __syncthreads();
}

#define XL_SUB(j) (CW_LB + 64 * (j))
#define XL_GEN(j) (CW_LB + 1024 + 64 * (j))
__device__ __forceinline__ unsigned lb_arrive(const XcdBarrier& b, unsigned* ctl) {
    unsigned gen = 0u;
    asm volatile("s_waitcnt vmcnt(0)" ::: "memory");
    __syncthreads();
    if (threadIdx.x == 0) {
        __builtin_amdgcn_s_waitcnt(0);
        const unsigned nloc = b.st[0];
        const unsigned old = xb_add(&ctl[XL_SUB(b.x)], 1u);
        gen = old / nloc;
        if (old + 1u == (gen + 1u) * nloc) xb_add(&ctl[XL_GEN(b.x)], 1u);
    }
    return gen;
}
__device__ __forceinline__ void lb_wait(const XcdBarrier& b, unsigned* ctl, unsigned gen) {
    if (threadIdx.x == 0) {
        XB_SPIN(xb_ld(&ctl[XL_GEN(b.x)]) == gen, b.bar);
        __builtin_amdgcn_fence(__ATOMIC_ACQUIRE, "agent");
        asm volatile("s_waitcnt vmcnt(0)" ::: "memory");
    }
    __syncthreads();
}

__device__ __forceinline__ void team_barrier(unsigned* cnt, unsigned gen, unsigned* tmo) {
    asm volatile("s_waitcnt vmcnt(0)" ::: "memory");
    __syncthreads();
    if (threadIdx.x == 0) {
        __builtin_amdgcn_s_waitcnt(0);
        (void)xb_add(cnt, 1u);
        XB_SPIN(xb_ld(cnt) < 4u * (gen + 1u), tmo - XB_TMO);
        __builtin_amdgcn_fence(__ATOMIC_ACQUIRE, "agent");
        asm volatile("s_waitcnt vmcnt(0)" ::: "memory");
    }
    __syncthreads();
}

struct EpiInProj {
    static constexpr bool PERM = true, AFTER_DRAIN = false;
    bf16* hbase; bf16* nabase; const float* lbp; const float* rstd0;
    __device__ __forceinline__ void operator()(const pg8::f32x4 (&acc)[2][2][4][2], const pg8::Unit& u, int wr, int wc, int fr, int fq) const {
        const int ot = u.pn;
        const int grp = ot >> 1;
        bf16* base = grp < 5 ? hbase + (size_t)grp * ((size_t)M * GW) : nabase + (size_t)(grp - 5) * ((size_t)M * GW);
        const int row0 = u.pm * 256 + wr * 64 + fr;
        const int col0 = (ot & 1) * 256 + wc * 32 + 8 * fq;
        float rs_[2][4];
#pragma unroll
        for (int ai = 0; ai < 2; ++ai)
#pragma unroll
            for (int m = 0; m < 4; ++m) rs_[ai][m] = rstd0[row0 + ai * 128 + m * 16];
        float lb[2][8];
#pragma unroll
        for (int bj = 0; bj < 2; ++bj)
#pragma unroll
            for (int e = 0; e < 8; ++e) lb[bj][e] = 0.f;
        if (grp == 1 || grp == 2) {
#pragma unroll
            for (int bj = 0; bj < 2; ++bj)
#pragma unroll
                for (int e = 0; e < 8; ++e) { const int c = (grp - 1) * GW + col0 + bj * 128 + e; lb[bj][e] = rcp_(1.f + ex2_(1.44269504089f * (lbp[1024 + c] - lbp[c]))); }
        }
#pragma unroll
        for (int ai = 0; ai < 2; ++ai)
#pragma unroll
            for (int m = 0; m < 4; ++m) { const size_t row = (size_t)(row0 + ai * 128 + m * 16);
#pragma unroll
                for (int bj = 0; bj < 2; ++bj) {
                    float v[8];
#pragma unroll
                    for (int e = 0; e < 4; ++e) { v[e] = acc[ai][bj][m][0][e] * rs_[ai][m]; v[4 + e] = acc[ai][bj][m][1][e] * rs_[ai][m]; }
                    if (grp == 0 || grp == 4) {
#pragma unroll
                        for (int e = 0; e < 8; ++e) v[e] = siluf_(v[e]);
                    } else if (grp == 1 || grp == 2) {
#pragma unroll
                        for (int e = 0; e < 8; ++e) v[e] = __builtin_amdgcn_logf(lb[bj][e] + (1.f - lb[bj][e]) * sigmoidf_(v[e]));
                    }
                    pg8::u32x4 w; w.x = cvtpk(v[0], v[1]); w.y = cvtpk(v[2], v[3]); w.z = cvtpk(v[4], v[5]); w.w = cvtpk(v[6], v[7]);
                    bf16* dst = grp < 5 ? base + (size_t)((ot & 1) * 2 + bj) * ((size_t)M * 128) + row * 128 + wc * 32 + 8 * fq
                                        : base + (size_t)((ot & 1) * 4 + bj * 2 + (wc >> 1)) * ((size_t)M * 64) + row * 64 + (wc & 1) * 32 + 8 * fq;
                    *(pg8::u32x4*)dst = w; } }
    }
};
struct EpiOutProj {
    static constexpr bool PERM = true, AFTER_DRAIN = false;
    const bf16* xb; bf16* x1b; float* ssq;
    __device__ __forceinline__ void operator()(const pg8::f32x4 (&acc)[2][2][4][2], const pg8::Unit& u, int wr, int wc, int fr, int fq) const {
        const int row0 = u.pm * 256 + wr * 64 + fr, col0 = u.pn * 256 + wc * 32 + 8 * fq;
        const bf16* xbase = xb + (size_t)row0 * D + col0;
#pragma unroll
        for (int ai = 0; ai < 2; ++ai) {
            pg8::u32x4 xw[4][2];
#pragma unroll
            for (int m = 0; m < 4; ++m)
#pragma unroll
                for (int bj = 0; bj < 2; ++bj) xw[m][bj] = __builtin_nontemporal_load((const pg8::u32x4*)(xbase + (size_t)(ai * 128 + m * 16) * D + bj * 128));
            __builtin_amdgcn_sched_barrier(0);
            float sq4[4];
#pragma unroll
            for (int m = 0; m < 4; ++m) { const int row = row0 + ai * 128 + m * 16;
                bf16* nrow = x1b + (size_t)row * D + col0;
                float sq = 0.f;
#pragma unroll
                for (int bj = 0; bj < 2; ++bj) {
                    const pg8::u32x4 x_ = xw[m][bj];
                    pg8::f32x4 a0 = acc[ai][bj][m][0], a1 = acc[ai][bj][m][1];
                    a0[0] += bflo(x_.x); a0[1] += bfhi(x_.x); a0[2] += bflo(x_.y); a0[3] += bfhi(x_.y); a1[0] += bflo(x_.z); a1[1] += bfhi(x_.z); a1[2] += bflo(x_.w); a1[3] += bfhi(x_.w);
                    sq += (a0[0] * a0[0] + a0[1] * a0[1]) + (a0[2] * a0[2] + a0[3] * a0[3]) + (a1[0] * a1[0] + a1[1] * a1[1]) + (a1[2] * a1[2] + a1[3] * a1[3]);
                    pg8::u32x4 w; w.x = cvtpk(a0[0], a0[1]); w.y = cvtpk(a0[2], a0[3]); w.z = cvtpk(a1[0], a1[1]); w.w = cvtpk(a1[2], a1[3]);
                    *(pg8::u32x4*)(nrow + bj * 128) = w; }
                sq4[m] = sq; }
#pragma unroll
            for (int m = 0; m < 4; ++m) sq4[m] += __shfl_xor(sq4[m], 16);
#pragma unroll
            for (int m = 0; m < 4; ++m) sq4[m] += __shfl_xor(sq4[m], 32);
            if (fq == 0) {
#pragma unroll
                for (int m = 0; m < 4; ++m) atomicAdd(ssq + row0 + ai * 128 + m * 16, sq4[m]); }
            __builtin_amdgcn_sched_barrier(0);
        }
    }
};
struct EpiGateUp {
    static constexpr bool PERM = true, AFTER_DRAIN = false;
    bf16* h; const float* ssq; unsigned* guard; unsigned need; mutable bool checked;
    __device__ __forceinline__ void operator()(const pg8::f32x4 (&acc)[2][2][4][2], const pg8::Unit& u, int wr, int wc, int fr, int fq) const {
        const int row0 = u.pm * 256 + wr * 64 + fr, col0 = u.pn * 128 + wc * 32 + 8 * fq;
        float sqv[2][4];
#pragma unroll
        for (int ai = 0; ai < 2; ++ai)
#pragma unroll
            for (int m = 0; m < 4; ++m) sqv[ai][m] = ssq[row0 + ai * 128 + m * 16];
        unsigned gv = checked ? need : xb_ld(guard);
        __builtin_amdgcn_sched_barrier(0);
        while (gv < need) { __builtin_amdgcn_s_sleep(2); gv = xb_ld(guard); }
        checked = true;
#pragma unroll
        for (int ai = 0; ai < 2; ++ai)
#pragma unroll
            for (int m = 0; m < 4; ++m) { const int row = row0 + ai * 128 + m * 16;
                const float rstd = rsq_(sqv[ai][m] * (((PROBE) == 5 ? 0.5f : 1.f) / D) + EPS);
                float v[8];
#pragma unroll
                for (int e = 0; e < 4; ++e) { v[e] = siluf_(acc[ai][0][m][0][e] * rstd) * (acc[ai][1][m][0][e] * rstd); v[4 + e] = siluf_(acc[ai][0][m][1][e] * rstd) * (acc[ai][1][m][1][e] * rstd); }
                pg8::u32x4 w; w.x = cvtpk(v[0], v[1]); w.y = cvtpk(v[2], v[3]); w.z = cvtpk(v[4], v[5]); w.w = cvtpk(v[6], v[7]);
                *(pg8::u32x4*)(h + (size_t)row * FF + col0) = w; }
    }
};
struct EpiDown {
    static constexpr bool PERM = true, AFTER_DRAIN = false;
    float* out; const bf16* x1b; unsigned* guard; unsigned need; mutable bool checked;
    __device__ __forceinline__ void operator()(const pg8::f32x4 (&acc)[2][2][4][2], const pg8::Unit& u, int wr, int wc, int fr, int fq) const {
        const int row0 = u.pm * 256 + wr * 64 + fr, col0 = u.pn * 256 + wc * 32 + 8 * fq;
        pg8::u32x4 xw[2][4][2];
#pragma unroll
        for (int ai = 0; ai < 2; ++ai)
#pragma unroll
            for (int m = 0; m < 4; ++m)
#pragma unroll
                for (int bj = 0; bj < 2; ++bj) xw[ai][m][bj] = __builtin_nontemporal_load((const pg8::u32x4*)(x1b + (size_t)(row0 + ai * 128 + m * 16) * D + col0 + bj * 128));
        unsigned gv = checked ? need : xb_ld(guard);
        __builtin_amdgcn_sched_barrier(0);
        while (gv < need) { __builtin_amdgcn_s_sleep(2); gv = xb_ld(guard); }
        checked = true;
#pragma unroll
        for (int ai = 0; ai < 2; ++ai)
#pragma unroll
            for (int m = 0; m < 4; ++m) { float* orow = out + (size_t)(row0 + ai * 128 + m * 16) * D + col0;
#pragma unroll
                for (int bj = 0; bj < 2; ++bj) { const pg8::u32x4 x = xw[ai][m][bj];
                    pg8::f32x4 a0 = acc[ai][bj][m][0], a1 = acc[ai][bj][m][1];
                    a0[0] += bflo(x.x); a0[1] += bfhi(x.x); a0[2] += bflo(x.y); a0[3] += bfhi(x.y); a1[0] += bflo(x.z); a1[1] += bfhi(x.z); a1[2] += bflo(x.w); a1[3] += bfhi(x.w);
                    __builtin_nontemporal_store(a0, (pg8::f32x4*)(orow + bj * 128)); __builtin_nontemporal_store(a1, (pg8::f32x4*)(orow + bj * 128 + 4)); } }
    }
};

__device__ __forceinline__ float wave_sum(float v) { v = sum16_(v); v += __shfl_xor(v, 16); v += __shfl_xor(v, 32); return v; }
__device__ __forceinline__ void tr_load(float (&wv)[32], const float* W, int N, int item, int lane) {
    const int nblk = N / 32, kb = item / nblk, nb = item % nblk, k0 = 64 * kb, n0 = 32 * nb;
#pragma unroll
    for (int i = 0; i < 32; ++i) wv[i] = __builtin_nontemporal_load(W + (size_t)(k0 + 2 * i + (lane >> 5)) * N + n0 + (lane & 31));
}
template <int MODE>
__device__ __forceinline__ void tr_finish(float (&wv)[32], int K, int N, bf16* WT, LAS float* scr, int item, int lane, const float* ksc = nullptr) {
    const int nblk = N / 32, kb = item / nblk, nb = item % nblk, k0 = 64 * kb, n0 = 32 * nb;
    if (ksc) {
#pragma unroll
        for (int i = 0; i < 32; ++i) wv[i] *= ksc[k0 + 2 * i + (lane >> 5)];
    }
#pragma unroll
    for (int i = 0; i < 32; ++i) scr[(2 * i + (lane >> 5)) * 33 + (lane & 31)] = wv[i];
    LDS_WAIT(); asm volatile("" ::: "memory");
    const int c = lane & 7;
    const int d0 = MODE == 0 ? n0 : (256 * (n0 / 128) + (n0 % 128) + (MODE == 2 ? 128 : 0));
#pragma unroll
    for (int j = 0; j < 4; ++j) { const int n = (lane >> 3) + 8 * j; const LAS float* s = scr + (8 * c) * 33 + n;
        v4u o; o.x = pk2(s[0 * 33], s[1 * 33]); o.y = pk2(s[2 * 33], s[3 * 33]); o.z = pk2(s[4 * 33], s[5 * 33]); o.w = pk2(s[6 * 33], s[7 * 33]);
        *(v4u*)(WT + (size_t)(d0 + n) * K + k0 + 8 * c) = o; }
    LDS_WAIT(); asm volatile("" ::: "memory");
}
template <int NR>
__device__ __forceinline__ void rows_to_bf16_rstd(const float* const (&xrow)[NR], bf16* const (&orow)[NR], float* const (&rsp)[NR], int lane) {
    f32x4 v[NR][4];
#pragma unroll
    for (int r = 0; r < NR; ++r)
#pragma unroll
        for (int j = 0; j < 4; ++j) v[r][j] = __builtin_nontemporal_load((const f32x4*)xrow[r] + lane + 64 * j);
#pragma unroll
    for (int r = 0; r < NR; ++r) { float s = 0.f;
#pragma unroll
        for (int j = 0; j < 4; ++j) s += (v[r][j].x * v[r][j].x + v[r][j].y * v[r][j].y) + (v[r][j].z * v[r][j].z + v[r][j].w * v[r][j].w);
        const float rstd = rsq_(wave_sum(s) * (1.f / D) + EPS);
        if (lane == 0) *rsp[r] = rstd;
        unsigned long long* o8 = (unsigned long long*)orow[r] + lane;
#pragma unroll
        for (int j = 0; j < 4; ++j) o8[64 * j] = (unsigned long long)pk2(v[r][j].x, v[r][j].y) | ((unsigned long long)pk2(v[r][j].z, v[r][j].w) << 32); }
}

struct Args { const float* in[14]; float* out; unsigned char* ws; int ph_lo, ph_hi; };

#define LDS_BARRIER() do { asm volatile("s_waitcnt lgkmcnt(0)" ::: "memory"); __builtin_amdgcn_s_barrier(); asm volatile("" ::: "memory"); } while (0)
typedef short s16x8 __attribute__((ext_vector_type(8)));
typedef short s16x4 __attribute__((ext_vector_type(4)));
__device__ __forceinline__ s16x4 tr16(const LAS unsigned char* p) { return __builtin_bit_cast(s16x4, __builtin_amdgcn_ds_read_tr16_b64_v4i16((LAS s16x4*)p)); }
__device__ __forceinline__ s16x8 mk8(s16x4 a, s16x4 b) { s16x8 r; r[0] = a[0]; r[1] = a[1]; r[2] = a[2]; r[3] = a[3]; r[4] = b[0]; r[5] = b[1]; r[6] = b[2]; r[7] = b[3]; return r; }
__device__ __forceinline__ s16x8 mk8u(unsigned a, unsigned b, unsigned c, unsigned d) { v4u t; t.x = a; t.y = b; t.z = c; t.w = d; return __builtin_bit_cast(s16x8, t); }
constexpr int TP = 288, AP = 144, TPQ = 272;
#define SWZ3(row_, colbyte_) ((colbyte_) ^ ((((row_) >> 3) & 1) << 7))
constexpr int HT_Q = 0, HT_G = 18432, HT_V = 36864, HT_QH = 55296, HT_KH = 73728, HT_A = 92160, HT_TOT = 101376, HT_DV = 105472, HT_V2 = 106496;
struct HGRegs { unsigned qw[8], gw[8]; v4u v0, v1; };
#define HG_LOAD(R_, cidx_) do { const size_t rb_ = hbase_ + (size_t)(s0 + 64 * (cidx_)) * 128; \
        _Pragma("unroll") for (int i_ = 0; i_ < 8; ++i_) { R_.qw[i_] = *(const unsigned*)(Hq + rb_ + (size_t)(8 * w + i_) * 128 + 2 * lane); R_.gw[i_] = *(const unsigned*)(Hg + rb_ + (size_t)(8 * w + i_) * 128 + 2 * lane); } \
        R_.v0 = *(const v4u*)(Hv + rb_ + (size_t)lr * 128 + lc * 8); R_.v1 = *(const v4u*)(Hv + rb_ + (size_t)(lr + 32) * 128 + lc * 8); } while (0)
template <int dir>
__device__ __forceinline__ void hgrn_step(LAS unsigned char* lds, const bf16* Hq, bf16* Hg, const bf16* Hv, bf16* Oo, int opitch, int s0, int cfirst, int nsteps, int head, int it, int dmode,
                                          HGRegs& R, f32x4 (&S)[8], float& bacc0, float& bacc1) {
    const int tid = threadIdx.x, lane = tid & 63, w = __builtin_amdgcn_readfirstlane(tid >> 6), h = lane >> 4, i16 = lane & 15, q4 = i16 >> 2, p4 = i16 & 3;
    LAS unsigned char* TQ = lds + HT_Q; LAS unsigned char* TG = lds + HT_G; LAS unsigned char* TV = lds + ((it & 1) ? HT_V2 : HT_V); LAS unsigned char* TQH = lds + HT_QH; LAS unsigned char* TKH = lds + HT_KH;
    LAS unsigned char* AM = lds + HT_A; LAS float* TOT = (LAS float*)(lds + HT_TOT); LAS float* DV = (LAS float*)(lds + HT_DV);
    const int lr = tid >> 4, lc = tid & 15;
    const size_t hbase_ = (size_t)head * ((size_t)M * 128);
    {
        const int cidx = dir ? cfirst - it : cfirst + it;
        *(LAS v4u*)(TV + lr * TP + SWZ3(lr, lc * 16)) = R.v0; *(LAS v4u*)(TV + (lr + 32) * TP + SWZ3(lr, lc * 16)) = R.v1;
        float glo[8], ghi[8], llo[8], lhi[8]; unsigned qws[8];
#pragma unroll
        for (int i = 0; i < 8; ++i) { glo[i] = bflo(R.gw[i]); ghi[i] = bfhi(R.gw[i]); qws[i] = R.qw[i]; }
        if (it + 1 < nsteps) { const int cn = dir ? cidx - 1 : cidx + 1; HG_LOAD(R, cn); }
        { float c0 = 0.f, c1 = 0.f;
          if (!dir) {
#pragma unroll
              for (int i = 0; i < 8; ++i) { c0 += glo[i]; c1 += ghi[i]; llo[i] = c0; lhi[i] = c1; }
          } else {
#pragma unroll
              for (int i = 7; i >= 0; --i) { c0 += glo[i]; c1 += ghi[i]; llo[i] = c0; lhi[i] = c1; }
          }
          *(LAS f32x2*)(TOT + w * 128 + 2 * lane) = (f32x2){c0, c1}; }
        LDS_BARRIER();
        if (!(dmode & 2)) {
            float offs0 = 0.f, offs1 = 0.f, ref0 = 0.f, ref1 = 0.f, all0 = 0.f, all1 = 0.f;
#pragma unroll
            for (int s = 0; s < 8; ++s) { const f32x2 tt = *(const LAS f32x2*)(TOT + s * 128 + 2 * lane); all0 += tt.x; all1 += tt.y;
                const float bo = (dir ? (s > w) : (s < w)) ? 1.f : 0.f;
                offs0 = __builtin_fmaf(bo, tt.x, offs0); offs1 = __builtin_fmaf(bo, tt.y, offs1);
                if (dir ? (s >= 4) : (s < 4)) { ref0 += tt.x; ref1 += tt.y; } }
            const float Er0 = ex2_(ref0), Er1 = ex2_(ref1), Ek0 = ex2_(all0 - ref0), Ek1 = ex2_(all1 - ref1);
            if (w == 0) *(LAS f32x2*)(DV + 2 * lane) = (f32x2){ex2_(all0), ex2_(all1)};
            const float Eg0 = Er0 * ex2_(bacc0), Eg1 = Er1 * ex2_(bacc1);
            bacc0 += all0; bacc1 += all1;
            float f0[8], f1[8], pre0[8], pre1[8];
#pragma unroll
            for (int i = 0; i < 8; ++i) { f0[i] = ex2_(glo[i]); f1[i] = ex2_(ghi[i]); }
            const float sg_ = dir ? -1.f : 1.f;
            float run0 = ex2_(fminf(sg_ * (offs0 + llo[0] - ref0), 115.f)), run1 = ex2_(fminf(sg_ * (offs1 + lhi[0] - ref1), 115.f));
            pre0[7] = ex2_(fminf(-sg_ * (offs0 + llo[7] - ref0), 115.f)); pre1[7] = ex2_(fminf(-sg_ * (offs1 + lhi[7] - ref1), 115.f));
#pragma unroll
            for (int i = 7; i > 0; --i) { pre0[i - 1] = pre0[i] * (dir ? f0[i - 1] : f0[i]); pre1[i - 1] = pre1[i] * (dir ? f1[i - 1] : f1[i]); }
            const int wv_ = tid >> 6;
            const int aq_ = HT_Q + (8 * wv_) * TP + lane * 4, aqh_ = HT_QH + (8 * wv_) * TPQ + lane * 4, akh_ = HT_KH + (8 * wv_) * TP + SWZ3(8 * wv_, lane * 4);
            bf16* gq_ = Hg + (size_t)head * ((size_t)M * 128) + (size_t)(s0 + 64 * cidx + 8 * wv_) * 128 + 2 * lane;
#pragma unroll
            for (int i = 0; i < 8; ++i) {
                const unsigned qw_ = qws[i]; const float q0 = bflo(qw_), q1 = bfhi(qw_);
                if (i > 0) { run0 *= dir ? f0[i - 1] : f0[i]; run1 *= dir ? f1[i - 1] : f1[i]; }
                const float e10 = dir ? pre0[i] : run0, e11 = dir ? pre1[i] : run1, e20 = dir ? run0 : pre0[i], e21 = dir ? run1 : pre1[i];
                const float k0 = 1.f - f0[i], k1 = 1.f - f1[i];
                const float qt0 = q0 * e10, qt1 = q1 * e11, kt0 = k0 * e20, kt1 = k1 * e21;
                *(LAS unsigned*)(lds + aq_ + i * TP) = cvtpk(qt0, qt1); *(LAS unsigned*)(lds + aq_ + (HT_G - HT_Q) + i * TP) = cvtpk(kt0, kt1);
                *(LAS unsigned*)(lds + aqh_ + i * TPQ) = cvtpk(qt0 * Er0, qt1 * Er1); *(LAS unsigned*)(lds + akh_ + i * TP) = cvtpk(kt0 * Ek0, kt1 * Ek1);
                if (!(dmode & 1)) *(unsigned*)(gq_ + i * 128) = cvtpk(qt0 * Eg0, qt1 * Eg1); }
        }
        LDS_BARRIER();
        if (!(dmode & 4)) {
            const int I = w >> 1;
            s16x8 qf[4], kf[2][4];
#pragma unroll
            for (int ks = 0; ks < 4; ++ks) qf[ks] = *(const LAS s16x8*)(TQ + (16 * I + i16) * TP + (32 * ks + 8 * h) * 2);
#pragma unroll
            for (int jj = 0; jj < 2; ++jj)
#pragma unroll
                for (int ks = 0; ks < 4; ++ks) kf[jj][ks] = *(const LAS s16x8*)(TG + (16 * (2 * (w & 1) + jj) + i16) * TP + (32 * ks + 8 * h) * 2);
            __builtin_amdgcn_sched_barrier(0);
            f32x4 a2[2];
#pragma unroll
            for (int jj = 0; jj < 2; ++jj) { a2[jj] = (f32x4){0.f, 0.f, 0.f, 0.f};
#pragma unroll
                for (int ks = 0; ks < 4; ++ks) a2[jj] = __builtin_amdgcn_mfma_f32_16x16x32_bf16(kf[jj][ks], qf[ks], a2[jj], 0, 0, 0); }
#pragma unroll
            for (int jj = 0; jj < 2; ++jj) { const int J = 2 * (w & 1) + jj; const int t = 16 * I + i16, sb = 16 * J + 4 * h;
                float vv[4];
#pragma unroll
                for (int r = 0; r < 4; ++r) { const bool keep = dir ? (sb + r >= t) : (sb + r <= t); vv[r] = keep ? a2[jj][r] : 0.f; }
                *(LAS v2u*)(AM + t * AP + sb * 2) = (v2u){cvtpk(vv[0], vv[1]), cvtpk(vv[2], vv[3])}; }
        }
        LDS_BARRIER();
        if (!(dmode & 8)) {
            s16x8 sf[4], vf[2];
#pragma unroll
            for (int ks = 0; ks < 4; ++ks) sf[ks] = mk8u(cvtpk(S[2 * ks][0], S[2 * ks][1]), cvtpk(S[2 * ks][2], S[2 * ks][3]), cvtpk(S[2 * ks + 1][0], S[2 * ks + 1][1]), cvtpk(S[2 * ks + 1][2], S[2 * ks + 1][3]));
#pragma unroll
            for (int ks = 0; ks < 2; ++ks) vf[ks] = mk8(tr16(TV + (32 * ks + 8 * h + q4) * TP + SWZ3(8 * h, (16 * w + 4 * p4) * 2)), tr16(TV + (32 * ks + 8 * h + 4 + q4) * TP + SWZ3(8 * h, (16 * w + 4 * p4) * 2)));
            f32x4 oo[4];
#pragma unroll
            for (int ip = 0; ip < 2; ++ip) {
                s16x8 afr[2][2], qfr[2][4];
#pragma unroll
                for (int ii = 0; ii < 2; ++ii) { const int i = 2 * ip + ii;
#pragma unroll
                    for (int ks = 0; ks < 2; ++ks) afr[ii][ks] = *(const LAS s16x8*)(AM + (16 * i + i16) * AP + (32 * ks + 8 * h) * 2);
#pragma unroll
                    for (int ks = 0; ks < 4; ++ks) { const v2u lo = *(const LAS v2u*)(TQH + (16 * i + i16) * TPQ + (32 * ks + 4 * h) * 2), hi = *(const LAS v2u*)(TQH + (16 * i + i16) * TPQ + (32 * ks + 16 + 4 * h) * 2);
                        qfr[ii][ks] = mk8u(lo.x, lo.y, hi.x, hi.y); } }
                __builtin_amdgcn_sched_barrier(0);
#pragma unroll
                for (int ii = 0; ii < 2; ++ii) { f32x4 o = (f32x4){0.f, 0.f, 0.f, 0.f};
#pragma unroll
                    for (int ks = 0; ks < 2; ++ks) o = __builtin_amdgcn_mfma_f32_16x16x32_bf16(vf[ks], afr[ii][ks], o, 0, 0, 0);
#pragma unroll
                    for (int ks = 0; ks < 4; ++ks) o = __builtin_amdgcn_mfma_f32_16x16x32_bf16(sf[ks], qfr[ii][ks], o, 0, 0, 0);
                    oo[2 * ip + ii] = o; }
                __builtin_amdgcn_sched_barrier(0);
            }
            s16x8 kfr[8][2]; f32x4 d4[8];
#pragma unroll
            for (int T = 0; T < 8; ++T) { d4[T] = *(const LAS f32x4*)(DV + 16 * T + 4 * h);
#pragma unroll
                for (int ks = 0; ks < 2; ++ks) kfr[T][ks] = mk8(tr16(TKH + (32 * ks + 8 * h + q4) * TP + SWZ3(8 * h, (16 * T + 4 * p4) * 2)), tr16(TKH + (32 * ks + 8 * h + 4 + q4) * TP + SWZ3(8 * h, (16 * T + 4 * p4) * 2))); }
#pragma unroll
            for (int i = 0; i < 4; ++i) *(v2u*)(Oo + (size_t)(s0 + 64 * cidx + 16 * i + i16) * opitch + 16 * w + 4 * h) = (v2u){cvtpk(oo[i][0], oo[i][1]), cvtpk(oo[i][2], oo[i][3])};
            __builtin_amdgcn_sched_barrier(0);
#pragma unroll
            for (int T = 0; T < 8; ++T) { S[T] = S[T] * d4[T];
#pragma unroll
                for (int ks = 0; ks < 2; ++ks) S[T] = __builtin_amdgcn_mfma_f32_16x16x32_bf16(kfr[T][ks], vf[ks], S[T], 0, 0, 0); }
        }
        if (it + 1 == nsteps) LDS_BARRIER();
    }
}
template <int dir>
__device__ __forceinline__ void hgrn_chain(LAS unsigned char* lds, const bf16* Hq, bf16* Hg, const bf16* Hv, bf16* Oo, int opitch, int s0, int cfirst, int nsteps, int head, float* SLc, float* Btc, int dmode = 0) {
    const int tid = threadIdx.x, lane = tid & 63, w = __builtin_amdgcn_readfirstlane(tid >> 6);
    const int lr = tid >> 4, lc = tid & 15;
    const size_t hbase_ = (size_t)head * ((size_t)M * 128);
    HGRegs A;
    HG_LOAD(A, cfirst);
    f32x4 S[8];
#pragma unroll
    for (int T = 0; T < 8; ++T) S[T] = (f32x4){0.f, 0.f, 0.f, 0.f};
    float bacc0 = 0.f, bacc1 = 0.f;
    for (int it = 0; it < nsteps; ++it)
        hgrn_step<dir>(lds, Hq, Hg, Hv, Oo, opitch, s0, cfirst, nsteps, head, it, dmode, A, S, bacc0, bacc1);
#undef HG_LOAD
#pragma unroll
    for (int T = 0; T < 8; ++T) *(f32x4*)(SLc + ((w * 8 + T) * 64 + lane) * 4) = S[T];
    if (w == 0) *(f32x2*)(Btc + 2 * lane) = (f32x2){bacc0, bacc1};
}
__device__ __forceinline__ void hgrn_scan(const float* SL, const float* Bt, v4u* SF, int gid, int nthreads, int own_x = -1) {
    for (int item = gid; item < 48 * 2048; item += nthreads) {
        const int g = item >> 11, e = item & 2047, seq = g >> 3, head = (g >> 1) & 3, dir = g & 1;
        const int ns = seq < 4 ? 4 : 8, sgbase = seq < 4 ? seq * 4 : 16 + (seq - 4) * 8;
        const int wq = e >> 8, ks = (e >> 6) & 3, ln = e & 63, dk0 = 32 * ks + 4 * (ln >> 4);
        f32x4 ta[8], tb[8], ba[8], bb[8];
#pragma unroll
        for (int jj = 0; jj < 8; ++jj) if (jj < ns) { const int j = dir ? ns - 1 - jj : jj; const int ch = ((sgbase + j) << 3) | (head << 1) | dir;
            const f32x4* p = (const f32x4*)(SL + (size_t)ch * 16384) + (wq * 8 + 2 * ks) * 64 + ln;
            ta[jj] = p[0]; tb[jj] = p[64]; ba[jj] = *(const f32x4*)(Bt + ch * 128 + dk0); bb[jj] = *(const f32x4*)(Bt + ch * 128 + dk0 + 16); }
        f32x4 ca = (f32x4){0.f, 0.f, 0.f, 0.f}, cb = ca;
#pragma unroll
        for (int jj = 0; jj < 8; ++jj) if (jj < ns) { const int j = dir ? ns - 1 - jj : jj; const int ch = ((sgbase + j) << 3) | (head << 1) | dir;
            v4u fr; fr.x = cvtpk(ca.x, ca.y); fr.y = cvtpk(ca.z, ca.w); fr.z = cvtpk(cb.x, cb.y); fr.w = cvtpk(cb.z, cb.w);
            if (own_x < 0 || ((sgbase + j) >> 2) == own_x) SF[(size_t)ch * 2048 + e] = fr;
            ca.x = ex2_(ba[jj].x) * ca.x + ta[jj].x; ca.y = ex2_(ba[jj].y) * ca.y + ta[jj].y; ca.z = ex2_(ba[jj].z) * ca.z + ta[jj].z; ca.w = ex2_(ba[jj].w) * ca.w + ta[jj].w;
            cb.x = ex2_(bb[jj].x) * cb.x + tb[jj].x; cb.y = ex2_(bb[jj].y) * cb.y + tb[jj].y; cb.z = ex2_(bb[jj].z) * cb.z + tb[jj].z; cb.w = ex2_(bb[jj].w) * cb.w + tb[jj].w; }
    }
}
constexpr int P2_QF = 0, P2_QB = 18432, P2_BUF = 36864, P2_OC = 73728, P2_OCP = 528;
__device__ __forceinline__ void hgrn_pass2(LAS unsigned char* lds, const bf16* Hqf, const bf16* Hqb, const bf16* Hgate, const float* gnw, const v4u* SF, const bf16* O, bf16* Ow, int opw, const bf16* OBk,
                                           int s0, int seg, int sg, int head, int half, int mode = 0) {
    const int tid = threadIdx.x, lane = tid & 63, w = __builtin_amdgcn_readfirstlane(tid >> 6), h = lane >> 4, i16 = lane & 15;
    const int ti = w >> 1, dh = w & 1;
    const int chf = (sg << 3) | (head << 1), chb = chf | 1;
    s16x8 sfF[4][4], sfB[4][4];
#pragma unroll
    for (int n = 0; n < 4; ++n)
#pragma unroll
        for (int ks = 0; ks < 4; ++ks) { const size_t fo = (size_t)((4 * dh + n) * 4 + ks) * 64 + lane;
            sfF[n][ks] = __builtin_bit_cast(s16x8, SF[(size_t)chf * 2048 + fo]); sfB[n][ks] = __builtin_bit_cast(s16x8, SF[(size_t)chb * 2048 + fo]); }
    const int lr = tid >> 4, lc = tid & 15; const size_t gcol = (size_t)head * 128 + lc * 8, hcol = (size_t)head * ((size_t)M * 128) + lc * 8;
    const f32x4 gn0 = *(const f32x4*)(gnw + 8 * lc), gn1 = *(const f32x4*)(gnw + 8 * lc + 4);
    LAS unsigned char* OC = lds + P2_OC;
    v4u pa0, pa1, pb0, pb1, rf0, rf1, rb0, rb1, rg0, rg1;
#define P2_LOAD(cidx_) do { const size_t o0_ = (size_t)(s0 + 64 * (cidx_) + lr) * 128 + hcol, o1_ = o0_ + (size_t)32 * 128; \
        pa0 = __builtin_nontemporal_load((const v4u*)(Hqf + o0_)); pa1 = __builtin_nontemporal_load((const v4u*)(Hqf + o1_)); pb0 = __builtin_nontemporal_load((const v4u*)(Hqb + o0_)); pb1 = __builtin_nontemporal_load((const v4u*)(Hqb + o1_)); } while (0)
#define P2_LOADR(cidx_) do { const size_t r0_ = (size_t)(s0 + 64 * (cidx_) + lr), r1_ = r0_ + 32; \
        rf0 = __builtin_nontemporal_load((const v4u*)(O + r0_ * D + gcol)); rf1 = __builtin_nontemporal_load((const v4u*)(O + r1_ * D + gcol)); rb0 = __builtin_nontemporal_load((const v4u*)(OBk + r0_ * 128 + hcol)); rb1 = __builtin_nontemporal_load((const v4u*)(OBk + r1_ * 128 + hcol)); \
        rg0 = __builtin_nontemporal_load((const v4u*)(Hgate + r0_ * 128 + hcol)); rg1 = __builtin_nontemporal_load((const v4u*)(Hgate + r1_ * 128 + hcol)); } while (0)
    P2_LOAD(16 * seg + 8 * half); P2_LOADR(16 * seg + 8 * half);
    for (int u = 0; u < 8; ++u) {
        const int cidx = 16 * seg + 8 * half + u;
        LAS unsigned char* TQF = lds + (u & 1) * P2_BUF + P2_QF; LAS unsigned char* TQB = lds + (u & 1) * P2_BUF + P2_QB;
        *(LAS v4u*)(TQF + lr * TPQ + lc * 16) = pa0; *(LAS v4u*)(TQF + (lr + 32) * TPQ + lc * 16) = pa1;
        *(LAS v4u*)(TQB + lr * TPQ + lc * 16) = pb0; *(LAS v4u*)(TQB + (lr + 32) * TPQ + lc * 16) = pb1;
        if (u + 1 < 8 && mode != 1) P2_LOAD(cidx + 1);
        LDS_BARRIER();
        if (mode != 2) {
            s16x8 ff[4], fb[4];
#pragma unroll
            for (int ks = 0; ks < 4; ++ks) { const int ro = (16 * ti + i16) * TPQ + (32 * ks + 4 * h) * 2;
                const v2u lo = *(const LAS v2u*)(TQF + ro), hi = *(const LAS v2u*)(TQF + ro + 32), lo2 = *(const LAS v2u*)(TQB + ro), hi2 = *(const LAS v2u*)(TQB + ro + 32);
                ff[ks] = mk8u(lo.x, lo.y, hi.x, hi.y); fb[ks] = mk8u(lo2.x, lo2.y, hi2.x, hi2.y); }
            __builtin_amdgcn_sched_barrier(0);
#pragma unroll
            for (int n = 0; n < 4; ++n) { f32x4 o = (f32x4){0.f, 0.f, 0.f, 0.f};
#pragma unroll
                for (int ks = 0; ks < 4; ++ks) { o = __builtin_amdgcn_mfma_f32_16x16x32_bf16(sfF[n][ks], ff[ks], o, 0, 0, 0); o = __builtin_amdgcn_mfma_f32_16x16x32_bf16(sfB[n][ks], fb[ks], o, 0, 0, 0); }
                *(LAS f32x4*)(OC + (16 * ti + i16) * P2_OCP + (16 * (4 * dh + n) + 4 * h) * 4) = o; }
            __builtin_amdgcn_sched_barrier(0);
        }
        LDS_BARRIER();
        {
            const v4u f0 = rf0, f1 = rf1, b0 = rb0, b1 = rb1, g0 = rg0, g1 = rg1;
            if (u + 1 < 8 && mode != 1) P2_LOADR(cidx + 1);
#pragma unroll
            for (int rr = 0; rr < 2; ++rr) { const int row = lr + 32 * rr; const v4u fw = rr ? f1 : f0, bw = rr ? b1 : b0, gw_ = rr ? g1 : g0;
                const f32x4 c0_ = *(const LAS f32x4*)(OC + row * P2_OCP + lc * 32), c1_ = *(const LAS f32x4*)(OC + row * P2_OCP + lc * 32 + 16);
                float o[8];
                o[0] = c0_.x + bflo(fw.x) + bflo(bw.x); o[1] = c0_.y + bfhi(fw.x) + bfhi(bw.x); o[2] = c0_.z + bflo(fw.y) + bflo(bw.y); o[3] = c0_.w + bfhi(fw.y) + bfhi(bw.y);
                o[4] = c1_.x + bflo(fw.z) + bflo(bw.z); o[5] = c1_.y + bfhi(fw.z) + bfhi(bw.z); o[6] = c1_.z + bflo(fw.w) + bflo(bw.w); o[7] = c1_.w + bfhi(fw.w) + bfhi(bw.w);
                float sq = (o[0] * o[0] + o[1] * o[1]) + (o[2] * o[2] + o[3] * o[3]) + (o[4] * o[4] + o[5] * o[5]) + (o[6] * o[6] + o[7] * o[7]);
                sq = sum16_(sq);
                const float r = rsq_(sq * (1.f / 128.f) + EPS);
                v4u ov; ov.x = cvtpk(o[0] * r * gn0.x * bflo(gw_.x), o[1] * r * gn0.y * bfhi(gw_.x)); ov.y = cvtpk(o[2] * r * gn0.z * bflo(gw_.y), o[3] * r * gn0.w * bfhi(gw_.y));
                ov.z = cvtpk(o[4] * r * gn1.x * bflo(gw_.z), o[5] * r * gn1.y * bfhi(gw_.z)); ov.w = cvtpk(o[6] * r * gn1.z * bflo(gw_.w), o[7] * r * gn1.w * bfhi(gw_.w));
                *(v4u*)(Ow + (size_t)(s0 + 64 * cidx + row) * opw + gcol) = ov; }
        }
    }
    LDS_BARRIER();
#undef P2_LOAD
#undef P2_LOADR
}
constexpr int NKP = 128, NROWB = 64 * NKP, NA_K = 0, NA_V = 9 * NROWB, NA_RPB = 18 * NROWB;
#define NA_KOFF(key_, chunk_) ((key_) * NKP + 16 * ((chunk_) ^ (((key_) >> 1) & 7)))
#define NA_VOFF(key_, unit_) ((key_) * NKP + 8 * ((unit_) ^ (4 * (((key_) >> 1) & 3))))
static_assert(NA_RPB + 480 * 4 <= LDSCTL_OFF, "NA LDS map");
__device__ __forceinline__ void na_store_krow(LAS unsigned char* KR, int row, int key, int c, v4u kr, const float* kw) {
    float x[8]; x[0] = bflo(kr.x); x[1] = bfhi(kr.x); x[2] = bflo(kr.y); x[3] = bfhi(kr.y); x[4] = bflo(kr.z); x[5] = bfhi(kr.z); x[6] = bflo(kr.w); x[7] = bfhi(kr.w);
    float ss = 0.f;
#pragma unroll
    for (int e = 0; e < 8; ++e) ss += x[e] * x[e];
    ss = sum8_(ss);
    const float sc = rsq_(ss * (1.f / 64.f) + EPS);
    const f32x4 w0 = *(const f32x4*)(kw + c * 8), w1 = *(const f32x4*)(kw + c * 8 + 4);
    v4u o; o.x = cvtpk(x[0] * sc * w0.x, x[1] * sc * w0.y); o.y = cvtpk(x[2] * sc * w0.z, x[3] * sc * w0.w); o.z = cvtpk(x[4] * sc * w1.x, x[5] * sc * w1.y); o.w = cvtpk(x[6] * sc * w1.z, x[7] * sc * w1.w);
    *(LAS v4u*)(KR + (row % 9) * NROWB + NA_KOFF(key, c)) = o;
}
__device__ __forceinline__ void na_store_vrow(LAS unsigned char* VR, int row, int key, int c, v4u vr) {
    *(LAS v4u*)(VR + (row % 9) * NROWB + NA_VOFF(key, 2 * c)) = vr;
}
__device__ __forceinline__ void na_qfrag(s16x8 (&qf)[2], v4u a, v4u b, const float* qw, int h) {
    float x[16]; x[0] = bflo(a.x); x[1] = bfhi(a.x); x[2] = bflo(a.y); x[3] = bfhi(a.y); x[4] = bflo(a.z); x[5] = bfhi(a.z); x[6] = bflo(a.w); x[7] = bfhi(a.w);
    x[8] = bflo(b.x); x[9] = bfhi(b.x); x[10] = bflo(b.y); x[11] = bfhi(b.y); x[12] = bflo(b.z); x[13] = bfhi(b.z); x[14] = bflo(b.w); x[15] = bfhi(b.w);
    float ss = 0.f;
#pragma unroll
    for (int e = 0; e < 16; ++e) ss += x[e] * x[e];
    ss += __shfl_xor(ss, 16); ss += __shfl_xor(ss, 32);
    const float sc = (0.125f * 1.44269504089f) * rsq_(ss * (1.f / 64.f) + EPS);
    const f32x4 wa0 = *(const f32x4*)(qw + 8 * h), wa1 = *(const f32x4*)(qw + 8 * h + 4), wb0 = *(const f32x4*)(qw + 32 + 8 * h), wb1 = *(const f32x4*)(qw + 32 + 8 * h + 4);
    qf[0] = mk8u(cvtpk(x[0] * sc * wa0.x, x[1] * sc * wa0.y), cvtpk(x[2] * sc * wa0.z, x[3] * sc * wa0.w), cvtpk(x[4] * sc * wa1.x, x[5] * sc * wa1.y), cvtpk(x[6] * sc * wa1.z, x[7] * sc * wa1.w));
    qf[1] = mk8u(cvtpk(x[8] * sc * wb0.x, x[9] * sc * wb0.y), cvtpk(x[10] * sc * wb0.z, x[11] * sc * wb0.w), cvtpk(x[12] * sc * wb1.x, x[13] * sc * wb1.y), cvtpk(x[14] * sc * wb1.z, x[15] * sc * wb1.w));
}
__device__ __forceinline__ void na_run(LAS unsigned char* lds, const bf16* NQ, const bf16* NK, const bf16* NV, const float* qw, const float* kw, const float* rpb, bf16* O, int s0, int rows, int head, int r0, int nr) {
    const int tid = threadIdx.x, lane = tid & 63, w = __builtin_amdgcn_readfirstlane(tid >> 6), h = lane >> 4, i16 = lane & 15, q4 = i16 >> 2, p4 = i16 & 3;
    LAS unsigned char* KR = lds + NA_K; LAS unsigned char* VR = lds + NA_V; LAS float* RB = (LAS float*)(lds + NA_RPB);
    for (int i = tid; i < 480; i += NWAVES * 64) { const int rw = i >> 5, cl = i & 31; RB[i] = cl < 31 ? rpb[head * 465 + rw * 31 + cl] * 1.44269504089f : -1e30f; }
    const int lkey = tid >> 3, lc = tid & 7; const size_t hbase = (size_t)head * ((size_t)M * 64);
    const int rr = w >> 2, j = w & 3, qcol = 16 * j + i16, bs = min(max(16 * j - 8, 0), 32), wsn = min(max(qcol - 8, 0), 48);
    {
        const int rs0 = min(max(r0 - 4, 0), rows - 8), hi0 = min(max(r0 - 3, 0), rows - 8) + 7; v4u kk[9], vv[9];
#pragma unroll
        for (int k = 0; k < 9; ++k) { const int row = min(rs0 + k, hi0); const size_t go = hbase + (size_t)(s0 + row * 64 + lkey) * 64 + lc * 8; kk[k] = *(const v4u*)(NK + go); vv[k] = *(const v4u*)(NV + go); }
#pragma unroll
        for (int k = 0; k < 9; ++k) { const int row = min(rs0 + k, hi0); na_store_krow(KR, row, lkey, lc, kk[k], kw); na_store_vrow(VR, row, lkey, lc, vv[k]); }
    }
    v4u qa, qb;
    { const size_t qrow = (size_t)(s0 + (r0 + rr) * 64 + qcol); qa = *(const v4u*)(NQ + hbase + qrow * 64 + 8 * h); qb = *(const v4u*)(NQ + hbase + qrow * 64 + 32 + 8 * h); }
    for (int st = 0; st < nr; st += 2) {
        const int r = r0 + st + rr, rs = min(max(r - 4, 0), rows - 8);
        const bool more = st + 2 < nr;
        const int hic = min(max(r0 + st - 3, 0), rows - 8) + 7, hin = min(max(r0 + st - 1, 0), rows - 8) + 7;
        const int nrA = min(hic + 1, hin), nrB = min(hic + 2, hin);
        const bool ldA = more && (hic + 1 <= hin), ldB = more && (hic + 2 <= hin);
        s16x8 qf[2]; na_qfrag(qf, qa, qb, qw, h);
        LDS_BARRIER();
        v4u nkA, nvA, nkB, nvB;
        if (ldA) { const size_t go = hbase + (size_t)(s0 + nrA * 64 + lkey) * 64 + lc * 8; nkA = *(const v4u*)(NK + go); nvA = *(const v4u*)(NV + go); }
        if (ldB) { const size_t go = hbase + (size_t)(s0 + nrB * 64 + lkey) * 64 + lc * 8; nkB = *(const v4u*)(NK + go); nvB = *(const v4u*)(NV + go); }
        const size_t qrow = (size_t)(s0 + r * 64 + qcol);
        if (more) { const size_t qn = qrow + 128; qa = *(const v4u*)(NQ + hbase + qn * 64 + 8 * h); qb = *(const v4u*)(NQ + hbase + qn * 64 + 32 + 8 * h); }
        {
            int dci[2][4];
#pragma unroll
            for (int ch = 0; ch < 2; ++ch)
#pragma unroll
                for (int rg = 0; rg < 4; ++rg) { const int kcol = bs + 16 * ch + 4 * h + rg; dci[ch][rg] = ((kcol >= wsn) && (kcol < wsn + 16)) ? kcol - qcol + 15 : 31; }
            const LAS float* rbp[2][4];
#pragma unroll
            for (int ch = 0; ch < 2; ++ch)
#pragma unroll
                for (int rg = 0; rg < 4; ++rg) rbp[ch][rg] = RB + (rs - r + 7) * 32 + dci[ch][rg];
            const s16x8 ones = {0x3F80, 0x3F80, 0x3F80, 0x3F80, 0x3F80, 0x3F80, 0x3F80, 0x3F80};
            f32x4 ls = (f32x4){0.f, 0.f, 0.f, 0.f}; s16x8 pf[8];
            float bv[2][2][2][4]; s16x8 kf[2][2][2][2];
#define NA_LOADK(B_, KP_) do { _Pragma("unroll") for (int k2 = 0; k2 < 2; ++k2) { const int kr_ = 2 * (KP_) + k2; const int slot_ = (rs + kr_) % 9; \
                _Pragma("unroll") for (int ch = 0; ch < 2; ++ch) { \
                    _Pragma("unroll") for (int rg = 0; rg < 4; ++rg) bv[B_][k2][ch][rg] = rbp[ch][rg][kr_ * 32]; \
                    _Pragma("unroll") for (int ks = 0; ks < 2; ++ks) { kf[B_][k2][ch][ks] = *(const LAS s16x8*)(KR + slot_ * NROWB + NA_KOFF(bs + 16 * ch + i16, 4 * ks + h)); } } } } while (0)
            NA_LOADK(0, 0);
#pragma unroll
            for (int kp = 0; kp < 4; ++kp) {
                if (kp < 3) NA_LOADK((kp + 1) & 1, kp + 1);
                __builtin_amdgcn_sched_barrier(0);
#pragma unroll
                for (int k2 = 0; k2 < 2; ++k2) { const int kr = 2 * kp + k2; float pp[2][4];
#pragma unroll
                    for (int ch = 0; ch < 2; ++ch) { f32x4 a = (f32x4){bv[kp & 1][k2][ch][0], bv[kp & 1][k2][ch][1], bv[kp & 1][k2][ch][2], bv[kp & 1][k2][ch][3]};
#pragma unroll
                        for (int ks = 0; ks < 2; ++ks) a = __builtin_amdgcn_mfma_f32_16x16x32_bf16(kf[kp & 1][k2][ch][ks], qf[ks], a, 0, 0, 0);
#pragma unroll
                        for (int rg = 0; rg < 4; ++rg) pp[ch][rg] = ex2_(a[rg]); }
                    pf[kr] = mk8u(cvtpk(pp[0][0], pp[0][1]), cvtpk(pp[0][2], pp[0][3]), cvtpk(pp[1][0], pp[1][1]), cvtpk(pp[1][2], pp[1][3]));
                    ls = __builtin_amdgcn_mfma_f32_16x16x32_bf16(ones, pf[kr], ls, 0, 0, 0); }
                __builtin_amdgcn_sched_barrier(0);
            }
#undef NA_LOADK
            const float il = rcp_(ls[0]);
            s16x8 vfr[2][8];
#define NA_LOADV(B_, N_) do { _Pragma("unroll") for (int kr = 0; kr < 8; ++kr) { const int slot_ = (rs + kr) % 9; \
                vfr[B_][kr] = mk8(tr16(VR + slot_ * NROWB + NA_VOFF(bs + 4 * h + q4, 4 * (N_) + p4)), tr16(VR + slot_ * NROWB + NA_VOFF(bs + 16 + 4 * h + q4, 4 * (N_) + p4))); } } while (0)
            NA_LOADV(0, 0);
#pragma unroll
            for (int n = 0; n < 4; ++n) {
                if (n < 3) NA_LOADV((n + 1) & 1, n + 1);
                __builtin_amdgcn_sched_barrier(0);
                f32x4 o = (f32x4){0.f, 0.f, 0.f, 0.f};
#pragma unroll
                for (int kr = 0; kr < 8; ++kr) o = __builtin_amdgcn_mfma_f32_16x16x32_bf16(vfr[n & 1][kr], pf[kr], o, 0, 0, 0);
                *(v2u*)(O + qrow * D + GW + head * 64 + 16 * n + 4 * h) = (v2u){cvtpk(o[0] * il, o[1] * il), cvtpk(o[2] * il, o[3] * il)};
                __builtin_amdgcn_sched_barrier(0);
            }
#undef NA_LOADV
        }
        LDS_BARRIER();
        if (ldA) { na_store_krow(KR, nrA, lkey, lc, nkA, kw); na_store_vrow(VR, nrA, lkey, lc, nvA); }
        if (ldB) { na_store_krow(KR, nrB, lkey, lc, nkB, kw); na_store_vrow(VR, nrB, lkey, lc, nvB); }
    }
    LDS_BARRIER();
}
constexpr int N_PHASES = 8;
#define REP(k) for (int rep_ = 0; rep_ < ((PROBE) == (k) ? 2 : 1); ++rep_)
__global__ void __launch_bounds__(NWAVES * 64, 2) fwd_kernel(Args args) {
    extern __shared__ __attribute__((aligned(16))) unsigned char lds_raw[];
    LAS unsigned char* lds = (LAS unsigned char*)lds_raw;
    volatile LAS unsigned* MISC = (volatile LAS unsigned*)(lds + MISC_OFF);
    const int tid = threadIdx.x, lane = tid & 63, wave = __builtin_amdgcn_readfirstlane(tid >> 6);
    const int G = gridDim.x; const int bx = blockIdx.x; const int vcu = (G % 8 == 0) ? (bx % 8) * (G / 8) + bx / 8 : bx;
    unsigned char* ws = args.ws;
    unsigned* ctl = (unsigned*)(ws + WS_CTL);
    const float* xp = args.in[0]; const float* xs = args.in[1]; const float* w_mix = args.in[2]; const float* w_in = args.in[3]; const float* lbp = args.in[4];
    const float* gnw = args.in[5]; const float* qnw = args.in[6]; const float* knw = args.in[7]; const float* rpb = args.in[8]; const float* w_out = args.in[9];
    const float* w_ffn = args.in[10]; const float* w_gate = args.in[11]; const float* w_up = args.in[12]; const float* w_down = args.in[13];
    float* out = args.out;
    bf16* Wgu_t = (bf16*)(ws + WS_WGU); bf16* Win_t = (bf16*)(ws + WS_WIN); bf16* Wout_t = (bf16*)(ws + WS_WOUT); bf16* Wdown_t = (bf16*)(ws + WS_WDOWN);
    bf16* XN = (bf16*)(ws + WS_A); bf16* OBk = (bf16*)out + 3 * (size_t)M * GW; bf16* Hb = (bf16*)(ws + WS_H); bf16* Ob = (bf16*)(ws + WS_O);
    bf16* X1b = (bf16*)(ws + WS_X1); bf16* HFF = (bf16*)(ws + WS_HFF); bf16* NAb = (bf16*)out; float* ssq = (float*)(ctl + CW_SSQ); float* SLb = (float*)(ws + WS_SL); float* Btb = (float*)(ctl + CW_BT);
    v4u* SFb = (v4u*)(ws + WS_SF);
    for (int u = tid; u < (LDS_BYTES - LDSCTL_OFF) / 4; u += NWAVES * 64) ((LAS unsigned*)(lds + LDSCTL_OFF))[u] = 0u;
    __syncthreads();
    const int lo = args.ph_lo, hi = args.ph_hi;
    XcdBarrier bar; bar.bar = ctl + CW_BAR; bar.x = 0; bar.st = nullptr;
    if (hi - lo > 1) bar = xcd_barrier_post(ctl + CW_BAR, MISC + 8);
#define IN(k) (lo <= (k) && (k) < hi)
#define SEAM(k) do { if (IN(k) && IN((k) + 1)) xcd_barrier(bar); } while (0)
#define SEAM_ARRIVE(k) do { if (IN(k) && IN((k) + 1)) bgen = xcd_barrier_arrive(bar); } while (0)
#define SEAM_WAIT(k) do { if (IN(k) && IN((k) + 1)) xcd_barrier_wait(bar, bgen); else __syncthreads(); } while (0)
    const int gw = vcu * NWAVES + wave, NGW = G * NWAVES;
    const bool full = (lo == 0 && hi == N_PHASES);
    unsigned bgen = 0u;
    if (full) { if (tid == 0 && bx < 8) __hip_atomic_store(&ctl[CW_XMAP + bx], xb_xcc_id() + 1u, __ATOMIC_RELAXED, __HIP_MEMORY_SCOPE_AGENT);
                bgen = xcd_barrier_arrive(bar); }

    if (IN(0)) REP(0) {
        LAS float* scr = (LAS float*)(lds + RING_OFF + wave * 16384);
        constexpr int I_IN = (D / 64) * (INC / 32), I_OUT = (D / 64) * (D / 32);
#define P0_LOAD(wv_, it_) do { if ((it_) < I_IN) tr_load(wv_, w_in, INC, (it_), lane); else tr_load(wv_, w_out, D, (it_) - I_IN, lane); } while (0)
#define P0_FIN(wv_, it_) do { if ((it_) < I_IN) tr_finish<0>(wv_, D, INC, Win_t, scr, (it_), lane, w_mix); else tr_finish<0>(wv_, D, D, Wout_t, scr, (it_) - I_IN, lane); } while (0)
        for (int it = gw; it < I_IN + I_OUT; it += 2 * NGW) { float wa[32], wb[32]; const bool two = it + NGW < I_IN + I_OUT;
            P0_LOAD(wa, it); if (two) P0_LOAD(wb, it + NGW);
            P0_FIN(wa, it); if (two) P0_FIN(wb, it + NGW); }
#undef P0_LOAD
#undef P0_FIN
        if (full) { xcd_barrier_poll(bar, bgen);
                    if (tid == 0 && (G % 8 != 0 || xb_ld(&ctl[CW_XMAP + (bx & 7)]) != xb_xcc_id() + 1u)) atomicOr(&ctl[CW_NONCANON], 1u);
                    bgen = xcd_barrier_arrive(bar); }
        for (int i = bx * (NWAVES * 64) + tid; i < M; i += G * NWAVES * 64) ssq[i] = 0.f;
        { float* rstd0 = (float*)(ctl + CW_RSTD0);
          if (G == 256) {
              const int tp0 = 16 * (bx & 7) + ((bx >> 3) & 7), rw0 = 64 * (bx >> 6) + 8 * wave;
#pragma unroll 1
              for (int it = 0; it < 4; ++it) { const float* xr[4]; bf16* orw[4]; float* rsp[4];
#pragma unroll
                  for (int r = 0; r < 4; ++r) { const int mm = 256 * (tp0 + 8 * (it >> 1)) + rw0 + 4 * (it & 1) + r; xr[r] = mm < MP ? xp + (size_t)mm * D : xs + (size_t)(mm - MP) * D; orw[r] = XN + (size_t)mm * D; rsp[r] = rstd0 + mm; }
                  rows_to_bf16_rstd<4>(xr, orw, rsp, lane); }
          } else
          for (int m = gw; m < M; m += 4 * NGW) {
              const float* xr[4]; bf16* orw[4]; float* rsp[4];
#pragma unroll
              for (int r = 0; r < 4; ++r) { const int mm = min(m + r * NGW, M - 1); xr[r] = mm < MP ? xp + (size_t)mm * D : xs + (size_t)(mm - MP) * D; orw[r] = XN + (size_t)mm * D; rsp[r] = rstd0 + mm; }
              rows_to_bf16_rstd<4>(xr, orw, rsp, lane); } }
    }
    unsigned* tcnt = ctl + CW_TB + 16 * (((bx & 7) << 3) | ((bx >> 3) & 7));
    if (full) { xcd_barrier_poll(bar, bgen); if (tid == 0) MISC[12] = xb_ld(&ctl[CW_NONCANON]); } else { SEAM(0); if (tid == 0) MISC[12] = 1u; }
    __syncthreads();
    const bool local_ok = (MISC[12] == 0u);
    const bool team_ok = local_ok && G == 256;
    unsigned lgen = 0u;
    if (full) { if (team_ok) team_barrier(tcnt, 0u, ctl + CW_BAR + XB_TMO); else xcd_barrier(bar); }
    if ((PROBE) == 100) { SEAM(0); SEAM(0); SEAM(0); SEAM(0); }
    if (IN(1)) REP(1) {
        pg8::Gemm g{XN, Win_t, M, INC, D}; pg8::StaticOrder S; S.init(M, INC, G, bx);
        EpiInProj E{Hb, NAb, lbp, (const float*)(ctl + CW_RSTD0)};
        pg8::gemm_phase<EpiInProj, pg8::StaticOrder, true, true>(lds + RING_OFF, g, S, E);
    }
    if (local_ok) { lgen = lb_arrive(bar, ctl); bgen = xcd_barrier_arrive(bar); lb_wait(bar, ctl, lgen); } else SEAM(1);
    if (wave >= 4) __builtin_amdgcn_s_setprio(1);
    if (IN(2)) {
        for (int rep_ = 0; rep_ < (((PROBE) == 20 || (PROBE) / 10 == 20) ? 2 : 1); ++rep_) for (int ch = vcu; ch < 256; ch += G) { const int dir = ch & 1, head = (ch >> 1) & 3, sg = ch >> 3;
            const int seq = sg < 16 ? sg >> 2 : 4 + ((sg - 16) >> 3), seg = sg < 16 ? sg & 3 : (sg - 16) & 7;
            const int s0 = seq < 4 ? seq * 4096 : MP + (seq - 4) * 8192;
            const int dm_ = (((PROBE) / 10 == 20 || (PROBE) == 20) && rep_ == 0) ? (1 | (((PROBE) / 10 == 20) ? ((PROBE) % 10) * 2 : 0)) : 0;
            if (dir) hgrn_chain<1>(lds, Hb, Hb + 2 * (size_t)M * GW, Hb + 3 * (size_t)M * GW, OBk + (size_t)head * ((size_t)M * 128), 128, s0, 16 * seg + 15, 16, head, SLb + (size_t)ch * 16384, Btb + ch * 128, dm_);
            else     hgrn_chain<0>(lds, Hb, Hb + (size_t)M * GW, Hb + 3 * (size_t)M * GW, Ob + head * 128, D, s0, 16 * seg, 16, head, SLb + (size_t)ch * 16384, Btb + ch * 128, dm_); }
        if (local_ok) xcd_barrier_wait(bar, bgen);
        if (team_ok) bgen = xcd_barrier_arrive(bar);
        REP(21) for (int ru = vcu; ru < 256; ru += G) { int seq, head, run;
            if (ru < 128) { seq = ru >> 5; head = (ru >> 2) & 7; run = ru & 3; } else { const int r2 = ru - 128, x2 = r2 >> 5, q2 = r2 & 31; seq = 4 + (x2 >> 1); head = q2 >> 2; run = 4 * (x2 & 1) + (q2 & 3); }
            const int s0 = seq < 4 ? seq * 4096 : MP + (seq - 4) * 8192, rows = seq < 4 ? 64 : 128;
            na_run(lds, NAb, NAb + (size_t)M * GW, NAb + 2 * (size_t)M * GW, qnw, knw, rpb, Ob, s0, rows, head, run * 16, 16); }
    }
    if (team_ok) {
        xcd_barrier_wait(bar, bgen);
        { const int xk = bx & 7, e_all = (bx >> 3) * (NWAVES * 64) + tid, seq = xk < 4 ? xk : 4 + ((xk - 4) >> 1);
          hgrn_scan(SLb, Btb, SFb, ((seq << 3) | (e_all >> 11)) * 2048 + (e_all & 2047), 1 << 30, xk); }
        lgen = lb_arrive(bar, ctl); lb_wait(bar, ctl, lgen);
    } else {
        SEAM(2);
        if (IN(3)) hgrn_scan(SLb, Btb, SFb, bx * (NWAVES * 64) + tid, G * NWAVES * 64);
        SEAM(3);
    }
    if (IN(4)) for (int rep_ = 0; rep_ < (((PROBE) == 4 || (PROBE) == 41 || (PROBE) == 42) ? 2 : 1); ++rep_) {
        const bool dry_ = ((PROBE) == 4 || (PROBE) == 41 || (PROBE) == 42) && rep_ == 0; const int mode_ = dry_ ? ((PROBE) == 41 ? 1 : ((PROBE) == 42 ? 2 : 0)) : 0;
        for (int un = vcu; un < 256; un += G) { const int half = un & 1, head = (un >> 1) & 3, sg = un >> 3;
            const int seq = sg < 16 ? sg >> 2 : 4 + ((sg - 16) >> 3), seg = sg < 16 ? sg & 3 : (sg - 16) & 7;
            const int s0 = seq < 4 ? seq * 4096 : MP + (seq - 4) * 8192;
            hgrn_pass2(lds, Hb + (size_t)M * GW, Hb + 2 * (size_t)M * GW, Hb + 4 * (size_t)M * GW, gnw, SFb, Ob, dry_ ? Hb + 3 * (size_t)M * GW : Ob, dry_ ? GW : D, OBk, s0, seg, sg, head, half, mode_); }
    }
    __builtin_amdgcn_s_setprio(0);
    __syncthreads(); if (tid == 0) (void)xb_add(&ctl[CW_P4DONE], 1u);
    if (team_ok) lgen = lb_arrive(bar, ctl); else SEAM_ARRIVE(4);
    constexpr int I_G = (D / 64) * (FF / 32), I_D = (FF / 64) * (D / 32);
    if (IN(5)) {
        LAS float* scr = (LAS float*)(lds + RING_OFF + wave * 16384);
#define P5_LOAD(wv_, it_) do { if ((it_) < I_G) tr_load(wv_, w_gate, FF, (it_), lane); else if ((it_) < 2 * I_G) tr_load(wv_, w_up, FF, (it_) - I_G, lane); else tr_load(wv_, w_down, D, (it_) - 2 * I_G, lane); } while (0)
#define P5_FIN(wv_, it_) do { if ((it_) < I_G) tr_finish<1>(wv_, D, FF, Wgu_t, scr, (it_), lane, w_ffn); else if ((it_) < 2 * I_G) tr_finish<2>(wv_, D, FF, Wgu_t, scr, (it_) - I_G, lane, w_ffn); \
                else tr_finish<0>(wv_, FF, D, Wdown_t, scr, (it_) - 2 * I_G, lane); } while (0)
        for (int it = gw; it < 2 * I_G + I_D; it += 2 * NGW) { float wa[32], wb[32]; const bool two = it + NGW < 2 * I_G + I_D;
            P5_LOAD(wa, it); if (two) P5_LOAD(wb, it + NGW);
            P5_FIN(wa, it); if (two) P5_FIN(wb, it + NGW); }
#undef P5_LOAD
#undef P5_FIN
    }
    if (team_ok) { bgen = xcd_barrier_arrive(bar); lb_wait(bar, ctl, lgen); }
    else { SEAM_WAIT(4); if (local_ok) bgen = xcd_barrier_arrive(bar); }
    if (IN(5)) REP(5) {
        pg8::Gemm g{Ob, Wout_t, M, D, D}; pg8::StaticOrder S; S.init(M, D, G, bx);
        EpiOutProj E{XN, X1b, ssq};
        pg8::gemm_phase<EpiOutProj, pg8::StaticOrder, true, true>(lds + RING_OFF, g, S, E);
    }
    if (team_ok) { xcd_barrier_poll(bar, bgen); team_barrier(tcnt, 1u, ctl + CW_BAR + XB_TMO); }
    else if (local_ok) { lgen = lb_arrive(bar, ctl); lb_wait(bar, ctl, lgen); xcd_barrier_wait(bar, bgen); } else SEAM(5);
    if (IN(6)) REP(6) {
        pg8::Gemm g{X1b, Wgu_t, M, 2 * FF, D}; pg8::StaticOrder S; S.init(M, 2 * FF, G, bx);
        EpiGateUp E{HFF, ssq, ctl + CW_P4DONE, full ? (unsigned)G : 0u, false};
        pg8::gemm_phase<EpiGateUp, pg8::StaticOrder, true, true>(lds + RING_OFF, g, S, E);
    }
    if (team_ok) team_barrier(tcnt, 2u, ctl + CW_BAR + XB_TMO);
    else if (local_ok) { lgen = lb_arrive(bar, ctl); lb_wait(bar, ctl, lgen); } else SEAM(6);
    if (IN(7)) REP(7) {
        pg8::Gemm g{HFF, Wdown_t, M, D, FF}; pg8::StaticOrder S; S.init(M, D, G, bx);
        EpiDown E{out, X1b, ctl + CW_P4DONE, full ? (unsigned)G : 0u, false};
        pg8::gemm_phase<EpiDown, pg8::StaticOrder, true, true>(lds + RING_OFF, g, S, E);
    }
#undef IN
#undef SEAM
}

#ifndef N_LAUNCHES
#define N_LAUNCHES 1
#endif
extern "C" void kernel_launch(void* const* d_in, const int* in_sizes, int n_in, void* d_out, int out_size, void* d_ws, size_t ws_size, hipStream_t stream) {
    static int grid = 0;
    if (grid == 0) {
        if (n_in != 14 || out_size != 2 * MP * D || ws_size < WS_END) { fprintf(stderr, "kernel_launch: unexpected shapes (n_in %d out %d ws %zu)\n", n_in, out_size, ws_size); grid = -1; return; }
        int dev = 0, cus = 0;
        if (hipGetDevice(&dev) != hipSuccess || hipDeviceGetAttribute(&cus, hipDeviceAttributeMultiprocessorCount, dev) != hipSuccess) { grid = -1; return; }
        if (hipFuncSetAttribute((const void*)fwd_kernel, hipFuncAttributeMaxDynamicSharedMemorySize, LDS_BYTES) != hipSuccess) { fprintf(stderr, "kernel_launch: hipFuncSetAttribute failed\n"); grid = -1; return; }
        grid = cus;
    }
    if (grid < 0) return;
    (void)hipMemsetAsync((char*)d_ws + WS_CTL, 0, CTL_ZERO_BYTES, stream);
    Args a{};
    for (int i = 0; i < 14; ++i) a.in[i] = (const float*)d_in[i];
    a.out = (float*)d_out; a.ws = (unsigned char*)d_ws;
    if (N_LAUNCHES == 1) { a.ph_lo = 0; a.ph_hi = N_PHASES; hipLaunchKernelGGL(fwd_kernel, dim3(grid), dim3(NWAVES * 64), LDS_BYTES, stream, a); }
    else for (int p = 0; p < N_PHASES; ++p) { a.ph_lo = p; a.ph_hi = p + 1; hipLaunchKernelGGL(fwd_kernel, dim3(grid), dim3(NWAVES * 64), LDS_BYTES, stream, a); }
}
```

```cpp
#include <hip/hip_runtime.h>
#include <cstdio>
#include <cstdint>
namespace pg8 {
#define PG8_LAS __attribute__((address_space(3)))
typedef unsigned short bf16_t;
typedef short bf16x8 __attribute__((ext_vector_type(8)));
typedef float f32x4 __attribute__((ext_vector_type(4)));
typedef unsigned u32x4 __attribute__((ext_vector_type(4)));
constexpr int BM = 256, BK = 64, HALF = 128, HTB = HALF * BK * 2  , STAGE_BYTES = 8 * HTB, NXCD = 8, WGM = 8;

__host__ __device__ __forceinline__ int lds_byte(int r, int c) { const int st = (r >> 4) * 2 + (c >> 5), rr = r & 15, cc = c & 31, ob = rr * 64 + cc * 2; return st * 1024 + (ob ^ (((ob >> 9) & 1) << 5)); }
__host__ __device__ __forceinline__ void stage_rc(int b, int& R, int& C) { const int st = b / 1024, sb = b % 1024, swz = sb ^ (((sb >> 9) & 1) << 5); R = (st >> 1) * 16 + swz / 64; C = (st & 1) * 32 + (swz % 64) / 2; }
__host__ __device__ __forceinline__ int perm32(int rho) { const int n = rho >> 4, i = rho & 15; return 8 * (i >> 2) + 4 * n + (i & 3); }

struct Unit { int pm, pn; };
struct Gemm { const bf16_t* A; const bf16_t* Bt; int M, N, K; };

struct StaticOrder {
    int nM, nN, nwg, G, c;
    __host__ __device__ void init(int M, int N, int G_, int c_) { nM = M / BM; nN = N / BM; nwg = nM * nN; G = G_; c = c_; }
    __host__ __device__ bool next(int i, Unit& u) const {
        const long L = (long)i * G + c; if (L >= nwg) return false;
        int wgid = (int)L; { const int q = nwg / NXCD, r = nwg % NXCD, xcd = wgid % NXCD, off = wgid / NXCD; wgid = (xcd < r ? xcd * (q + 1) : r * (q + 1) + (xcd - r) * q) + off; }
        const int nig = WGM * nN, gid = wgid / nig, fm = gid * WGM, gsz = (nM - fm) < WGM ? (nM - fm) : WGM;
        u.pm = fm + ((wgid % nig) % gsz); u.pn = (wgid % nig) / gsz; return true;
    }
    __device__ __forceinline__ void a_ready(const Unit&) const {}
    __device__ __forceinline__ void done(const Unit&) const {}
};

__device__ __forceinline__ unsigned cvt_pk_bf16(float lo, float hi) { unsigned r; asm volatile("v_cvt_pk_bf16_f32 %0, %1, %2" : "=v"(r) : "v"(lo), "v"(hi)); return r; }
template <class Epi, class Sched, bool ALIGN_EPI = false, bool SP2 = false>
__device__ __forceinline__ void gemm_phase(PG8_LAS unsigned char* lds, const Gemm g, const Sched& S, const Epi& E) {
    const int tid = threadIdx.x, wid = __builtin_amdgcn_readfirstlane(tid >> 6), lane = tid & 63, wr = wid >> 2, wc = wid & 3, fr = lane & 15, fq = lane >> 4;
    const int K = g.K, nt = K / BK;
    unsigned voffA[2], voffB[2];
#pragma unroll
    for (int i = 0; i < 2; ++i) { int R, C; stage_rc(tid * 16 + i * 8192, R, C); const int Rb = Epi::PERM ? ((R & ~31) + perm32(R & 31)) : R;
        voffA[i] = (unsigned)(R * K + C) * 2u; voffB[i] = (unsigned)(Rb * K + C) * 2u; }
    const size_t kstep = (size_t)(BK * 2);
    const size_t hstep = (size_t)HALF * K * 2;
    const size_t tstep = 2 * hstep;
    const unsigned ldsw = (unsigned)wid * 1024u;
    const int aoff = lds_byte(wr * 64 + fr, fq * 8), boff = lds_byte(wc * 32 + fr, fq * 8);
#define PG8_SA(b, h) (((b) * 2 + (h)) * HTB)
#define PG8_SB(b, h) ((4 + (b) * 2 + (h)) * HTB)
#define PG8_STAGE(bufoff, gbase, voff) do { _Pragma("unroll") for (int _i = 0; _i < 2; ++_i) \
        __builtin_amdgcn_global_load_lds((const unsigned*)((const char*)(gbase) + (voff)[_i]), (PG8_LAS unsigned*)(lds + (bufoff) + ldsw + _i * 8192), 16, 0, 0); } while (0)
#define PG8_LDA(dst, b, h) do { _Pragma("unroll") for (int m = 0; m < 4; ++m) _Pragma("unroll") for (int k = 0; k < 2; ++k) dst[m][k] = *(const PG8_LAS bf16x8*)(lds + PG8_SA(b, h) + aoff + m * 2048 + k * 1024); } while (0)
#define PG8_LDB(dst, b, h) do { _Pragma("unroll") for (int n = 0; n < 2; ++n) _Pragma("unroll") for (int k = 0; k < 2; ++k) dst[n][k] = *(const PG8_LAS bf16x8*)(lds + PG8_SB(b, h) + boff + n * 2048 + k * 1024); } while (0)
#define PG8_MMA(ai, bj, At, Bt) do { __builtin_amdgcn_s_setprio(1); _Pragma("unroll") for (int m = 0; m < 4; ++m) _Pragma("unroll") for (int n = 0; n < 2; ++n) _Pragma("unroll") for (int k = 0; k < 2; ++k) \
        acc[ai][bj][m][n] = __builtin_amdgcn_mfma_f32_16x16x32_bf16(Bt[n][k], At[m][k], acc[ai][bj][m][n], 0, 0, 0); __builtin_amdgcn_s_setprio(0); } while (0)
#define PG8_WAIT_V(n) asm volatile("s_waitcnt vmcnt(" #n ")" ::: "memory")
#define PG8_WAIT_L(n) asm volatile("s_waitcnt lgkmcnt(" #n ")" ::: "memory")
#define PG8_BAR __builtin_amdgcn_s_barrier()
#define PG8_SCHED __builtin_amdgcn_sched_barrier(0)
    Unit cur, nxt; int ui = 0;
    if (!S.next(0, cur)) return;
    f32x4 acc[2][2][4][2];
#pragma unroll
    for (int a = 0; a < 2; ++a)
#pragma unroll
        for (int b = 0; b < 2; ++b)
#pragma unroll
            for (int m = 0; m < 4; ++m)
#pragma unroll
                for (int n = 0; n < 2; ++n) acc[a][b][m][n] = (f32x4){0.f, 0.f, 0.f, 0.f};
    bf16x8 At[4][2], B0[2][2], B1[2][2];
    const char* cA = (const char*)g.A + (size_t)cur.pm * tstep; const char* cB = (const char*)g.Bt + (size_t)cur.pn * tstep;
    S.a_ready(cur);
    if constexpr (SP2) {
        PG8_STAGE(PG8_SB(0, 0), cB, voffB); PG8_STAGE(PG8_SB(0, 1), cB + hstep, voffB); PG8_STAGE(PG8_SA(0, 0), cA, voffA); PG8_STAGE(PG8_SA(0, 1), cA + hstep, voffA);
        if (wr == 1) PG8_BAR;
        PG8_WAIT_V(2); PG8_BAR;
        PG8_STAGE(PG8_SB(1, 0), cB + kstep, voffB); PG8_STAGE(PG8_SA(1, 0), cA + kstep, voffA); PG8_STAGE(PG8_SB(1, 1), cB + hstep + kstep, voffB);
        PG8_WAIT_V(6); PG8_BAR;
    } else {
        PG8_STAGE(PG8_SB(0, 0), cB, voffB); PG8_STAGE(PG8_SA(0, 0), cA, voffA); PG8_STAGE(PG8_SB(0, 1), cB + hstep, voffB); PG8_STAGE(PG8_SA(0, 1), cA + hstep, voffA);
        if (wr == 1) PG8_BAR;
        PG8_WAIT_V(4); PG8_BAR;
        PG8_STAGE(PG8_SB(1, 0), cB + kstep, voffB); PG8_STAGE(PG8_SA(1, 0), cA + kstep, voffA); PG8_STAGE(PG8_SB(1, 1), cB + hstep + kstep, voffB);
        PG8_WAIT_V(6); PG8_BAR;
    }
    for (;;) {
        const bool has_next = S.next(ui + 1, nxt);
        const char* nA = has_next ? (const char*)g.A + (size_t)nxt.pm * tstep : cA; const char* nB = has_next ? (const char*)g.Bt + (size_t)nxt.pn * tstep : cB;
        for (int t = 0; t < nt; t += 2) {
            const bool last = (t == nt - 2);
            const char* a1 = cA + (size_t)(t + 1) * kstep;
            const char* a2 = last ? nA : cA + (size_t)(t + 2) * kstep; const char* b2 = last ? nB : cB + (size_t)(t + 2) * kstep;
            const char* a3 = a2 + kstep; const char* b3 = b2 + kstep;
            if (last && has_next) S.a_ready(nxt);
            if constexpr (SP2) {
            PG8_LDB(B0, 0, 0); PG8_LDB(B1, 0, 1); PG8_SCHED; PG8_LDA(At, 0, 0); PG8_STAGE(PG8_SA(1, 1), a1 + hstep, voffA);
            PG8_WAIT_V(8); PG8_WAIT_L(0); PG8_BAR; PG8_MMA(0, 0, At, B0); PG8_MMA(0, 1, At, B1); PG8_BAR; PG8_SCHED;
            PG8_LDA(At, 0, 1); PG8_STAGE(PG8_SB(0, 0), b2, voffB); PG8_STAGE(PG8_SB(0, 1), b2 + hstep, voffB); PG8_STAGE(PG8_SA(0, 0), a2, voffA);
            PG8_WAIT_V(8); PG8_WAIT_L(0); PG8_BAR; PG8_MMA(1, 0, At, B0); PG8_MMA(1, 1, At, B1); PG8_BAR; PG8_SCHED;
            PG8_LDB(B0, 1, 0); PG8_LDB(B1, 1, 1); PG8_SCHED; PG8_LDA(At, 1, 0); PG8_STAGE(PG8_SA(0, 1), a2 + hstep, voffA);
            PG8_WAIT_V(8); PG8_WAIT_L(0); PG8_BAR; PG8_MMA(0, 0, At, B0); PG8_MMA(0, 1, At, B1); PG8_BAR; PG8_SCHED;
            PG8_LDA(At, 1, 1); PG8_STAGE(PG8_SB(1, 0), b3, voffB); PG8_STAGE(PG8_SB(1, 1), b3 + hstep, voffB); PG8_STAGE(PG8_SA(1, 0), a3, voffA);
            PG8_WAIT_V(8); PG8_WAIT_L(0); PG8_BAR; PG8_MMA(1, 0, At, B0); PG8_MMA(1, 1, At, B1); PG8_BAR; PG8_SCHED;
            } else {
            PG8_LDB(B0, 0, 0); PG8_SCHED; PG8_LDA(At, 0, 0); PG8_STAGE(PG8_SA(1, 1), a1 + hstep, voffA);
            PG8_WAIT_L(8); PG8_BAR; PG8_WAIT_L(0); PG8_MMA(0, 0, At, B0); PG8_BAR; PG8_SCHED;
            PG8_LDB(B1, 0, 1); PG8_STAGE(PG8_SB(0, 0), b2, voffB);
            PG8_BAR; PG8_WAIT_L(0); PG8_MMA(0, 1, At, B1); PG8_BAR;
            PG8_LDA(At, 0, 1); PG8_STAGE(PG8_SA(0, 0), a2, voffA);
            PG8_BAR; PG8_WAIT_L(0); PG8_MMA(1, 0, At, B0); PG8_BAR; PG8_SCHED;
            PG8_STAGE(PG8_SB(0, 1), b2 + hstep, voffB);
            PG8_WAIT_V(6); PG8_BAR; PG8_MMA(1, 1, At, B1); PG8_BAR;
            PG8_LDB(B0, 1, 0); PG8_SCHED; PG8_LDA(At, 1, 0); PG8_STAGE(PG8_SA(0, 1), a2 + hstep, voffA);
            PG8_WAIT_L(8); PG8_BAR; PG8_WAIT_L(0); PG8_MMA(0, 0, At, B0); PG8_BAR; PG8_SCHED;
            PG8_LDB(B1, 1, 1); PG8_STAGE(PG8_SB(1, 0), b3, voffB);
            PG8_BAR; PG8_WAIT_L(0); PG8_MMA(0, 1, At, B1); PG8_BAR;
            PG8_LDA(At, 1, 1); PG8_STAGE(PG8_SA(1, 0), a3, voffA);
            PG8_BAR; PG8_WAIT_L(0); PG8_MMA(1, 0, At, B0); PG8_BAR; PG8_SCHED;
            PG8_STAGE(PG8_SB(1, 1), b3 + hstep, voffB);
            PG8_WAIT_V(6); PG8_BAR; PG8_MMA(1, 1, At, B1); PG8_BAR;
            }
        }
        if constexpr (ALIGN_EPI) { if (wr == 0) PG8_BAR; }
        if constexpr (!Epi::AFTER_DRAIN) { E(acc, cur, wr, wc, fr, fq); S.done(cur); }
        if (!has_next) break;
#pragma unroll
        for (int a = 0; a < 2; ++a)
#pragma unroll
            for (int b = 0; b < 2; ++b)
#pragma unroll
                for (int m = 0; m < 4; ++m)
#pragma unroll
                    for (int n = 0; n < 2; ++n) acc[a][b][m][n] = (f32x4){0.f, 0.f, 0.f, 0.f};
        cur = nxt; cA = nA; cB = nB; ++ui;
        if constexpr (ALIGN_EPI) { if (wr == 1) PG8_BAR; }
    }
    PG8_WAIT_V(0);
    if constexpr (!ALIGN_EPI) { if (wr == 0) PG8_BAR; }
    PG8_BAR;
    if constexpr (Epi::AFTER_DRAIN) { E.fused(acc, cur, wr, wc, fr, fq, lds, wid, lane); S.done(cur); }
#undef PG8_SA
#undef PG8_SB
#undef PG8_STAGE
#undef PG8_LDA
#undef PG8_LDB
#undef PG8_MMA
#undef PG8_WAIT_V
#undef PG8_WAIT_L
#undef PG8_BAR
#undef PG8_SCHED
}
}

#ifndef PROBE
#define PROBE -1
#endif

constexpr int NWAVES = 8;
constexpr int M = 32768, MP = 16384, D = 1024, INC = 4096, FF = 2816, GW = 512;
constexpr float EPS = 1e-6f;
constexpr size_t MiB = 1u << 20;
constexpr size_t WS_CTL = 0, CTL_BYTES = 1 * MiB, CTL_ZERO_BYTES = 32768;
constexpr size_t WS_WIN = 1 * MiB;
constexpr size_t WS_WOUT = 9 * MiB;
constexpr size_t WS_WGU = 11 * MiB;
constexpr size_t WS_WDOWN = 22 * MiB;
constexpr size_t WS_A = 28 * MiB;
constexpr size_t WS_O = 92 * MiB;
constexpr size_t WS_H = 156 * MiB;
constexpr size_t WS_SL = 316 * MiB;
constexpr size_t WS_SF = 332 * MiB;
constexpr size_t WS_X1 = 340 * MiB;
constexpr size_t WS_HFF = WS_H;
constexpr size_t WS_END = 404 * MiB;
static_assert(WS_HFF + (size_t)M * FF * 2 <= WS_SF && WS_SL + 16 * MiB <= WS_SF, "ws map");
constexpr int CW_BAR = 4096;
constexpr int CW_LB = 0;
constexpr int CW_NONCANON = 3072;
constexpr int CW_TB = 2048;
constexpr int CW_P4DONE = 3264;
constexpr int CW_XMAP = 3136;
constexpr int CW_RSTD0 = 98304;
constexpr int CW_SSQ = 65536;
constexpr int CW_BT = 131072;
static_assert((CW_SSQ + M) <= CW_BT && (CW_BT + 256 * 128) * 4 <= (int)CTL_BYTES && (CW_BAR + 3456) * 4 <= (int)CTL_ZERO_BYTES, "ctl");
constexpr int RING_OFF = 0, RING_BYTES = 131072;
constexpr int LDS_BYTES = 163840;
constexpr int LDSCTL_OFF = 159744, MISC_OFF = LDSCTL_OFF + 320;

#define GAS __attribute__((address_space(1)))
#define LAS __attribute__((address_space(3)))
typedef unsigned short bf16;
typedef unsigned v4u __attribute__((ext_vector_type(4)));
typedef unsigned v2u __attribute__((ext_vector_type(2)));
typedef float f32x4 __attribute__((ext_vector_type(4)));
typedef float f32x2 __attribute__((ext_vector_type(2)));
#define LDS_WAIT() asm volatile("s_waitcnt lgkmcnt(0)" ::: "memory")
#define VM_WAIT() asm volatile("s_waitcnt vmcnt(0)" ::: "memory")
__device__ __forceinline__ unsigned f2bf(float f) { unsigned u = __builtin_bit_cast(unsigned, f); return (u + 0x7fffu + ((u >> 16) & 1u)) >> 16; }
__device__ __forceinline__ unsigned pk2(float lo, float hi) { return f2bf(lo) | (f2bf(hi) << 16); }
__device__ __forceinline__ float bflo(unsigned w) { return __builtin_bit_cast(float, w << 16); }
__device__ __forceinline__ float bfhi(unsigned w) { return __builtin_bit_cast(float, w & 0xffff0000u); }
typedef float f32x2_t __attribute__((ext_vector_type(2))); typedef __bf16 bf16x2_t __attribute__((ext_vector_type(2)));
__device__ __forceinline__ unsigned cvtpk(float lo, float hi) { f32x2_t v = {lo, hi}; bf16x2_t b = __builtin_convertvector(v, bf16x2_t); return __builtin_bit_cast(unsigned, b); }
__device__ __forceinline__ float ex2_(float x) { return __builtin_amdgcn_exp2f(x); }
__device__ __forceinline__ float rcp_(float x) { return __builtin_amdgcn_rcpf(x); }
__device__ __forceinline__ float rsq_(float x) { return __builtin_amdgcn_rsqf(x); }
template <int CTRL> __device__ __forceinline__ float dpp_(float v) { return __builtin_bit_cast(float, __builtin_amdgcn_update_dpp(0, __builtin_bit_cast(int, v), CTRL, 0xF, 0xF, false)); }
__device__ __forceinline__ float sum8_(float v) { v += dpp_<0xB1>(v); v += dpp_<0x4E>(v); v += dpp_<0x141>(v); return v; }
__device__ __forceinline__ float sum16_(float v) { v = sum8_(v); v += dpp_<0x140>(v); return v; }
__device__ __forceinline__ float sigmoidf_(float x) { return rcp_(1.f + ex2_(-1.44269504089f * x)); }
__device__ __forceinline__ float siluf_(float x) { return x * rcp_(1.f + ex2_(-1.44269504089f * x)); }

#define XB_TMO      128
#define XB_XCNT(j)  (256  + 64 * (j))
#define XB_XSUB(j)  (1280 + 64 * (j))
#define XB_XGEN(j)  (2304 + 64 * (j))
#define XB_TOP      3328
#define XB_TOPGEN   3392
#define XCD_BAR_WORDS 3456
#define XB_SPIN_CAP (1u << 18)
__device__ __forceinline__ unsigned xb_ld(unsigned* p)              { return __hip_atomic_load(p, __ATOMIC_RELAXED, __HIP_MEMORY_SCOPE_AGENT); }
__device__ __forceinline__ unsigned xb_add(unsigned* p, unsigned v) { return __hip_atomic_fetch_add(p, v, __ATOMIC_RELAXED, __HIP_MEMORY_SCOPE_AGENT); }
__device__ __forceinline__ void st16_wt(void* p, v4u v) { asm volatile("global_store_dwordx4 %0, %1, off sc1" :: "v"(p), "v"(v) : "memory"); }
__device__ __forceinline__ unsigned xb_xcc_id() { return (unsigned)__builtin_amdgcn_s_getreg((3 << 11) | 20) & 0xFu; }
#define XB_SPIN(cond, bar) do { unsigned _sp = 0; while (cond) { __builtin_amdgcn_s_sleep(1); \
    if ((++_sp & 255u) == 0u) { if (xb_ld(&(bar)[XB_TMO])) break; if (_sp > XB_SPIN_CAP) { atomicAdd(&(bar)[XB_TMO], 1u); break; } } } } while (0)
struct XcdBarrier { unsigned* bar; unsigned x; volatile LAS unsigned* st; };
__device__ __forceinline__ XcdBarrier xcd_barrier_post(unsigned* bar, volatile LAS unsigned* st) {
    XcdBarrier b; b.bar = bar; b.x = xb_xcc_id(); b.st = st;
    if (threadIdx.x == 0) (void)xb_add(&bar[XB_XCNT(b.x)], 1u);
    return b;
}
__device__ __forceinline__ void xcd_barrier_complete(unsigned* bar, unsigned x, unsigned& nloc, unsigned& nx) {
    const unsigned G = gridDim.x * gridDim.y * gridDim.z;
    unsigned sum, cnt, mine, sp = 0u;
    for (;;) {
        sum = 0u; cnt = 0u; mine = 0u;
#pragma unroll
        for (unsigned j = 0; j < 16; ++j) { const unsigned c = xb_ld(&bar[XB_XCNT(j)]); sum += c; cnt += (c > 0u) ? 1u : 0u; mine = (j == x) ? c : mine; }
        if (sum == G) break;
        __builtin_amdgcn_s_sleep(1);
        if ((++sp & 255u) == 0u) { if (xb_ld(&bar[XB_TMO])) break; if (sp > XB_SPIN_CAP) { atomicAdd(&bar[XB_TMO], 1u); break; } }
    }
    nloc = mine > 0u ? mine : 1u; nx = cnt > 0u ? cnt : 1u;
}
__device__ __forceinline__ void xcd_barrier(const XcdBarrier& b) {
    asm volatile("s_waitcnt vmcnt(0)" ::: "memory");
    __syncthreads();
    if (threadIdx.x == 0) {
        unsigned* bar = b.bar;
        __builtin_amdgcn_s_waitcnt(0);
        unsigned nloc = b.st[0], nx = b.st[1];
        if (nloc == 0u) { xcd_barrier_complete(bar, b.x, nloc, nx); b.st[0] = nloc; b.st[1] = nx; }
        const unsigned old = xb_add(&bar[XB_XSUB(b.x)], 1u);
        const unsigned gen = old / nloc;
        if (old + 1u == (gen + 1u) * nloc) {
            __builtin_amdgcn_fence(__ATOMIC_RELEASE, "agent");
            asm volatile("s_waitcnt vmcnt(0)" ::: "memory");
            const unsigned og = xb_add(&bar[XB_TOP], 1u);
            const unsigned tg = og / nx;
            if (og + 1u == (tg + 1u) * nx) xb_add(&bar[XB_TOPGEN], 1u);
            else XB_SPIN(xb_ld(&bar[XB_TOPGEN]) == tg, bar);
            __builtin_amdgcn_fence(__ATOMIC_ACQUIRE, "agent");
            xb_add(&bar[XB_XGEN(b.x)], 1u);
            asm volatile("s_waitcnt vmcnt(0)" ::: "memory");
        } else {
            XB_SPIN(xb_ld(&bar[XB_XGEN(b.x)]) == gen, bar);
            __builtin_amdgcn_fence(__ATOMIC_ACQUIRE, "agent");
            asm volatile("s_waitcnt vmcnt(0)" ::: "memory");
        }
    }
    __syncthreads();
}

__device__ __forceinline__ unsigned xcd_barrier_arrive(const XcdBarrier& b, bool rel = true) {
    unsigned gen = 0u;
    asm volatile("s_waitcnt vmcnt(0)" ::: "memory");
    __syncthreads();
    if (threadIdx.x == 0) {
        unsigned* bar = b.bar;
        __builtin_amdgcn_s_waitcnt(0);
        unsigned nloc = b.st[0], nx = b.st[1];
        if (nloc == 0u) { xcd_barrier_complete(bar, b.x, nloc, nx); b.st[0] = nloc; b.st[1] = nx; }
        const unsigned old = xb_add(&bar[XB_XSUB(b.x)], 1u);
        gen = old / nloc;
        if (old + 1u == (gen + 1u) * nloc) {
            if (rel) { __builtin_amdgcn_fence(__ATOMIC_RELEASE, "agent"); asm volatile("s_waitcnt vmcnt(0)" ::: "memory"); }
            const unsigned og = xb_add(&bar[XB_TOP], 1u);
            const unsigned tg = og / nx;
            if (og + 1u == (tg + 1u) * nx) xb_add(&bar[XB_TOPGEN], 1u);
            xb_add(&bar[XB_XGEN(b.x)], 1u);
        }
    }
    return gen;
}
__device__ __forceinline__ void xcd_barrier_poll(const XcdBarrier& b, unsigned gen) {
    if (threadIdx.x == 0) { unsigned* bar = b.bar; XB_SPIN(xb_ld(&bar[XB_TOPGEN]) == gen, bar); }
}
__device__ __forceinline__ void xcd_barrier_wait(const XcdBarrier& b, unsigned gen) {
    if (threadIdx.x == 0) {
        unsigned* bar = b.bar;
        XB_SPIN(xb_ld(&bar[XB_TOPGEN]) == gen, bar);
        __builtin_amdgcn_fence(__ATOMIC_ACQUIRE, "agent");
        asm volatile("s_waitcnt vmcnt(0)" ::: "memory");
    }
    __syncthreads();
}

#define XL_SUB(j) (CW_LB + 64 * (j))
#define XL_GEN(j) (CW_LB + 1024 + 64 * (j))
__device__ __forceinline__ unsigned lb_arrive(const XcdBarrier& b, unsigned* ctl) {
    unsigned gen = 0u;
    asm volatile("s_waitcnt vmcnt(0)" ::: "memory");
    __syncthreads();
    if (threadIdx.x == 0) {
        __builtin_amdgcn_s_waitcnt(0);
        const unsigned nloc = b.st[0];
        const unsigned old = xb_add(&ctl[XL_SUB(b.x)], 1u);
        gen = old / nloc;
        if (old + 1u == (gen + 1u) * nloc) xb_add(&ctl[XL_GEN(b.x)], 1u);
    }
    return gen;
}
__device__ __forceinline__ void lb_wait(const XcdBarrier& b, unsigned* ctl, unsigned gen) {
    if (threadIdx.x == 0) {
        XB_SPIN(xb_ld(&ctl[XL_GEN(b.x)]) == gen, b.bar);
        __builtin_amdgcn_fence(__ATOMIC_ACQUIRE, "agent");
        asm volatile("s_waitcnt vmcnt(0)" ::: "memory");
    }
    __syncthreads();
}

__device__ __forceinline__ void team_barrier(unsigned* cnt, unsigned gen, unsigned* tmo) {
    asm volatile("s_waitcnt vmcnt(0)" ::: "memory");
    __syncthreads();
    if (threadIdx.x == 0) {
        __builtin_amdgcn_s_waitcnt(0);
        (void)xb_add(cnt, 1u);
        XB_SPIN(xb_ld(cnt) < 4u * (gen + 1u), tmo - XB_TMO);
        __builtin_amdgcn_fence(__ATOMIC_ACQUIRE, "agent");
        asm volatile("s_waitcnt vmcnt(0)" ::: "memory");
    }
    __syncthreads();
}

struct EpiInProj {
    static constexpr bool PERM = true, AFTER_DRAIN = false;
    bf16* hbase; bf16* nabase; const float* lbp; const float* rstd0;
    __device__ __forceinline__ void operator()(const pg8::f32x4 (&acc)[2][2][4][2], const pg8::Unit& u, int wr, int wc, int fr, int fq) const {
        const int ot = u.pn;
        const int grp = ot >> 1;
        bf16* base = grp < 5 ? hbase + (size_t)grp * ((size_t)M * GW) : nabase + (size_t)(grp - 5) * ((size_t)M * GW);
        const int row0 = u.pm * 256 + wr * 64 + fr;
        const int col0 = (ot & 1) * 256 + wc * 32 + 8 * fq;
        float rs_[2][4];
#pragma unroll
        for (int ai = 0; ai < 2; ++ai)
#pragma unroll
            for (int m = 0; m < 4; ++m) rs_[ai][m] = rstd0[row0 + ai * 128 + m * 16];
        float lb[2][8];
#pragma unroll
        for (int bj = 0; bj < 2; ++bj)
#pragma unroll
            for (int e = 0; e < 8; ++e) lb[bj][e] = 0.f;
        if (grp == 1 || grp == 2) {
#pragma unroll
            for (int bj = 0; bj < 2; ++bj)
#pragma unroll
                for (int e = 0; e < 8; ++e) { const int c = (grp - 1) * GW + col0 + bj * 128 + e; lb[bj][e] = rcp_(1.f + ex2_(1.44269504089f * (lbp[1024 + c] - lbp[c]))); }
        }
#pragma unroll
        for (int ai = 0; ai < 2; ++ai)
#pragma unroll
            for (int m = 0; m < 4; ++m) { const size_t row = (size_t)(row0 + ai * 128 + m * 16);
#pragma unroll
                for (int bj = 0; bj < 2; ++bj) {
                    float v[8];
#pragma unroll
                    for (int e = 0; e < 4; ++e) { v[e] = acc[ai][bj][m][0][e] * rs_[ai][m]; v[4 + e] = acc[ai][bj][m][1][e] * rs_[ai][m]; }
                    if (grp == 0 || grp == 4) {
#pragma unroll
                        for (int e = 0; e < 8; ++e) v[e] = siluf_(v[e]);
                    } else if (grp == 1 || grp == 2) {
#pragma unroll
                        for (int e = 0; e < 8; ++e) v[e] = __builtin_amdgcn_logf(lb[bj][e] + (1.f - lb[bj][e]) * sigmoidf_(v[e]));
                    }
                    pg8::u32x4 w; w.x = cvtpk(v[0], v[1]); w.y = cvtpk(v[2], v[3]); w.z = cvtpk(v[4], v[5]); w.w = cvtpk(v[6], v[7]);
                    bf16* dst = grp < 5 ? base + (size_t)((ot & 1) * 2 + bj) * ((size_t)M * 128) + row * 128 + wc * 32 + 8 * fq
                                        : base + (size_t)((ot & 1) * 4 + bj * 2 + (wc >> 1)) * ((size_t)M * 64) + row * 64 + (wc & 1) * 32 + 8 * fq;
                    *(pg8::u32x4*)dst = w; } }
    }
};
struct EpiOutProj {
    static constexpr bool PERM = true, AFTER_DRAIN = false;
    const bf16* xb; bf16* x1b; float* ssq;
    __device__ __forceinline__ void operator()(const pg8::f32x4 (&acc)[2][2][4][2], const pg8::Unit& u, int wr, int wc, int fr, int fq) const {
        const int row0 = u.pm * 256 + wr * 64 + fr, col0 = u.pn * 256 + wc * 32 + 8 * fq;
        const bf16* xbase = xb + (size_t)row0 * D + col0;
#pragma unroll
        for (int ai = 0; ai < 2; ++ai) {
            pg8::u32x4 xw[4][2];
#pragma unroll
            for (int m = 0; m < 4; ++m)
#pragma unroll
                for (int bj = 0; bj < 2; ++bj) xw[m][bj] = __builtin_nontemporal_load((const pg8::u32x4*)(xbase + (size_t)(ai * 128 + m * 16) * D + bj * 128));
            __builtin_amdgcn_sched_barrier(0);
            float sq4[4];
#pragma unroll
            for (int m = 0; m < 4; ++m) { const int row = row0 + ai * 128 + m * 16;
                bf16* nrow = x1b + (size_t)row * D + col0;
                float sq = 0.f;
#pragma unroll
                for (int bj = 0; bj < 2; ++bj) {
                    const pg8::u32x4 x_ = xw[m][bj];
                    pg8::f32x4 a0 = acc[ai][bj][m][0], a1 = acc[ai][bj][m][1];
                    a0[0] += bflo(x_.x); a0[1] += bfhi(x_.x); a0[2] += bflo(x_.y); a0[3] += bfhi(x_.y); a1[0] += bflo(x_.z); a1[1] += bfhi(x_.z); a1[2] += bflo(x_.w); a1[3] += bfhi(x_.w);
                    sq += (a0[0] * a0[0] + a0[1] * a0[1]) + (a0[2] * a0[2] + a0[3] * a0[3]) + (a1[0] * a1[0] + a1[1] * a1[1]) + (a1[2] * a1[2] + a1[3] * a1[3]);
                    pg8::u32x4 w; w.x = cvtpk(a0[0], a0[1]); w.y = cvtpk(a0[2], a0[3]); w.z = cvtpk(a1[0], a1[1]); w.w = cvtpk(a1[2], a1[3]);
                    *(pg8::u32x4*)(nrow + bj * 128) = w; }
                sq4[m] = sq; }
#pragma unroll
            for (int m = 0; m < 4; ++m) sq4[m] += __shfl_xor(sq4[m], 16);
#pragma unroll
            for (int m = 0; m < 4; ++m) sq4[m] += __shfl_xor(sq4[m], 32);
            if (fq == 0) {
#pragma unroll
                for (int m = 0; m < 4; ++m) atomicAdd(ssq + row0 + ai * 128 + m * 16, sq4[m]); }
            __builtin_amdgcn_sched_barrier(0);
        }
    }
};
struct EpiGateUp {
    static constexpr bool PERM = true, AFTER_DRAIN = false;
    bf16* h; const float* ssq; unsigned* guard; unsigned need; mutable bool checked;
    __device__ __forceinline__ void operator()(const pg8::f32x4 (&acc)[2][2][4][2], const pg8::Unit& u, int wr, int wc, int fr, int fq) const {
        const int row0 = u.pm * 256 + wr * 64 + fr, col0 = u.pn * 128 + wc * 32 + 8 * fq;
        float sqv[2][4];
#pragma unroll
        for (int ai = 0; ai < 2; ++ai)
#pragma unroll
            for (int m = 0; m < 4; ++m) sqv[ai][m] = ssq[row0 + ai * 128 + m * 16];
        unsigned gv = checked ? need : xb_ld(guard);
        __builtin_amdgcn_sched_barrier(0);
        while (gv < need) { __builtin_amdgcn_s_sleep(2); gv = xb_ld(guard); }
        checked = true;
#pragma unroll
        for (int ai = 0; ai < 2; ++ai)
#pragma unroll
            for (int m = 0; m < 4; ++m) { const int row = row0 + ai * 128 + m * 16;
                const float rstd = rsq_(sqv[ai][m] * (((PROBE) == 5 ? 0.5f : 1.f) / D) + EPS);
                float v[8];
#pragma unroll
                for (int e = 0; e < 4; ++e) { v[e] = siluf_(acc[ai][0][m][0][e] * rstd) * (acc[ai][1][m][0][e] * rstd); v[4 + e] = siluf_(acc[ai][0][m][1][e] * rstd) * (acc[ai][1][m][1][e] * rstd); }
                pg8::u32x4 w; w.x = cvtpk(v[0], v[1]); w.y = cvtpk(v[2], v[3]); w.z = cvtpk(v[4], v[5]); w.w = cvtpk(v[6], v[7]);
                *(pg8::u32x4*)(h + (size_t)row * FF + col0) = w; }
    }
};
struct EpiDown {
    static constexpr bool PERM = true, AFTER_DRAIN = false;
    float* out; const bf16* x1b; unsigned* guard; unsigned need; mutable bool checked;
    __device__ __forceinline__ void operator()(const pg8::f32x4 (&acc)[2][2][4][2], const pg8::Unit& u, int wr, int wc, int fr, int fq) const {
        const int row0 = u.pm * 256 + wr * 64 + fr, col0 = u.pn * 256 + wc * 32 + 8 * fq;
        pg8::u32x4 xw[2][4][2];
#pragma unroll
        for (int ai = 0; ai < 2; ++ai)
#pragma unroll
            for (int m = 0; m < 4; ++m)
#pragma unroll
                for (int bj = 0; bj < 2; ++bj) xw[ai][m][bj] = __builtin_nontemporal_load((const pg8::u32x4*)(x1b + (size_t)(row0 + ai * 128 + m * 16) * D + col0 + bj * 128));
        unsigned gv = checked ? need : xb_ld(guard);
        __builtin_amdgcn_sched_barrier(0);
        while (gv < need) { __builtin_amdgcn_s_sleep(2); gv = xb_ld(guard); }
        checked = true;
#pragma unroll
        for (int ai = 0; ai < 2; ++ai)
#pragma unroll
            for (int m = 0; m < 4; ++m) { float* orow = out + (size_t)(row0 + ai * 128 + m * 16) * D + col0;
#pragma unroll
                for (int bj = 0; bj < 2; ++bj) { const pg8::u32x4 x = xw[ai][m][bj];
                    pg8::f32x4 a0 = acc[ai][bj][m][0], a1 = acc[ai][bj][m][1];
                    a0[0] += bflo(x.x); a0[1] += bfhi(x.x); a0[2] += bflo(x.y); a0[3] += bfhi(x.y); a1[0] += bflo(x.z); a1[1] += bfhi(x.z); a1[2] += bflo(x.w); a1[3] += bfhi(x.w);
                    __builtin_nontemporal_store(a0, (pg8::f32x4*)(orow + bj * 128)); __builtin_nontemporal_store(a1, (pg8::f32x4*)(orow + bj * 128 + 4)); } }
    }
};

__device__ __forceinline__ float wave_sum(float v) { v = sum16_(v); v += __shfl_xor(v, 16); v += __shfl_xor(v, 32); return v; }
__device__ __forceinline__ void tr_load(float (&wv)[32], const float* W, int N, int item, int lane) {
    const int nblk = N / 32, kb = item / nblk, nb = item % nblk, k0 = 64 * kb, n0 = 32 * nb;
#pragma unroll
    for (int i = 0; i < 32; ++i) wv[i] = __builtin_nontemporal_load(W + (size_t)(k0 + 2 * i + (lane >> 5)) * N + n0 + (lane & 31));
}
template <int MODE, bool WT_ = false>
__device__ __forceinline__ void tr_finish(float (&wv)[32], int K, int N, bf16* WT, LAS float* scr, int item, int lane, const float* ksc = nullptr) {
    const int nblk = N / 32, kb = item / nblk, nb = item % nblk, k0 = 64 * kb, n0 = 32 * nb;
    if (ksc) {
#pragma unroll
        for (int i = 0; i < 32; ++i) wv[i] *= ksc[k0 + 2 * i + (lane >> 5)];
    }
#pragma unroll
    for (int i = 0; i < 32; ++i) scr[(2 * i + (lane >> 5)) * 33 + (lane & 31)] = wv[i];
    LDS_WAIT(); asm volatile("" ::: "memory");
    const int c = lane & 7;
    const int d0 = MODE == 0 ? n0 : (256 * (n0 / 128) + (n0 % 128) + (MODE == 2 ? 128 : 0));
#pragma unroll
    for (int j = 0; j < 4; ++j) { const int n = (lane >> 3) + 8 * j; const LAS float* s = scr + (8 * c) * 33 + n;
        v4u o; o.x = pk2(s[0 * 33], s[1 * 33]); o.y = pk2(s[2 * 33], s[3 * 33]); o.z = pk2(s[4 * 33], s[5 * 33]); o.w = pk2(s[6 * 33], s[7 * 33]);
        if constexpr (WT_) st16_wt(WT + (size_t)(d0 + n) * K + k0 + 8 * c, o); else *(v4u*)(WT + (size_t)(d0 + n) * K + k0 + 8 * c) = o; }
    LDS_WAIT(); asm volatile("" ::: "memory");
}
template <int NR>
__device__ __forceinline__ void rows_to_bf16_rstd(const float* const (&xrow)[NR], bf16* const (&orow)[NR], float* const (&rsp)[NR], int lane) {
    f32x4 v[NR][4];
#pragma unroll
    for (int r = 0; r < NR; ++r)
#pragma unroll
        for (int j = 0; j < 4; ++j) v[r][j] = __builtin_nontemporal_load((const f32x4*)xrow[r] + lane + 64 * j);
#pragma unroll
    for (int r = 0; r < NR; ++r) { float s = 0.f;
#pragma unroll
        for (int j = 0; j < 4; ++j) s += (v[r][j].x * v[r][j].x + v[r][j].y * v[r][j].y) + (v[r][j].z * v[r][j].z + v[r][j].w * v[r][j].w);
        const float rstd = rsq_(wave_sum(s) * (1.f / D) + EPS);
        if (lane == 0) *rsp[r] = rstd;
        unsigned long long* o8 = (unsigned long long*)orow[r] + lane;
#pragma unroll
        for (int j = 0; j < 4; ++j) o8[64 * j] = (unsigned long long)pk2(v[r][j].x, v[r][j].y) | ((unsigned long long)pk2(v[r][j].z, v[r][j].w) << 32); }
}

struct Args { const float* in[14]; float* out; unsigned char* ws; int ph_lo, ph_hi; };

#define LDS_BARRIER() do { asm volatile("s_waitcnt lgkmcnt(0)" ::: "memory"); __builtin_amdgcn_s_barrier(); asm volatile("" ::: "memory"); } while (0)
typedef short s16x8 __attribute__((ext_vector_type(8)));
typedef short s16x4 __attribute__((ext_vector_type(4)));
__device__ __forceinline__ s16x4 tr16(const LAS unsigned char* p) { return __builtin_bit_cast(s16x4, __builtin_amdgcn_ds_read_tr16_b64_v4i16((LAS s16x4*)p)); }
__device__ __forceinline__ s16x8 mk8(s16x4 a, s16x4 b) { s16x8 r; r[0] = a[0]; r[1] = a[1]; r[2] = a[2]; r[3] = a[3]; r[4] = b[0]; r[5] = b[1]; r[6] = b[2]; r[7] = b[3]; return r; }
__device__ __forceinline__ s16x8 mk8u(unsigned a, unsigned b, unsigned c, unsigned d) { v4u t; t.x = a; t.y = b; t.z = c; t.w = d; return __builtin_bit_cast(s16x8, t); }
constexpr int TP = 288, AP = 144, TPQ = 272;
#define SWZ3(row_, colbyte_) ((colbyte_) ^ ((((row_) >> 3) & 1) << 7))
constexpr int KTP = 144;
constexpr int HT_Q = 0, HT_G = 18432, HT_V = 36864, HT_QH = 55296, HT_KH = 73728, HT_A = 92160, HT_TOT = 101376, HT_DV = 105472, HT_V2 = 106496;
struct HGRegs { unsigned qw[8], gw[8]; v4u v0, v1; };
#define HG_LOAD(R_, cidx_) do { const size_t rb_ = hbase_ + (size_t)(s0 + 64 * (cidx_)) * 128; \
        _Pragma("unroll") for (int i_ = 0; i_ < 8; ++i_) { R_.qw[i_] = *(const unsigned*)(Hq + rb_ + (size_t)(8 * w + i_) * 128 + 2 * lane); R_.gw[i_] = *(const unsigned*)(Hg + rb_ + (size_t)(8 * w + i_) * 128 + 2 * lane); } \
        R_.v0 = *(const v4u*)(Hv + rb_ + (size_t)lr * 128 + lc * 8); R_.v1 = *(const v4u*)(Hv + rb_ + (size_t)(lr + 32) * 128 + lc * 8); } while (0)
template <int dir>
__device__ __forceinline__ void hgrn_step(LAS unsigned char* lds, const bf16* Hq, bf16* Hg, const bf16* Hv, bf16* Oo, int opitch, int s0, int cfirst, int nsteps, int head, int it, int dmode,
                                          HGRegs& R, f32x4 (&S)[8], float& bacc0, float& bacc1) {
    const int tid = threadIdx.x, lane = tid & 63, w = __builtin_amdgcn_readfirstlane(tid >> 6), h = lane >> 4, i16 = lane & 15, q4 = i16 >> 2, p4 = i16 & 3;
    LAS unsigned char* TQ = lds + HT_Q; LAS unsigned char* TG = lds + HT_G; LAS unsigned char* TV = lds + ((it & 1) ? HT_V2 : HT_V); LAS unsigned char* TQH = lds + HT_QH; LAS unsigned char* TKH = lds + HT_KH;
    LAS unsigned char* AM = lds + HT_A; LAS float* TOT = (LAS float*)(lds + HT_TOT); LAS float* DV = (LAS float*)(lds + HT_DV);
    const int lr = tid >> 4, lc = tid & 15;
    const size_t hbase_ = (size_t)head * ((size_t)M * 128);
    {
        const int cidx = dir ? cfirst - it : cfirst + it;
        *(LAS v4u*)(TV + lr * TP + SWZ3(lr, lc * 16)) = R.v0; *(LAS v4u*)(TV + (lr + 32) * TP + SWZ3(lr, lc * 16)) = R.v1;
        float glo[8], ghi[8], llo[8], lhi[8]; unsigned qws[8];
#pragma unroll
        for (int i = 0; i < 8; ++i) { glo[i] = bflo(R.gw[i]); ghi[i] = bfhi(R.gw[i]); qws[i] = R.qw[i]; }
        if (it + 1 < nsteps) { const int cn = dir ? cidx - 1 : cidx + 1; HG_LOAD(R, cn); }
        { float c0 = 0.f, c1 = 0.f;
          if (!dir) {
#pragma unroll
              for (int i = 0; i < 8; ++i) { c0 += glo[i]; c1 += ghi[i]; llo[i] = c0; lhi[i] = c1; }
          } else {
#pragma unroll
              for (int i = 7; i >= 0; --i) { c0 += glo[i]; c1 += ghi[i]; llo[i] = c0; lhi[i] = c1; }
          }
          *(LAS f32x2*)(TOT + w * 128 + 2 * lane) = (f32x2){c0, c1}; }
        LDS_BARRIER();
        if (!(dmode & 2)) {
            float offs0 = 0.f, offs1 = 0.f, ref0 = 0.f, ref1 = 0.f, all0 = 0.f, all1 = 0.f;
#pragma unroll
            for (int s = 0; s < 8; ++s) { const f32x2 tt = *(const LAS f32x2*)(TOT + s * 128 + 2 * lane); all0 += tt.x; all1 += tt.y;
                const float bo = (dir ? (s > w) : (s < w)) ? 1.f : 0.f;
                offs0 = __builtin_fmaf(bo, tt.x, offs0); offs1 = __builtin_fmaf(bo, tt.y, offs1);
                if (dir ? (s >= 4) : (s < 4)) { ref0 += tt.x; ref1 += tt.y; } }
            const float Er0 = ex2_(ref0), Er1 = ex2_(ref1), Ek0 = ex2_(all0 - ref0), Ek1 = ex2_(all1 - ref1);
            if (w == 0) *(LAS f32x2*)(DV + 2 * lane) = (f32x2){ex2_(all0), ex2_(all1)};
            const float Eg0 = Er0 * ex2_(bacc0), Eg1 = Er1 * ex2_(bacc1);
            bacc0 += all0; bacc1 += all1;
            float f0[8], f1[8], pre0[8], pre1[8];
#pragma unroll
            for (int i = 0; i < 8; ++i) { f0[i] = ex2_(glo[i]); f1[i] = ex2_(ghi[i]); }
            const float sg_ = dir ? -1.f : 1.f;
            float run0 = ex2_(fminf(sg_ * (offs0 + llo[0] - ref0), 115.f)), run1 = ex2_(fminf(sg_ * (offs1 + lhi[0] - ref1), 115.f));
            pre0[7] = ex2_(fminf(-sg_ * (offs0 + llo[7] - ref0), 115.f)); pre1[7] = ex2_(fminf(-sg_ * (offs1 + lhi[7] - ref1), 115.f));
#pragma unroll
            for (int i = 7; i > 0; --i) { pre0[i - 1] = pre0[i] * (dir ? f0[i - 1] : f0[i]); pre1[i - 1] = pre1[i] * (dir ? f1[i - 1] : f1[i]); }
            const int wv_ = tid >> 6;
            const int aq_ = HT_Q + (8 * wv_) * TP + lane * 4, aqh_ = HT_QH + (8 * wv_) * TPQ + lane * 4;
            v4u kh0_, kh1_; float kp0_ = 0.f, kp1_ = 0.f;
            bf16* gq_ = Hg + (size_t)head * ((size_t)M * 128) + (size_t)(s0 + 64 * cidx + 8 * wv_) * 128 + 2 * lane;
#pragma unroll
            for (int i = 0; i < 8; ++i) {
                const unsigned qw_ = qws[i]; const float q0 = bflo(qw_), q1 = bfhi(qw_);
                if (i > 0) { run0 *= dir ? f0[i - 1] : f0[i]; run1 *= dir ? f1[i - 1] : f1[i]; }
                const float e10 = dir ? pre0[i] : run0, e11 = dir ? pre1[i] : run1, e20 = dir ? run0 : pre0[i], e21 = dir ? run1 : pre1[i];
                const float k0 = 1.f - f0[i], k1 = 1.f - f1[i];
                const float qt0 = q0 * e10, qt1 = q1 * e11, kt0 = k0 * e20, kt1 = k1 * e21;
                *(LAS unsigned*)(lds + aq_ + i * TP) = cvtpk(qt0, qt1); *(LAS unsigned*)(lds + aq_ + (HT_G - HT_Q) + i * TP) = cvtpk(kt0, kt1);
                *(LAS unsigned*)(lds + aqh_ + i * TPQ) = cvtpk(qt0 * Er0, qt1 * Er1);
                if (i & 1) { kh0_[i >> 1] = cvtpk(kp0_, kt0 * Ek0); kh1_[i >> 1] = cvtpk(kp1_, kt1 * Ek1); } else { kp0_ = kt0 * Ek0; kp1_ = kt1 * Ek1; }
                if (!(dmode & 1)) *(unsigned*)(gq_ + i * 128) = cvtpk(qt0 * Eg0, qt1 * Eg1); }
            *(LAS v4u*)(lds + HT_KH + (2 * lane) * KTP + 16 * wv_) = kh0_; *(LAS v4u*)(lds + HT_KH + (2 * lane + 1) * KTP + 16 * wv_) = kh1_;
        }
        LDS_BARRIER();
        if (!(dmode & 4)) {
            const int I = w >> 1;
            s16x8 qf[4], kf[2][4];
#pragma unroll
            for (int ks = 0; ks < 4; ++ks) qf[ks] = *(const LAS s16x8*)(TQ + (16 * I + i16) * TP + (32 * ks + 8 * h) * 2);
#pragma unroll
            for (int jj = 0; jj < 2; ++jj)
#pragma unroll
                for (int ks = 0; ks < 4; ++ks) kf[jj][ks] = *(const LAS s16x8*)(TG + (16 * (2 * (w & 1) + jj) + i16) * TP + (32 * ks + 8 * h) * 2);
            __builtin_amdgcn_sched_barrier(0);
            f32x4 a2[2];
#pragma unroll
            for (int jj = 0; jj < 2; ++jj) { a2[jj] = (f32x4){0.f, 0.f, 0.f, 0.f};
#pragma unroll
                for (int ks = 0; ks < 4; ++ks) a2[jj] = __builtin_amdgcn_mfma_f32_16x16x32_bf16(kf[jj][ks], qf[ks], a2[jj], 0, 0, 0); }
#pragma unroll
            for (int jj = 0; jj < 2; ++jj) { const int J = 2 * (w & 1) + jj; const int t = 16 * I + i16, sb = 16 * J + 4 * h;
                float vv[4];
#pragma unroll
                for (int r = 0; r < 4; ++r) { const bool keep = dir ? (sb + r >= t) : (sb + r <= t); vv[r] = keep ? a2[jj][r] : 0.f; }
                *(LAS v2u*)(AM + t * AP + sb * 2) = (v2u){cvtpk(vv[0], vv[1]), cvtpk(vv[2], vv[3])}; }
        }
        LDS_BARRIER();
        if (!(dmode & 8)) {
            s16x8 sf[4], vf[2];
#pragma unroll
            for (int ks = 0; ks < 4; ++ks) sf[ks] = mk8u(cvtpk(S[2 * ks][0], S[2 * ks][1]), cvtpk(S[2 * ks][2], S[2 * ks][3]), cvtpk(S[2 * ks + 1][0], S[2 * ks + 1][1]), cvtpk(S[2 * ks + 1][2], S[2 * ks + 1][3]));
#pragma unroll
            for (int ks = 0; ks < 2; ++ks) vf[ks] = mk8(tr16(TV + (32 * ks + 8 * h + q4) * TP + SWZ3(8 * h, (16 * w + 4 * p4) * 2)), tr16(TV + (32 * ks + 8 * h + 4 + q4) * TP + SWZ3(8 * h, (16 * w + 4 * p4) * 2)));
            f32x4 oo[4];
#pragma unroll
            for (int ip = 0; ip < 2; ++ip) {
                s16x8 afr[2][2], qfr[2][4];
#pragma unroll
                for (int ii = 0; ii < 2; ++ii) { const int i = 2 * ip + ii;
#pragma unroll
                    for (int ks = 0; ks < 2; ++ks) afr[ii][ks] = *(const LAS s16x8*)(AM + (16 * i + i16) * AP + (32 * ks + 8 * h) * 2);
#pragma unroll
                    for (int ks = 0; ks < 4; ++ks) { const v2u lo = *(const LAS v2u*)(TQH + (16 * i + i16) * TPQ + (32 * ks + 4 * h) * 2), hi = *(const LAS v2u*)(TQH + (16 * i + i16) * TPQ + (32 * ks + 16 + 4 * h) * 2);
                        qfr[ii][ks] = mk8u(lo.x, lo.y, hi.x, hi.y); } }
                __builtin_amdgcn_sched_barrier(0);
#pragma unroll
                for (int ii = 0; ii < 2; ++ii) { f32x4 o = (f32x4){0.f, 0.f, 0.f, 0.f};
#pragma unroll
                    for (int ks = 0; ks < 2; ++ks) o = __builtin_amdgcn_mfma_f32_16x16x32_bf16(vf[ks], afr[ii][ks], o, 0, 0, 0);
#pragma unroll
                    for (int ks = 0; ks < 4; ++ks) o = __builtin_amdgcn_mfma_f32_16x16x32_bf16(sf[ks], qfr[ii][ks], o, 0, 0, 0);
                    oo[2 * ip + ii] = o; }
                __builtin_amdgcn_sched_barrier(0);
            }
            s16x8 kfr[8][2]; f32x4 d4[8];
#pragma unroll
            for (int T = 0; T < 8; ++T) { d4[T] = *(const LAS f32x4*)(DV + 16 * T + 4 * h);
#pragma unroll
                for (int ks = 0; ks < 2; ++ks) kfr[T][ks] = *(const LAS s16x8*)(TKH + (16 * T + i16) * KTP + (32 * ks + 8 * h) * 2); }
#pragma unroll
            for (int i = 0; i < 4; ++i) *(v2u*)(Oo + (size_t)(s0 + 64 * cidx + 16 * i + i16) * opitch + 16 * w + 4 * h) = (v2u){cvtpk(oo[i][0], oo[i][1]), cvtpk(oo[i][2], oo[i][3])};
            __builtin_amdgcn_sched_barrier(0);
#pragma unroll
            for (int T = 0; T < 8; ++T) { S[T] = S[T] * d4[T];
#pragma unroll
                for (int ks = 0; ks < 2; ++ks) S[T] = __builtin_amdgcn_mfma_f32_16x16x32_bf16(kfr[T][ks], vf[ks], S[T], 0, 0, 0); }
        }
        if (it + 1 == nsteps) LDS_BARRIER();
    }
}
template <int dir>
__device__ __forceinline__ void hgrn_chain(LAS unsigned char* lds, const bf16* Hq, bf16* Hg, const bf16* Hv, bf16* Oo, int opitch, int s0, int cfirst, int nsteps, int head, float* SLc, float* Btc, int dmode = 0) {
    const int tid = threadIdx.x, lane = tid & 63, w = __builtin_amdgcn_readfirstlane(tid >> 6);
    const int lr = tid >> 4, lc = tid & 15;
    const size_t hbase_ = (size_t)head * ((size_t)M * 128);
    HGRegs A;
    HG_LOAD(A, cfirst);
    f32x4 S[8];
#pragma unroll
    for (int T = 0; T < 8; ++T) S[T] = (f32x4){0.f, 0.f, 0.f, 0.f};
    float bacc0 = 0.f, bacc1 = 0.f;
    for (int it = 0; it < nsteps; ++it)
        hgrn_step<dir>(lds, Hq, Hg, Hv, Oo, opitch, s0, cfirst, nsteps, head, it, dmode, A, S, bacc0, bacc1);
#undef HG_LOAD
#pragma unroll
    for (int T = 0; T < 8; ++T) *(f32x4*)(SLc + ((w * 8 + T) * 64 + lane) * 4) = S[T];
    if (w == 0) *(f32x2*)(Btc + 2 * lane) = (f32x2){bacc0, bacc1};
}
constexpr int TQP = 272;
constexpr int H2_Q = 0, H2_G = 17408, H2_A = 34816, H2_TOT = 44032, H2_GRP = 48128, H2_GS = 54784;
constexpr int H2_OQH = 18432, H2_OKH = 35840, H2_ODV = 54272;
static_assert(H2_GRP + 2 * H2_GS <= (int)LDSCTL_OFF && H2_G + 64 * TQP <= H2_A && H2_A + 64 * AP <= H2_TOT && H2_TOT + 4096 <= H2_GRP && 64 * TP <= H2_OQH && H2_OQH + 64 * TPQ <= H2_OKH && H2_OKH + 128 * KTP <= H2_ODV && H2_ODV + 512 <= H2_GS, "chain LDS map");
struct HGElem { float b0a, b0b, b7a, b7b; };
template <int dir>
__device__ __forceinline__ void hg_scan(LAS unsigned char* lds, const unsigned (&gw)[8], HGElem& E, int w, int lane) {
    float glo[8], ghi[8];
#pragma unroll
    for (int i = 0; i < 8; ++i) { glo[i] = bflo(gw[i]); ghi[i] = bfhi(gw[i]); }
    float c0 = 0.f, c1 = 0.f;
    if (!dir) {
#pragma unroll
        for (int i = 0; i < 8; ++i) { c0 += glo[i]; c1 += ghi[i]; if (i == 0) { E.b0a = c0; E.b0b = c1; } if (i == 7) { E.b7a = c0; E.b7b = c1; } }
    } else {
#pragma unroll
        for (int i = 7; i >= 0; --i) { c0 += glo[i]; c1 += ghi[i]; if (i == 7) { E.b7a = c0; E.b7b = c1; } if (i == 0) { E.b0a = c0; E.b0b = c1; } }
    }
    *(LAS f32x2*)((LAS float*)(lds + H2_TOT) + w * 128 + 2 * lane) = (f32x2){c0, c1};
}
template <int dir>
__device__ __forceinline__ void hg_elem(LAS unsigned char* lds, const HGElem& E, const unsigned (&gw)[8], const unsigned (&qws)[8], v4u v0, v4u v1, int buf, bf16* gq_, float& bacc0, float& bacc1, int w, int lane, int tid) {
    LAS float* TOT = (LAS float*)(lds + H2_TOT);
    float f0[8], f1[8];
#pragma unroll
    for (int i = 0; i < 8; ++i) { f0[i] = ex2_(bflo(gw[i])); f1[i] = ex2_(bfhi(gw[i])); }
    const int lr = tid >> 4, lc = tid & 15;
    LAS unsigned char* GB = lds + H2_GRP + buf * H2_GS;
    LAS unsigned char* TV = GB;
    *(LAS v4u*)(TV + lr * TP + SWZ3(lr, lc * 16)) = v0; *(LAS v4u*)(TV + (lr + 32) * TP + SWZ3(lr, lc * 16)) = v1;
    float offs0 = 0.f, offs1 = 0.f, ref0 = 0.f, ref1 = 0.f, all0 = 0.f, all1 = 0.f;
#pragma unroll
    for (int s = 0; s < 8; ++s) { const f32x2 tt = *(const LAS f32x2*)(TOT + s * 128 + 2 * lane); all0 += tt.x; all1 += tt.y;
        const float bo = (dir ? (s > w) : (s < w)) ? 1.f : 0.f;
        offs0 = __builtin_fmaf(bo, tt.x, offs0); offs1 = __builtin_fmaf(bo, tt.y, offs1);
        if (dir ? (s >= 4) : (s < 4)) { ref0 += tt.x; ref1 += tt.y; } }
    const float Er0 = ex2_(ref0), Er1 = ex2_(ref1), Ek0 = ex2_(all0 - ref0), Ek1 = ex2_(all1 - ref1);
    if (w == 0) *(LAS f32x2*)((LAS float*)(GB + H2_ODV) + 2 * lane) = (f32x2){ex2_(all0), ex2_(all1)};
    const float Eg0 = Er0 * ex2_(bacc0), Eg1 = Er1 * ex2_(bacc1);
    bacc0 += all0; bacc1 += all1;
    float pre0[8], pre1[8];
    const float sg_ = dir ? -1.f : 1.f;
    float run0 = ex2_(fminf(sg_ * (offs0 + E.b0a - ref0), 115.f)), run1 = ex2_(fminf(sg_ * (offs1 + E.b0b - ref1), 115.f));
    pre0[7] = ex2_(fminf(-sg_ * (offs0 + E.b7a - ref0), 115.f)); pre1[7] = ex2_(fminf(-sg_ * (offs1 + E.b7b - ref1), 115.f));
#pragma unroll
    for (int i = 7; i > 0; --i) { pre0[i - 1] = pre0[i] * (dir ? f0[i - 1] : f0[i]); pre1[i - 1] = pre1[i] * (dir ? f1[i - 1] : f1[i]); }
    const int wv_ = tid >> 6;
    const int aq_ = H2_Q + (8 * wv_) * TQP + lane * 4, aqh_ = H2_GRP + buf * H2_GS + H2_OQH + (8 * wv_) * TPQ + lane * 4;
    v4u kh0_, kh1_; float kp0_ = 0.f, kp1_ = 0.f;
#pragma unroll
    for (int i = 0; i < 8; ++i) {
        const unsigned qw_ = qws[i]; const float q0 = bflo(qw_), q1 = bfhi(qw_);
        if (i > 0) { run0 *= dir ? f0[i - 1] : f0[i]; run1 *= dir ? f1[i - 1] : f1[i]; }
        const float e10 = dir ? pre0[i] : run0, e11 = dir ? pre1[i] : run1, e20 = dir ? run0 : pre0[i], e21 = dir ? run1 : pre1[i];
        const float k0 = 1.f - f0[i], k1 = 1.f - f1[i];
        const float qt0 = q0 * e10, qt1 = q1 * e11, kt0 = k0 * e20, kt1 = k1 * e21;
        *(LAS unsigned*)(lds + aq_ + i * TQP) = cvtpk(qt0, qt1); *(LAS unsigned*)(lds + aq_ + (H2_G - H2_Q) + i * TQP) = cvtpk(kt0, kt1);
        *(LAS unsigned*)(lds + aqh_ + i * TPQ) = cvtpk(qt0 * Er0, qt1 * Er1);
        if (i & 1) { kh0_[i >> 1] = cvtpk(kp0_, kt0 * Ek0); kh1_[i >> 1] = cvtpk(kp1_, kt1 * Ek1); } else { kp0_ = kt0 * Ek0; kp1_ = kt1 * Ek1; }
        *(unsigned*)(gq_ + i * 128) = cvtpk(qt0 * Eg0, qt1 * Eg1); }
    LAS unsigned char* TKH = GB + H2_OKH;
    *(LAS v4u*)(TKH + (2 * lane) * KTP + 16 * wv_) = kh0_; *(LAS v4u*)(TKH + (2 * lane + 1) * KTP + 16 * wv_) = kh1_;
}
template <int dir>
__device__ __forceinline__ void hgrn_chain2(LAS unsigned char* lds, const bf16* Hq, bf16* Hg, const bf16* Hv, bf16* Oo, int opitch, int s0, int cfirst, int nsteps, int head, float* SLc, float* Btc) {
    const int tid = threadIdx.x, lane = tid & 63, w = __builtin_amdgcn_readfirstlane(tid >> 6), h = lane >> 4, i16 = lane & 15, q4 = i16 >> 2, p4 = i16 & 3;
    const int lr = tid >> 4, lc = tid & 15, wv_ = tid >> 6;
    const size_t hbase_ = (size_t)head * ((size_t)M * 128);
    LAS unsigned char* TQ = lds + H2_Q; LAS unsigned char* TG = lds + H2_G; LAS unsigned char* AM = lds + H2_A;
#define H2_CIDX(k_) (dir ? cfirst - (k_) : cfirst + (k_))
#define H2_LOAD_G(k_) do { const size_t rb_ = hbase_ + (size_t)(s0 + 64 * H2_CIDX(k_)) * 128; \
        _Pragma("unroll") for (int i_ = 0; i_ < 8; ++i_) R.gw[i_] = *(const unsigned*)(Hg + rb_ + (size_t)(8 * w + i_) * 128 + 2 * lane); } while (0)
#define H2_LOAD_QV(k_) do { const size_t rb_ = hbase_ + (size_t)(s0 + 64 * H2_CIDX(k_)) * 128; \
        _Pragma("unroll") for (int i_ = 0; i_ < 8; ++i_) R.qw[i_] = *(const unsigned*)(Hq + rb_ + (size_t)(8 * w + i_) * 128 + 2 * lane); \
        R.v0 = *(const v4u*)(Hv + rb_ + (size_t)lr * 128 + lc * 8); R.v1 = *(const v4u*)(Hv + rb_ + (size_t)(lr + 32) * 128 + lc * 8); } while (0)
#define H2_GQ(k_) (Hg + hbase_ + (size_t)(s0 + 64 * H2_CIDX(k_) + 8 * wv_) * 128 + 2 * lane)
    HGRegs R; H2_LOAD_G(0); H2_LOAD_QV(0);
#define H2_LOAD(k_) do { H2_LOAD_G(k_); H2_LOAD_QV(k_); } while (0)
    f32x4 S[8];
#pragma unroll
    for (int T = 0; T < 8; ++T) S[T] = (f32x4){0.f, 0.f, 0.f, 0.f};
    float bacc0 = 0.f, bacc1 = 0.f;
    HGElem E;
    hg_scan<dir>(lds, R.gw, E, w, lane);
    LDS_BARRIER();
    hg_elem<dir>(lds, E, R.gw, R.qw, R.v0, R.v1, 0, H2_GQ(0), bacc0, bacc1, w, lane, tid);
    if (nsteps > 1) H2_LOAD(1);
    for (int it = 0; it < nsteps; ++it) {
        const int cidx = H2_CIDX(it), bsel = it & 1;
        const bool more = it + 1 < nsteps;
        LDS_BARRIER();
        {
            const int I = w >> 1;
            s16x8 qf[4], kf[2][4];
#pragma unroll
            for (int ks = 0; ks < 4; ++ks) qf[ks] = *(const LAS s16x8*)(TQ + (16 * I + i16) * TQP + (32 * ks + 8 * h) * 2);
#pragma unroll
            for (int jj = 0; jj < 2; ++jj)
#pragma unroll
                for (int ks = 0; ks < 4; ++ks) kf[jj][ks] = *(const LAS s16x8*)(TG + (16 * (2 * (w & 1) + jj) + i16) * TQP + (32 * ks + 8 * h) * 2);
            __builtin_amdgcn_sched_barrier(0);
            f32x4 a2[2];
#pragma unroll
            for (int jj = 0; jj < 2; ++jj) { a2[jj] = (f32x4){0.f, 0.f, 0.f, 0.f};
#pragma unroll
                for (int ks = 0; ks < 4; ++ks) a2[jj] = __builtin_amdgcn_mfma_f32_16x16x32_bf16(kf[jj][ks], qf[ks], a2[jj], 0, 0, 0); }
#pragma unroll
            for (int jj = 0; jj < 2; ++jj) { const int J = 2 * (w & 1) + jj; const int t = 16 * I + i16, sb = 16 * J + 4 * h;
                float vv[4];
#pragma unroll
                for (int r = 0; r < 4; ++r) { const bool keep = dir ? (sb + r >= t) : (sb + r <= t); vv[r] = keep ? a2[jj][r] : 0.f; }
                *(LAS v2u*)(AM + t * AP + sb * 2) = (v2u){cvtpk(vv[0], vv[1]), cvtpk(vv[2], vv[3])}; }
        }
        if (more) hg_scan<dir>(lds, R.gw, E, w, lane);
        LDS_BARRIER();
        if (more) { hg_elem<dir>(lds, E, R.gw, R.qw, R.v0, R.v1, bsel ^ 1, H2_GQ(it + 1), bacc0, bacc1, w, lane, tid); if (it + 2 < nsteps) H2_LOAD(it + 2); }
        {
            LAS unsigned char* GB = lds + H2_GRP + bsel * H2_GS;
            LAS unsigned char* TV = GB; LAS unsigned char* TQH = GB + H2_OQH; LAS unsigned char* TKH = GB + H2_OKH; LAS float* DV = (LAS float*)(GB + H2_ODV);
            s16x8 sf[4], vf[2];
#pragma unroll
            for (int ks = 0; ks < 4; ++ks) sf[ks] = mk8u(cvtpk(S[2 * ks][0], S[2 * ks][1]), cvtpk(S[2 * ks][2], S[2 * ks][3]), cvtpk(S[2 * ks + 1][0], S[2 * ks + 1][1]), cvtpk(S[2 * ks + 1][2], S[2 * ks + 1][3]));
#pragma unroll
            for (int ks = 0; ks < 2; ++ks) vf[ks] = mk8(tr16(TV + (32 * ks + 8 * h + q4) * TP + SWZ3(8 * h, (16 * w + 4 * p4) * 2)), tr16(TV + (32 * ks + 8 * h + 4 + q4) * TP + SWZ3(8 * h, (16 * w + 4 * p4) * 2)));
            f32x4 oo[4];
            {
                s16x8 afr[4][2], qfr[4][4];
#pragma unroll
                for (int i = 0; i < 4; ++i) {
#pragma unroll
                    for (int ks = 0; ks < 2; ++ks) afr[i][ks] = *(const LAS s16x8*)(AM + (16 * i + i16) * AP + (32 * ks + 8 * h) * 2);
#pragma unroll
                    for (int ks = 0; ks < 4; ++ks) { const v2u lo = *(const LAS v2u*)(TQH + (16 * i + i16) * TPQ + (32 * ks + 4 * h) * 2), hi = *(const LAS v2u*)(TQH + (16 * i + i16) * TPQ + (32 * ks + 16 + 4 * h) * 2);
                        qfr[i][ks] = mk8u(lo.x, lo.y, hi.x, hi.y); } }
                __builtin_amdgcn_sched_barrier(0);
#pragma unroll
                for (int i = 0; i < 4; ++i) oo[i] = (f32x4){0.f, 0.f, 0.f, 0.f};
#pragma unroll
                for (int ks = 0; ks < 2; ++ks)
#pragma unroll
                    for (int i = 0; i < 4; ++i) oo[i] = __builtin_amdgcn_mfma_f32_16x16x32_bf16(vf[ks], afr[i][ks], oo[i], 0, 0, 0);
#pragma unroll
                for (int ks = 0; ks < 4; ++ks)
#pragma unroll
                    for (int i = 0; i < 4; ++i) oo[i] = __builtin_amdgcn_mfma_f32_16x16x32_bf16(sf[ks], qfr[i][ks], oo[i], 0, 0, 0);
                __builtin_amdgcn_sched_barrier(0);
            }
            s16x8 kfr[8][2]; f32x4 d4[8];
#pragma unroll
            for (int T = 0; T < 8; ++T) { d4[T] = *(const LAS f32x4*)(DV + 16 * T + 4 * h);
#pragma unroll
                for (int ks = 0; ks < 2; ++ks) kfr[T][ks] = *(const LAS s16x8*)(TKH + (16 * T + i16) * KTP + (32 * ks + 8 * h) * 2); }
#pragma unroll
            for (int i = 0; i < 4; ++i) *(v2u*)(Oo + (size_t)(s0 + 64 * cidx + 16 * i + i16) * opitch + 16 * w + 4 * h) = (v2u){cvtpk(oo[i][0], oo[i][1]), cvtpk(oo[i][2], oo[i][3])};
            __builtin_amdgcn_sched_barrier(0);
#pragma unroll
            for (int T = 0; T < 8; ++T) { S[T] = S[T] * d4[T];
#pragma unroll
                for (int ks = 0; ks < 2; ++ks) S[T] = __builtin_amdgcn_mfma_f32_16x16x32_bf16(kfr[T][ks], vf[ks], S[T], 0, 0, 0); }
        }
    }
    LDS_BARRIER();
#undef H2_CIDX
#undef H2_LOAD_G
#undef H2_LOAD_QV
#undef H2_LOAD
#undef H2_GQ
#pragma unroll
    for (int T = 0; T < 8; ++T) *(f32x4*)(SLc + ((w * 8 + T) * 64 + lane) * 4) = S[T];
    if (w == 0) *(f32x2*)(Btc + 2 * lane) = (f32x2){bacc0, bacc1};
}
__device__ __forceinline__ void hgrn_scan(const float* SL, const float* Bt, v4u* SF, int gid, int nthreads, int own_x = -1) {
    for (int item = gid; item < 48 * 2048; item += nthreads) {
        const int g = item >> 11, e = item & 2047, seq = g >> 3, head = (g >> 1) & 3, dir = g & 1;
        const int ns = seq < 4 ? 4 : 8, sgbase = seq < 4 ? seq * 4 : 16 + (seq - 4) * 8;
        const int wq = e >> 8, ks = (e >> 6) & 3, ln = e & 63, dk0 = 32 * ks + 4 * (ln >> 4);
        f32x4 ta[8], tb[8], ba[8], bb[8];
#pragma unroll
        for (int jj = 0; jj < 8; ++jj) if (jj < ns) { const int j = dir ? ns - 1 - jj : jj; const int ch = ((sgbase + j) << 3) | (head << 1) | dir;
            const f32x4* p = (const f32x4*)(SL + (size_t)ch * 16384) + (wq * 8 + 2 * ks) * 64 + ln;
            ta[jj] = p[0]; tb[jj] = p[64]; ba[jj] = *(const f32x4*)(Bt + ch * 128 + dk0); bb[jj] = *(const f32x4*)(Bt + ch * 128 + dk0 + 16); }
        f32x4 ca = (f32x4){0.f, 0.f, 0.f, 0.f}, cb = ca;
#pragma unroll
        for (int jj = 0; jj < 8; ++jj) if (jj < ns) { const int j = dir ? ns - 1 - jj : jj; const int ch = ((sgbase + j) << 3) | (head << 1) | dir;
            v4u fr; fr.x = cvtpk(ca.x, ca.y); fr.y = cvtpk(ca.z, ca.w); fr.z = cvtpk(cb.x, cb.y); fr.w = cvtpk(cb.z, cb.w);
            if (own_x < 0 || ((sgbase + j) >> 2) == own_x) SF[(size_t)ch * 2048 + e] = fr;
            ca.x = ex2_(ba[jj].x) * ca.x + ta[jj].x; ca.y = ex2_(ba[jj].y) * ca.y + ta[jj].y; ca.z = ex2_(ba[jj].z) * ca.z + ta[jj].z; ca.w = ex2_(ba[jj].w) * ca.w + ta[jj].w;
            cb.x = ex2_(bb[jj].x) * cb.x + tb[jj].x; cb.y = ex2_(bb[jj].y) * cb.y + tb[jj].y; cb.z = ex2_(bb[jj].z) * cb.z + tb[jj].z; cb.w = ex2_(bb[jj].w) * cb.w + tb[jj].w; }
    }
}
constexpr int P2_QF = 0, P2_QB = 18432, P2_BUF = 36864, P2_OC = 73728, P2_OCP = 528;
__device__ __forceinline__ void hgrn_pass2(LAS unsigned char* lds, const bf16* Hqf, const bf16* Hqb, const bf16* Hgate, const float* gnw, const v4u* SF, const bf16* O, bf16* Ow, int opw, const bf16* OBk,
                                           int s0, int seg, int sg, int head, int half, int mode = 0) {
    const int tid = threadIdx.x, lane = tid & 63, w = __builtin_amdgcn_readfirstlane(tid >> 6), h = lane >> 4, i16 = lane & 15;
    const int ti = w >> 1, dh = w & 1;
    const int chf = (sg << 3) | (head << 1), chb = chf | 1;
    s16x8 sfF[4][4], sfB[4][4];
#pragma unroll
    for (int n = 0; n < 4; ++n)
#pragma unroll
        for (int ks = 0; ks < 4; ++ks) { const size_t fo = (size_t)((4 * dh + n) * 4 + ks) * 64 + lane;
            sfF[n][ks] = __builtin_bit_cast(s16x8, SF[(size_t)chf * 2048 + fo]); sfB[n][ks] = __builtin_bit_cast(s16x8, SF[(size_t)chb * 2048 + fo]); }
    const int lr = tid >> 4, lc = tid & 15; const size_t gcol = (size_t)head * 128 + lc * 8, hcol = (size_t)head * ((size_t)M * 128) + lc * 8;
    LAS unsigned char* OC = lds + P2_OC;
    v4u pa0, pa1, pb0, pb1, rf0, rf1, rb0, rb1, rg0, rg1;
#define P2_LOAD(cidx_) do { const size_t o0_ = (size_t)(s0 + 64 * (cidx_) + lr) * 128 + hcol, o1_ = o0_ + (size_t)32 * 128; \
        pa0 = __builtin_nontemporal_load((const v4u*)(Hqf + o0_)); pa1 = __builtin_nontemporal_load((const v4u*)(Hqf + o1_)); pb0 = __builtin_nontemporal_load((const v4u*)(Hqb + o0_)); pb1 = __builtin_nontemporal_load((const v4u*)(Hqb + o1_)); } while (0)
#define P2_LOADR(cidx_) do { const size_t r0_ = (size_t)(s0 + 64 * (cidx_) + lr), r1_ = r0_ + 32; \
        rf0 = __builtin_nontemporal_load((const v4u*)(O + r0_ * D + gcol)); rf1 = __builtin_nontemporal_load((const v4u*)(O + r1_ * D + gcol)); rb0 = __builtin_nontemporal_load((const v4u*)(OBk + r0_ * 128 + hcol)); rb1 = __builtin_nontemporal_load((const v4u*)(OBk + r1_ * 128 + hcol)); \
        rg0 = __builtin_nontemporal_load((const v4u*)(Hgate + r0_ * 128 + hcol)); rg1 = __builtin_nontemporal_load((const v4u*)(Hgate + r1_ * 128 + hcol)); } while (0)
    P2_LOAD(16 * seg + 8 * half); P2_LOADR(16 * seg + 8 * half);
    for (int u = 0; u < 8; ++u) {
        const int cidx = 16 * seg + 8 * half + u;
        LAS unsigned char* TQF = lds + (u & 1) * P2_BUF + P2_QF; LAS unsigned char* TQB = lds + (u & 1) * P2_BUF + P2_QB;
        *(LAS v4u*)(TQF + lr * TPQ + lc * 16) = pa0; *(LAS v4u*)(TQF + (lr + 32) * TPQ + lc * 16) = pa1;
        *(LAS v4u*)(TQB + lr * TPQ + lc * 16) = pb0; *(LAS v4u*)(TQB + (lr + 32) * TPQ + lc * 16) = pb1;
        if (u + 1 < 8 && mode != 1) P2_LOAD(cidx + 1);
        LDS_BARRIER();
        if (mode != 2) {
            s16x8 ff[4], fb[4];
#pragma unroll
            for (int ks = 0; ks < 4; ++ks) { const int ro = (16 * ti + i16) * TPQ + (32 * ks + 4 * h) * 2;
                const v2u lo = *(const LAS v2u*)(TQF + ro), hi = *(const LAS v2u*)(TQF + ro + 32), lo2 = *(const LAS v2u*)(TQB + ro), hi2 = *(const LAS v2u*)(TQB + ro + 32);
                ff[ks] = mk8u(lo.x, lo.y, hi.x, hi.y); fb[ks] = mk8u(lo2.x, lo2.y, hi2.x, hi2.y); }
            __builtin_amdgcn_sched_barrier(0);
#pragma unroll
            for (int n = 0; n < 4; ++n) { f32x4 o = (f32x4){0.f, 0.f, 0.f, 0.f};
#pragma unroll
                for (int ks = 0; ks < 4; ++ks) { o = __builtin_amdgcn_mfma_f32_16x16x32_bf16(sfF[n][ks], ff[ks], o, 0, 0, 0); o = __builtin_amdgcn_mfma_f32_16x16x32_bf16(sfB[n][ks], fb[ks], o, 0, 0, 0); }
                *(LAS f32x4*)(OC + (16 * ti + i16) * P2_OCP + (16 * (4 * dh + n) + 4 * h) * 4) = o; }
            __builtin_amdgcn_sched_barrier(0);
        }
        LDS_BARRIER();
        {
            const v4u f0 = rf0, f1 = rf1, b0 = rb0, b1 = rb1, g0 = rg0, g1 = rg1;
            const f32x4 gn0 = *(const f32x4*)(gnw + 8 * lc), gn1 = *(const f32x4*)(gnw + 8 * lc + 4);
            if (u + 1 < 8 && mode != 1) P2_LOADR(cidx + 1);
#pragma unroll
            for (int rr = 0; rr < 2; ++rr) { const int row = lr + 32 * rr; const v4u fw = rr ? f1 : f0, bw = rr ? b1 : b0, gw_ = rr ? g1 : g0;
                const f32x4 c0_ = *(const LAS f32x4*)(OC + row * P2_OCP + lc * 32), c1_ = *(const LAS f32x4*)(OC + row * P2_OCP + lc * 32 + 16);
                float o[8];
                o[0] = c0_.x + bflo(fw.x) + bflo(bw.x); o[1] = c0_.y + bfhi(fw.x) + bfhi(bw.x); o[2] = c0_.z + bflo(fw.y) + bflo(bw.y); o[3] = c0_.w + bfhi(fw.y) + bfhi(bw.y);
                o[4] = c1_.x + bflo(fw.z) + bflo(bw.z); o[5] = c1_.y + bfhi(fw.z) + bfhi(bw.z); o[6] = c1_.z + bflo(fw.w) + bflo(bw.w); o[7] = c1_.w + bfhi(fw.w) + bfhi(bw.w);
                float sq = (o[0] * o[0] + o[1] * o[1]) + (o[2] * o[2] + o[3] * o[3]) + (o[4] * o[4] + o[5] * o[5]) + (o[6] * o[6] + o[7] * o[7]);
                sq = sum16_(sq);
                const float r = rsq_(sq * (1.f / 128.f) + EPS);
                v4u ov; ov.x = cvtpk(o[0] * r * gn0.x * bflo(gw_.x), o[1] * r * gn0.y * bfhi(gw_.x)); ov.y = cvtpk(o[2] * r * gn0.z * bflo(gw_.y), o[3] * r * gn0.w * bfhi(gw_.y));
                ov.z = cvtpk(o[4] * r * gn1.x * bflo(gw_.z), o[5] * r * gn1.y * bfhi(gw_.z)); ov.w = cvtpk(o[6] * r * gn1.z * bflo(gw_.w), o[7] * r * gn1.w * bfhi(gw_.w));
                *(v4u*)(Ow + (size_t)(s0 + 64 * cidx + row) * opw + gcol) = ov; }
        }
    }
    LDS_BARRIER();
#undef P2_LOAD
#undef P2_LOADR
}
constexpr int NKP = 128, NROWB = 64 * NKP, NA_K = 0, NA_V = 9 * NROWB, NA_RPB = 18 * NROWB;
#define NA_KOFF(key_, chunk_) ((key_) * NKP + 16 * ((chunk_) ^ (((key_) >> 1) & 7)))
#define NA_VOFF(key_, unit_) ((key_) * NKP + 8 * ((unit_) ^ (4 * (((key_) >> 1) & 3))))
static_assert(NA_RPB + 480 * 4 <= LDSCTL_OFF, "NA LDS map");
__device__ __forceinline__ void na_store_krow(LAS unsigned char* KR, int row, int key, int c, v4u kr, const float* kw) {
    float x[8]; x[0] = bflo(kr.x); x[1] = bfhi(kr.x); x[2] = bflo(kr.y); x[3] = bfhi(kr.y); x[4] = bflo(kr.z); x[5] = bfhi(kr.z); x[6] = bflo(kr.w); x[7] = bfhi(kr.w);
    float ss = 0.f;
#pragma unroll
    for (int e = 0; e < 8; ++e) ss += x[e] * x[e];
    ss = sum8_(ss);
    const float sc = rsq_(ss * (1.f / 64.f) + EPS);
    const f32x4 w0 = *(const f32x4*)(kw + c * 8), w1 = *(const f32x4*)(kw + c * 8 + 4);
    v4u o; o.x = cvtpk(x[0] * sc * w0.x, x[1] * sc * w0.y); o.y = cvtpk(x[2] * sc * w0.z, x[3] * sc * w0.w); o.z = cvtpk(x[4] * sc * w1.x, x[5] * sc * w1.y); o.w = cvtpk(x[6] * sc * w1.z, x[7] * sc * w1.w);
    *(LAS v4u*)(KR + (row % 9) * NROWB + NA_KOFF(key, c)) = o;
}
__device__ __forceinline__ v4u na_norm_krow(int c, v4u kr, const float* kw) {
    float x[8]; x[0] = bflo(kr.x); x[1] = bfhi(kr.x); x[2] = bflo(kr.y); x[3] = bfhi(kr.y); x[4] = bflo(kr.z); x[5] = bfhi(kr.z); x[6] = bflo(kr.w); x[7] = bfhi(kr.w);
    float ss = 0.f;
#pragma unroll
    for (int e = 0; e < 8; ++e) ss += x[e] * x[e];
    ss = sum8_(ss);
    const float sc = rsq_(ss * (1.f / 64.f) + EPS);
    const f32x4 w0 = *(const f32x4*)(kw + c * 8), w1 = *(const f32x4*)(kw + c * 8 + 4);
    v4u o; o.x = cvtpk(x[0] * sc * w0.x, x[1] * sc * w0.y); o.y = cvtpk(x[2] * sc * w0.z, x[3] * sc * w0.w); o.z = cvtpk(x[4] * sc * w1.x, x[5] * sc * w1.y); o.w = cvtpk(x[6] * sc * w1.z, x[7] * sc * w1.w);
    return o;
}
__device__ __forceinline__ void na_put_krow(LAS unsigned char* KR, int row, int key, int c, v4u o) { *(LAS v4u*)(KR + (row % 9) * NROWB + NA_KOFF(key, c)) = o; }
__device__ __forceinline__ void na_store_vrow(LAS unsigned char* VR, int row, int key, int c, v4u vr) {
    *(LAS v4u*)(VR + (row % 9) * NROWB + NA_VOFF(key, 2 * c)) = vr;
}
__device__ __forceinline__ void na_qfrag(s16x8 (&qf)[2], v4u a, v4u b, const float* qw, int h) {
    float x[16]; x[0] = bflo(a.x); x[1] = bfhi(a.x); x[2] = bflo(a.y); x[3] = bfhi(a.y); x[4] = bflo(a.z); x[5] = bfhi(a.z); x[6] = bflo(a.w); x[7] = bfhi(a.w);
    x[8] = bflo(b.x); x[9] = bfhi(b.x); x[10] = bflo(b.y); x[11] = bfhi(b.y); x[12] = bflo(b.z); x[13] = bfhi(b.z); x[14] = bflo(b.w); x[15] = bfhi(b.w);
    float ss = 0.f;
#pragma unroll
    for (int e = 0; e < 16; ++e) ss += x[e] * x[e];
    ss += __shfl_xor(ss, 16); ss += __shfl_xor(ss, 32);
    const float sc = (0.125f * 1.44269504089f) * rsq_(ss * (1.f / 64.f) + EPS);
    const f32x4 wa0 = *(const f32x4*)(qw + 8 * h), wa1 = *(const f32x4*)(qw + 8 * h + 4), wb0 = *(const f32x4*)(qw + 32 + 8 * h), wb1 = *(const f32x4*)(qw + 32 + 8 * h + 4);
    qf[0] = mk8u(cvtpk(x[0] * sc * wa0.x, x[1] * sc * wa0.y), cvtpk(x[2] * sc * wa0.z, x[3] * sc * wa0.w), cvtpk(x[4] * sc * wa1.x, x[5] * sc * wa1.y), cvtpk(x[6] * sc * wa1.z, x[7] * sc * wa1.w));
    qf[1] = mk8u(cvtpk(x[8] * sc * wb0.x, x[9] * sc * wb0.y), cvtpk(x[10] * sc * wb0.z, x[11] * sc * wb0.w), cvtpk(x[12] * sc * wb1.x, x[13] * sc * wb1.y), cvtpk(x[14] * sc * wb1.z, x[15] * sc * wb1.w));
}
__device__ __forceinline__ void na_run(LAS unsigned char* lds, const bf16* NQ, const bf16* NK, const bf16* NV, const float* qw, const float* kw, const float* rpb, bf16* O, int s0, int rows, int head, int r0, int nr) {
    const int tid = threadIdx.x, lane = tid & 63, w = __builtin_amdgcn_readfirstlane(tid >> 6), h = lane >> 4, i16 = lane & 15, q4 = i16 >> 2, p4 = i16 & 3;
    LAS unsigned char* KR = lds + NA_K; LAS unsigned char* VR = lds + NA_V; LAS float* RB = (LAS float*)(lds + NA_RPB);
    for (int i = tid; i < 480; i += NWAVES * 64) { const int rw = i >> 5, cl = i & 31; RB[i] = cl < 31 ? rpb[head * 465 + rw * 31 + cl] * 1.44269504089f : -1e30f; }
    const int lkey = tid >> 3, lc = tid & 7; const size_t hbase = (size_t)head * ((size_t)M * 64);
    const int rr = w >> 2, j = w & 3, qcol = 16 * j + i16, bs = min(max(16 * j - 8, 0), 32), wsn = min(max(qcol - 8, 0), 48);
    {
        const int rs0 = min(max(r0 - 4, 0), rows - 8), hi0 = min(max(r0 - 3, 0), rows - 8) + 7; v4u kk[9], vv[9];
#pragma unroll
        for (int k = 0; k < 9; ++k) { const int row = min(rs0 + k, hi0); const size_t go = hbase + (size_t)(s0 + row * 64 + lkey) * 64 + lc * 8; kk[k] = *(const v4u*)(NK + go); vv[k] = *(const v4u*)(NV + go); }
#pragma unroll
        for (int k = 0; k < 9; ++k) { const int row = min(rs0 + k, hi0); na_store_krow(KR, row, lkey, lc, kk[k], kw); na_store_vrow(VR, row, lkey, lc, vv[k]); }
    }
    v4u qa, qb;
    { const size_t qrow = (size_t)(s0 + (r0 + rr) * 64 + qcol); qa = *(const v4u*)(NQ + hbase + qrow * 64 + 8 * h); qb = *(const v4u*)(NQ + hbase + qrow * 64 + 32 + 8 * h); }
    s16x8 qf[2]; na_qfrag(qf, qa, qb, qw, h);
    for (int st = 0; st < nr; st += 2) {
        const int r = r0 + st + rr, rs = min(max(r - 4, 0), rows - 8);
        const bool more = st + 2 < nr;
        const int hic = min(max(r0 + st - 3, 0), rows - 8) + 7, hin = min(max(r0 + st - 1, 0), rows - 8) + 7;
        const int nrA = min(hic + 1, hin), nrB = min(hic + 2, hin);
        const bool ldA = more && (hic + 1 <= hin), ldB = more && (hic + 2 <= hin);
        LDS_BARRIER();
        v4u nkA, nvA, nkB, nvB;
        if (ldA) { const size_t go = hbase + (size_t)(s0 + nrA * 64 + lkey) * 64 + lc * 8; nkA = *(const v4u*)(NK + go); nvA = *(const v4u*)(NV + go); }
        if (ldB) { const size_t go = hbase + (size_t)(s0 + nrB * 64 + lkey) * 64 + lc * 8; nkB = *(const v4u*)(NK + go); nvB = *(const v4u*)(NV + go); }
        const size_t qrow = (size_t)(s0 + r * 64 + qcol);
        if (more) { const size_t qn = qrow + 128; qa = *(const v4u*)(NQ + hbase + qn * 64 + 8 * h); qb = *(const v4u*)(NQ + hbase + qn * 64 + 32 + 8 * h); }
        {
            int dci[2][4];
#pragma unroll
            for (int ch = 0; ch < 2; ++ch)
#pragma unroll
                for (int rg = 0; rg < 4; ++rg) { const int kcol = bs + 16 * ch + 4 * h + rg; dci[ch][rg] = ((kcol >= wsn) && (kcol < wsn + 16)) ? kcol - qcol + 15 : 31; }
            const LAS float* rbp[2][4];
#pragma unroll
            for (int ch = 0; ch < 2; ++ch)
#pragma unroll
                for (int rg = 0; rg < 4; ++rg) rbp[ch][rg] = RB + (rs - r + 7) * 32 + dci[ch][rg];
            const s16x8 ones = {0x3F80, 0x3F80, 0x3F80, 0x3F80, 0x3F80, 0x3F80, 0x3F80, 0x3F80};
            f32x4 ls = (f32x4){0.f, 0.f, 0.f, 0.f}; s16x8 pf[8];
            float bv[2][2][2][4]; s16x8 kf[2][2][2][2];
#define NA_LOADK(B_, KP_) do { _Pragma("unroll") for (int k2 = 0; k2 < 2; ++k2) { const int kr_ = 2 * (KP_) + k2; const int slot_ = (rs + kr_) % 9; \
                _Pragma("unroll") for (int ch = 0; ch < 2; ++ch) { \
                    _Pragma("unroll") for (int rg = 0; rg < 4; ++rg) bv[B_][k2][ch][rg] = rbp[ch][rg][kr_ * 32]; \
                    _Pragma("unroll") for (int ks = 0; ks < 2; ++ks) { kf[B_][k2][ch][ks] = *(const LAS s16x8*)(KR + slot_ * NROWB + NA_KOFF(bs + 16 * ch + i16, 4 * ks + h)); } } } } while (0)
            NA_LOADK(0, 0);
#pragma unroll
            for (int kp = 0; kp < 4; ++kp) {
                if (kp < 3) NA_LOADK((kp + 1) & 1, kp + 1);
                __builtin_amdgcn_sched_barrier(0);
#pragma unroll
                for (int k2 = 0; k2 < 2; ++k2) { const int kr = 2 * kp + k2; float pp[2][4];
#pragma unroll
                    for (int ch = 0; ch < 2; ++ch) { f32x4 a = (f32x4){bv[kp & 1][k2][ch][0], bv[kp & 1][k2][ch][1], bv[kp & 1][k2][ch][2], bv[kp & 1][k2][ch][3]};
#pragma unroll
                        for (int ks = 0; ks < 2; ++ks) a = __builtin_amdgcn_mfma_f32_16x16x32_bf16(kf[kp & 1][k2][ch][ks], qf[ks], a, 0, 0, 0);
#pragma unroll
                        for (int rg = 0; rg < 4; ++rg) pp[ch][rg] = ex2_(a[rg]); }
                    pf[kr] = mk8u(cvtpk(pp[0][0], pp[0][1]), cvtpk(pp[0][2], pp[0][3]), cvtpk(pp[1][0], pp[1][1]), cvtpk(pp[1][2], pp[1][3]));
                    ls = __builtin_amdgcn_mfma_f32_16x16x32_bf16(ones, pf[kr], ls, 0, 0, 0); }
                __builtin_amdgcn_sched_barrier(0);
            }
#undef NA_LOADK
            const float il = rcp_(ls[0]);
            s16x8 vfr[2][8];
#define NA_LOADV(B_, N_) do { _Pragma("unroll") for (int kr = 0; kr < 8; ++kr) { const int slot_ = (rs + kr) % 9; \
                vfr[B_][kr] = mk8(tr16(VR + slot_ * NROWB + NA_VOFF(bs + 4 * h + q4, 4 * (N_) + p4)), tr16(VR + slot_ * NROWB + NA_VOFF(bs + 16 + 4 * h + q4, 4 * (N_) + p4))); } } while (0)
            NA_LOADV(0, 0);
#pragma unroll
            for (int n = 0; n < 4; ++n) {
                if (n < 3) NA_LOADV((n + 1) & 1, n + 1);
                __builtin_amdgcn_sched_barrier(0);
                f32x4 o = (f32x4){0.f, 0.f, 0.f, 0.f};
#pragma unroll
                for (int kr = 0; kr < 8; ++kr) o = __builtin_amdgcn_mfma_f32_16x16x32_bf16(vfr[n & 1][kr], pf[kr], o, 0, 0, 0);
                *(v2u*)(O + qrow * D + GW + head * 64 + 16 * n + 4 * h) = (v2u){cvtpk(o[0] * il, o[1] * il), cvtpk(o[2] * il, o[3] * il)};
                __builtin_amdgcn_sched_barrier(0);
            }
#undef NA_LOADV
        }
        if (ldA) nkA = na_norm_krow(lc, nkA, kw);
        if (ldB) nkB = na_norm_krow(lc, nkB, kw);
        if (more) na_qfrag(qf, qa, qb, qw, h);
        LDS_BARRIER();
        if (ldA) { na_put_krow(KR, nrA, lkey, lc, nkA); na_store_vrow(VR, nrA, lkey, lc, nvA); }
        if (ldB) { na_put_krow(KR, nrB, lkey, lc, nkB); na_store_vrow(VR, nrB, lkey, lc, nvB); }
    }
    LDS_BARRIER();
}
constexpr int N_PHASES = 8;
#define REP(k) for (int rep_ = 0; rep_ < ((PROBE) == (k) ? 2 : 1); ++rep_)
__global__ void __launch_bounds__(NWAVES * 64, 2) fwd_kernel(Args args) {
    extern __shared__ __attribute__((aligned(16))) unsigned char lds_raw[];
    LAS unsigned char* lds = (LAS unsigned char*)lds_raw;
    volatile LAS unsigned* MISC = (volatile LAS unsigned*)(lds + MISC_OFF);
    const int tid = threadIdx.x, lane = tid & 63, wave = __builtin_amdgcn_readfirstlane(tid >> 6);
    const int G = gridDim.x; const int bx = blockIdx.x; const int vcu = (G % 8 == 0) ? (bx % 8) * (G / 8) + bx / 8 : bx;
    unsigned char* ws = args.ws;
    unsigned* ctl = (unsigned*)(ws + WS_CTL);
    const float* xp = args.in[0]; const float* xs = args.in[1]; const float* w_mix = args.in[2]; const float* w_in = args.in[3]; const float* lbp = args.in[4];
    const float* gnw = args.in[5]; const float* qnw = args.in[6]; const float* knw = args.in[7]; const float* rpb = args.in[8]; const float* w_out = args.in[9];
    const float* w_ffn = args.in[10]; const float* w_gate = args.in[11]; const float* w_up = args.in[12]; const float* w_down = args.in[13];
    float* out = args.out;
    bf16* Wgu_t = (bf16*)(ws + WS_WGU); bf16* Win_t = (bf16*)(ws + WS_WIN); bf16* Wout_t = (bf16*)(ws + WS_WOUT); bf16* Wdown_t = (bf16*)(ws + WS_WDOWN);
    bf16* XN = (bf16*)(ws + WS_A); bf16* OBk = (bf16*)out + 3 * (size_t)M * GW; bf16* Hb = (bf16*)(ws + WS_H); bf16* Ob = (bf16*)(ws + WS_O);
    bf16* X1b = (bf16*)(ws + WS_X1); bf16* HFF = (bf16*)(ws + WS_HFF); bf16* NAb = (bf16*)out; float* ssq = (float*)(ctl + CW_SSQ); float* SLb = (float*)(ws + WS_SL); float* Btb = (float*)(ctl + CW_BT);
    v4u* SFb = (v4u*)(ws + WS_SF);
    { int t0_ = tid; asm volatile("" : "+v"(t0_));
      for (int u = t0_; u < (LDS_BYTES - LDSCTL_OFF) / 4; u += NWAVES * 64) ((LAS unsigned*)(lds + LDSCTL_OFF))[u] = 0u; }
    __syncthreads();
    const int lo = args.ph_lo, hi = args.ph_hi;
    XcdBarrier bar; bar.bar = ctl + CW_BAR; bar.x = 0; bar.st = nullptr;
    if (hi - lo > 1) bar = xcd_barrier_post(ctl + CW_BAR, MISC + 8);
#define IN(k) (lo <= (k) && (k) < hi)
#define SEAM(k) do { if (IN(k) && IN((k) + 1)) xcd_barrier(bar); } while (0)
#define SEAM_ARRIVE(k) do { if (IN(k) && IN((k) + 1)) bgen = xcd_barrier_arrive(bar); } while (0)
#define SEAM_WAIT(k) do { if (IN(k) && IN((k) + 1)) xcd_barrier_wait(bar, bgen); else __syncthreads(); } while (0)
    const int gw = vcu * NWAVES + wave, NGW = G * NWAVES;
    const bool full = (lo == 0 && hi == N_PHASES);
    unsigned bgen = 0u;
    if (full) { if (tid == 0 && bx < 8) __hip_atomic_store(&ctl[CW_XMAP + bx], xb_xcc_id() + 1u, __ATOMIC_RELAXED, __HIP_MEMORY_SCOPE_AGENT);
                bgen = xcd_barrier_arrive(bar); }

    if (IN(0)) REP(0) {
        LAS float* scr = (LAS float*)(lds + RING_OFF + wave * 16384);
        constexpr int I_IN = (D / 64) * (INC / 32), I_OUT = (D / 64) * (D / 32);
#define P0_LOAD(wv_, it_) do { if ((it_) < I_IN) tr_load(wv_, w_in, INC, (it_), lane); else tr_load(wv_, w_out, D, (it_) - I_IN, lane); } while (0)
#define P0_FIN(wv_, it_) do { if ((it_) < I_IN) tr_finish<0>(wv_, D, INC, Win_t, scr, (it_), lane, w_mix); else tr_finish<0>(wv_, D, D, Wout_t, scr, (it_) - I_IN, lane); } while (0)
        for (int it = gw; it < I_IN + I_OUT; it += 2 * NGW) { float wa[32], wb[32]; const bool two = it + NGW < I_IN + I_OUT;
            P0_LOAD(wa, it); if (two) P0_LOAD(wb, it + NGW);
            P0_FIN(wa, it); if (two) P0_FIN(wb, it + NGW); }
#undef P0_LOAD
#undef P0_FIN
        if (full) { xcd_barrier_poll(bar, bgen);
                    if (tid == 0 && (G % 8 != 0 || xb_ld(&ctl[CW_XMAP + (bx & 7)]) != xb_xcc_id() + 1u)) atomicOr(&ctl[CW_NONCANON], 1u);
                    bgen = xcd_barrier_arrive(bar); }
        for (int i = bx * (NWAVES * 64) + tid; i < M; i += G * NWAVES * 64) ssq[i] = 0.f;
        { float* rstd0 = (float*)(ctl + CW_RSTD0);
          if (G == 256) {
              const int tp0 = 16 * (bx & 7) + ((bx >> 3) & 7), rw0 = 64 * (bx >> 6) + 8 * wave;
#pragma unroll 1
              for (int it = 0; it < 2; ++it) { const float* xr[8]; bf16* orw[8]; float* rsp[8];
#pragma unroll
                  for (int r = 0; r < 8; ++r) { const int mm = 256 * (tp0 + 8 * it) + rw0 + r; xr[r] = mm < MP ? xp + (size_t)mm * D : xs + (size_t)(mm - MP) * D; orw[r] = XN + (size_t)mm * D; rsp[r] = rstd0 + mm; }
                  rows_to_bf16_rstd<8>(xr, orw, rsp, lane); }
          } else
          for (int m = gw; m < M; m += 4 * NGW) {
              const float* xr[4]; bf16* orw[4]; float* rsp[4];
#pragma unroll
              for (int r = 0; r < 4; ++r) { const int mm = min(m + r * NGW, M - 1); xr[r] = mm < MP ? xp + (size_t)mm * D : xs + (size_t)(mm - MP) * D; orw[r] = XN + (size_t)mm * D; rsp[r] = rstd0 + mm; }
              rows_to_bf16_rstd<4>(xr, orw, rsp, lane); } }
    }
    unsigned* tcnt = ctl + CW_TB + 16 * (((bx & 7) << 3) | ((bx >> 3) & 7));
    if (full) { xcd_barrier_poll(bar, bgen); if (tid == 0) MISC[12] = xb_ld(&ctl[CW_NONCANON]); } else { SEAM(0); if (tid == 0) MISC[12] = 1u; }
    __syncthreads();
    const bool local_ok = (MISC[12] == 0u);
    const bool team_ok = local_ok && G == 256;
    unsigned lgen = 0u;
    if (full) { if (team_ok) team_barrier(tcnt, 0u, ctl + CW_BAR + XB_TMO); else xcd_barrier(bar); }
    if ((PROBE) == 100) { SEAM(0); SEAM(0); SEAM(0); SEAM(0); }
    if (IN(1)) REP(1) {
        pg8::Gemm g{XN, Win_t, M, INC, D}; pg8::StaticOrder S; S.init(M, INC, G, bx);
        EpiInProj E{Hb, NAb, lbp, (const float*)(ctl + CW_RSTD0)};
        pg8::gemm_phase<EpiInProj, pg8::StaticOrder, true, true>(lds + RING_OFF, g, S, E);
    }
    if (local_ok) { lgen = lb_arrive(bar, ctl); bgen = xcd_barrier_arrive(bar); lb_wait(bar, ctl, lgen); } else SEAM(1);
    if (wave >= 4) __builtin_amdgcn_s_setprio(1);
    if (IN(2)) {
        for (int rep_ = 0; rep_ < (((PROBE) == 20 || (PROBE) / 10 == 20) ? 2 : 1); ++rep_) for (int ch = vcu; ch < 256; ch += G) { const int dir = ch & 1, head = (ch >> 1) & 3, sg = ch >> 3;
            const int seq = sg < 16 ? sg >> 2 : 4 + ((sg - 16) >> 3), seg = sg < 16 ? sg & 3 : (sg - 16) & 7;
            const int s0 = seq < 4 ? seq * 4096 : MP + (seq - 4) * 8192;
            const int dm_ = (((PROBE) / 10 == 20 || (PROBE) == 20) && rep_ == 0) ? (1 | (((PROBE) / 10 == 20) ? ((PROBE) % 10) * 2 : 0)) : 0;
            if (dir) hgrn_chain2<1>(lds, Hb, Hb + 2 * (size_t)M * GW, Hb + 3 * (size_t)M * GW, OBk + (size_t)head * ((size_t)M * 128), 128, s0, 16 * seg + 15, 16, head, SLb + (size_t)ch * 16384, Btb + ch * 128);
            else     hgrn_chain2<0>(lds, Hb, Hb + (size_t)M * GW, Hb + 3 * (size_t)M * GW, Ob + head * 128, D, s0, 16 * seg, 16, head, SLb + (size_t)ch * 16384, Btb + ch * 128); (void)dm_; }
        if (local_ok) xcd_barrier_wait(bar, bgen);
        if (team_ok) bgen = xcd_barrier_arrive(bar);
        REP(21) for (int ru = vcu; ru < 256; ru += G) { int seq, head, run;
            if (ru < 128) { seq = ru >> 5; head = (ru >> 2) & 7; run = ru & 3; } else { const int r2 = ru - 128, x2 = r2 >> 5, q2 = r2 & 31; seq = 4 + (x2 >> 1); head = q2 >> 2; run = 4 * (x2 & 1) + (q2 & 3); }
            const int s0 = seq < 4 ? seq * 4096 : MP + (seq - 4) * 8192, rows = seq < 4 ? 64 : 128;
            na_run(lds, NAb, NAb + (size_t)M * GW, NAb + 2 * (size_t)M * GW, qnw, knw, rpb, Ob, s0, rows, head, run * 16, 16); }
    }
    if (team_ok) {
        xcd_barrier_wait(bar, bgen);
        { const int xk = bx & 7, e_all = (bx >> 3) * (NWAVES * 64) + tid, seq = xk < 4 ? xk : 4 + ((xk - 4) >> 1);
          hgrn_scan(SLb, Btb, SFb, ((seq << 3) | (e_all >> 11)) * 2048 + (e_all & 2047), 1 << 30, xk); }
        lgen = lb_arrive(bar, ctl); lb_wait(bar, ctl, lgen);
    } else {
        SEAM(2);
        if (IN(3)) hgrn_scan(SLb, Btb, SFb, bx * (NWAVES * 64) + tid, G * NWAVES * 64);
        SEAM(3);
    }
    if (IN(4)) for (int rep_ = 0; rep_ < (((PROBE) == 4 || (PROBE) == 41 || (PROBE) == 42) ? 2 : 1); ++rep_) {
        const bool dry_ = ((PROBE) == 4 || (PROBE) == 41 || (PROBE) == 42) && rep_ == 0; const int mode_ = dry_ ? ((PROBE) == 41 ? 1 : ((PROBE) == 42 ? 2 : 0)) : 0;
        for (int un = vcu; un < 256; un += G) { const int half = un & 1, head = (un >> 1) & 3, sg = un >> 3;
            const int seq = sg < 16 ? sg >> 2 : 4 + ((sg - 16) >> 3), seg = sg < 16 ? sg & 3 : (sg - 16) & 7;
            const int s0 = seq < 4 ? seq * 4096 : MP + (seq - 4) * 8192;
            hgrn_pass2(lds, Hb + (size_t)M * GW, Hb + 2 * (size_t)M * GW, Hb + 4 * (size_t)M * GW, gnw, SFb, Ob, dry_ ? Hb + 3 * (size_t)M * GW : Ob, dry_ ? GW : D, OBk, s0, seg, sg, head, half, mode_); }
    }
    __builtin_amdgcn_s_setprio(0);
    __syncthreads(); if (tid == 0) (void)xb_add(&ctl[CW_P4DONE], 1u);
    if (team_ok) lgen = lb_arrive(bar, ctl); else SEAM_ARRIVE(4);
    constexpr int I_G = (D / 64) * (FF / 32), I_D = (FF / 64) * (D / 32);
    if (IN(5)) {
        LAS float* scr = (LAS float*)(lds + RING_OFF + wave * 16384);
#define P5_LOAD(wv_, it_) do { if ((it_) < I_G) tr_load(wv_, w_gate, FF, (it_), lane); else if ((it_) < 2 * I_G) tr_load(wv_, w_up, FF, (it_) - I_G, lane); else tr_load(wv_, w_down, D, (it_) - 2 * I_G, lane); } while (0)
#define P5_FIN(wv_, it_) do { if ((it_) < I_G) tr_finish<1>(wv_, D, FF, Wgu_t, scr, (it_), lane, w_ffn); else if ((it_) < 2 * I_G) tr_finish<2>(wv_, D, FF, Wgu_t, scr, (it_) - I_G, lane, w_ffn); \
                else tr_finish<0>(wv_, FF, D, Wdown_t, scr, (it_) - 2 * I_G, lane); } while (0)
        for (int it = gw; it < 2 * I_G + I_D; it += 2 * NGW) { float wa[32], wb[32]; const bool two = it + NGW < 2 * I_G + I_D;
            P5_LOAD(wa, it); if (two) P5_LOAD(wb, it + NGW);
            P5_FIN(wa, it); if (two) P5_FIN(wb, it + NGW); }
#undef P5_LOAD
#undef P5_FIN
    }
    if (team_ok) { bgen = xcd_barrier_arrive(bar); lb_wait(bar, ctl, lgen); }
    else { SEAM_WAIT(4); if (local_ok) bgen = xcd_barrier_arrive(bar); }
    if (IN(5)) REP(5) {
        pg8::Gemm g{Ob, Wout_t, M, D, D}; pg8::StaticOrder S; S.init(M, D, G, bx);
        EpiOutProj E{XN, X1b, ssq};
        pg8::gemm_phase<EpiOutProj, pg8::StaticOrder, true, true>(lds + RING_OFF, g, S, E);
    }
    if (team_ok) { xcd_barrier_poll(bar, bgen); team_barrier(tcnt, 1u, ctl + CW_BAR + XB_TMO); }
    else if (local_ok) { lgen = lb_arrive(bar, ctl); lb_wait(bar, ctl, lgen); xcd_barrier_wait(bar, bgen); } else SEAM(5);
    if (IN(6)) REP(6) {
        pg8::Gemm g{X1b, Wgu_t, M, 2 * FF, D}; pg8::StaticOrder S; S.init(M, 2 * FF, G, bx);
        EpiGateUp E{HFF, ssq, ctl + CW_P4DONE, full ? (unsigned)G : 0u, false};
        pg8::gemm_phase<EpiGateUp, pg8::StaticOrder, true, true>(lds + RING_OFF, g, S, E);
    }
    if (team_ok) team_barrier(tcnt, 2u, ctl + CW_BAR + XB_TMO);
    else if (local_ok) { lgen = lb_arrive(bar, ctl); lb_wait(bar, ctl, lgen); } else SEAM(6);
    if (IN(7)) REP(7) {
        pg8::Gemm g{HFF, Wdown_t, M, D, FF}; pg8::StaticOrder S; S.init(M, D, G, bx);
        EpiDown E{out, X1b, ctl + CW_P4DONE, full ? (unsigned)G : 0u, false};
        pg8::gemm_phase<EpiDown, pg8::StaticOrder, true, true>(lds + RING_OFF, g, S, E);
    }
#undef IN
#undef SEAM
}

#ifndef N_LAUNCHES
#define N_LAUNCHES 1
#endif
extern "C" void kernel_launch(void* const* d_in, const int* in_sizes, int n_in, void* d_out, int out_size, void* d_ws, size_t ws_size, hipStream_t stream) {
    static int grid = 0;
    if (grid == 0) {
        if (n_in != 14 || out_size != 2 * MP * D || ws_size < WS_END) { fprintf(stderr, "kernel_launch: unexpected shapes (n_in %d out %d ws %zu)\n", n_in, out_size, ws_size); grid = -1; return; }
        int dev = 0, cus = 0;
        if (hipGetDevice(&dev) != hipSuccess || hipDeviceGetAttribute(&cus, hipDeviceAttributeMultiprocessorCount, dev) != hipSuccess) { grid = -1; return; }
        if (hipFuncSetAttribute((const void*)fwd_kernel, hipFuncAttributeMaxDynamicSharedMemorySize, LDS_BYTES) != hipSuccess) { fprintf(stderr, "kernel_launch: hipFuncSetAttribute failed\n"); grid = -1; return; }
        grid = cus;
    }
    if (grid < 0) return;
    (void)hipMemsetAsync((char*)d_ws + WS_CTL, 0, CTL_ZERO_BYTES, stream);
    Args a{};
    for (int i = 0; i < 14; ++i) a.in[i] = (const float*)d_in[i];
    a.out = (float*)d_out; a.ws = (unsigned char*)d_ws;
    if (N_LAUNCHES == 1) { a.ph_lo = 0; a.ph_hi = N_PHASES; hipLaunchKernelGGL(fwd_kernel, dim3(grid), dim3(NWAVES * 64), LDS_BYTES, stream, a); }
    else for (int p = 0; p < N_PHASES; ++p) { a.ph_lo = p; a.ph_hi = p + 1; hipLaunchKernelGGL(fwd_kernel, dim3(grid), dim3(NWAVES * 64), LDS_BYTES, stream, a); }
}
```
